# Optimizing an MI355X kernel written in HIP

```python
import math
import jax, jax.numpy as jnp
from jax import lax
import numpy as np

D_MODEL = 1024
BATCH = 32
SEQ = 2048
DEPTH = 4

N_EVEN = (DEPTH + 1) // 2
N_ODD = DEPTH // 2
HEAD_DIM = 64
A_Q_HEADS = D_MODEL // 128
A_KV_HEADS = A_Q_HEADS // 4
A_GROUP = A_Q_HEADS // A_KV_HEADS
A_WIDTH = A_Q_HEADS * HEAD_DIM
KV_WIDTH = A_KV_HEADS * HEAD_DIM
WINDOW = 128
BLOCK = 128
ROPE_THETA = 10000.0
NEG_INF = -1e30
B_GROUPS = D_MODEL // 128
B_GROUP_DIM = 64
B_WIDTH = B_GROUPS * B_GROUP_DIM
CHUNK = 128
IN_WIDTH = A_WIDTH + 2 * KV_WIDTH + 2 * B_WIDTH
MIX_WIDTH = A_WIDTH + B_WIDTH
S5_GROUP = 16
S5_GROUPS = D_MODEL // S5_GROUP
S5_STATE = 64
D_FF = ((8 * D_MODEL // 3 + 127) // 128) * 128
N_EXPERTS = 8
TOP_K = 2
ALPHA = (2.0 * DEPTH) ** 0.25
BETA = (8.0 * DEPTH) ** -0.25
LN_EPS = 1e-5

kernel_name = 'hybrid_window_gqa_gmlp_s5_moe_encoder'


def layer_norm(x, g, b):
    xf = x.astype(jnp.float32)
    mu = xf.mean(-1, keepdims=True)
    var = jnp.square(xf - mu).mean(-1, keepdims=True)
    return ((xf - mu) * lax.rsqrt(var + LN_EPS) * g.astype(jnp.float32) + b.astype(jnp.float32)).astype(x.dtype)


def rope_tables(seq):
    pos = jnp.arange(seq, dtype=jnp.float32)
    inv_freq = ROPE_THETA ** (-jnp.arange(0, HEAD_DIM, 2, dtype=jnp.float32) / HEAD_DIM)
    ang = pos[:, None] * inv_freq[None, :]
    return jnp.cos(ang), jnp.sin(ang)


def apply_rope(x, cos, sin):
    xf = x.astype(jnp.float32)
    x1, x2 = jnp.split(xf, 2, axis=-1)
    c = cos[None, :, None, :]
    s = sin[None, :, None, :]
    return jnp.concatenate([x1 * c - x2 * s, x2 * c + x1 * s], axis=-1).astype(x.dtype)


def window_attention(q, k, v, sink):
    Bsz, S = q.shape[0], q.shape[1]
    nb = S // BLOCK
    qb = q.reshape(Bsz, nb, BLOCK, A_KV_HEADS, A_GROUP, HEAD_DIM)

    def neighbours(t):
        tp = jnp.pad(t, ((0, 0), (BLOCK, BLOCK), (0, 0), (0, 0))).reshape(Bsz, nb + 2, BLOCK, A_KV_HEADS, HEAD_DIM)
        return jnp.concatenate([tp[:, :-2], tp[:, 1:-1], tp[:, 2:]], axis=2)

    kb, vb = neighbours(k), neighbours(v)
    scores = jnp.einsum('bnqhgd,bnshd->bnhgqs', qb, kb, preferred_element_type=jnp.float32) * (HEAD_DIM ** -0.5)
    blk = jnp.arange(nb)[:, None]
    qpos = blk * BLOCK + jnp.arange(BLOCK)[None, :]
    kpos = blk * BLOCK - BLOCK + jnp.arange(3 * BLOCK)[None, :]
    kp = kpos[:, None, :]
    valid = (jnp.abs(kp - qpos[:, :, None]) <= WINDOW) & (kp >= 0) & (kp < S)
    scores = jnp.where(valid[None, :, None, None], scores, NEG_INF)
    sink_l = sink.astype(jnp.float32).reshape(1, 1, A_KV_HEADS, A_GROUP, 1, 1)
    m = jnp.maximum(scores.max(-1, keepdims=True), sink_l)
    p = jnp.exp(scores - m)
    denom = p.sum(-1, keepdims=True) + jnp.exp(sink_l - m)
    probs = (p / denom).astype(v.dtype)
    out = jnp.einsum('bnhgqs,bnshd->bnqhgd', probs, vb)
    return out.reshape(Bsz, S, A_WIDTH)


def spatial_gating(z_u, z_v, w_s, b_s, ln_g, ln_b):
    Bsz, S = z_u.shape[0], z_u.shape[1]
    u = jax.nn.gelu(z_u)
    v = layer_norm(jax.nn.gelu(z_v), ln_g, ln_b)
    vc = v.reshape(Bsz, S // CHUNK, CHUNK, B_GROUPS, B_GROUP_DIM)
    sv = jnp.einsum('gpq,bnqgd->bnpgd', w_s, vc) + b_s.T[None, None, :, :, None]
    return (u * sv.reshape(Bsz, S, B_GROUPS, B_GROUP_DIM)).reshape(Bsz, S, B_WIDTH)


def mixer_ab(x, w_in, sink, w_s, b_s, sgu_g, sgu_b, w_out, cos, sin):
    Bsz, S, _ = x.shape
    h = x @ w_in
    q, k, v, z_u, z_v = jnp.split(h, [A_WIDTH, A_WIDTH + KV_WIDTH, A_WIDTH + 2 * KV_WIDTH,
                                      A_WIDTH + 2 * KV_WIDTH + B_WIDTH], axis=-1)
    q = apply_rope(q.reshape(Bsz, S, A_Q_HEADS, HEAD_DIM), cos, sin)
    k = apply_rope(k.reshape(Bsz, S, A_KV_HEADS, HEAD_DIM), cos, sin)
    v = v.reshape(Bsz, S, A_KV_HEADS, HEAD_DIM)
    a_out = window_attention(q, k, v, sink)
    b_out = spatial_gating(z_u.reshape(Bsz, S, B_GROUPS, B_GROUP_DIM), z_v.reshape(Bsz, S, B_GROUPS, B_GROUP_DIM),
                           w_s, b_s, sgu_g, sgu_b)
    return jnp.concatenate([a_out, b_out], axis=-1) @ w_out


def _ssm_combine(left, right):
    a_l, b_l = left
    a_r, b_r = right
    return a_r * a_l, a_r * b_l + b_r


def mixer_c(x, lam_re, lam_im, log_dt, b_re, b_im, c_re, c_im, d_skip, w_val, w_gate):
    Bsz, S, _ = x.shape
    u = x.astype(jnp.float32).reshape(Bsz, S, S5_GROUPS, S5_GROUP)
    uc = u.astype(jnp.complex64)
    y = d_skip.astype(jnp.float32) * u
    for direction, reverse in ((0, False), (1, True)):
        lam = lax.complex(lam_re[direction].astype(jnp.float32), lam_im[direction].astype(jnp.float32))
        dt = jnp.exp(log_dt[direction].astype(jnp.float32))[:, None]
        lam_bar = jnp.exp(lam * dt)
        bmat = lax.complex(b_re[direction].astype(jnp.float32), b_im[direction].astype(jnp.float32))
        b_bar = ((lam_bar - 1.0) / lam)[..., None] * bmat
        bu = jnp.einsum('gpc,bsgc->bsgp', b_bar, uc)
        a = jnp.broadcast_to(lam_bar, (1, S, S5_GROUPS, S5_STATE))
        _, states = lax.associative_scan(_ssm_combine, (a, bu), reverse=reverse, axis=1)
        cmat = lax.complex(c_re[direction].astype(jnp.float32), c_im[direction].astype(jnp.float32))
        y = y + jnp.einsum('gcp,bsgp->bsgc', cmat, states).real
    y = jax.nn.gelu(y.reshape(Bsz, S, D_MODEL)).astype(x.dtype)
    return (y @ w_val) * jax.nn.sigmoid(y @ w_gate)


def swiglu(x, w_gate, w_up, w_down):
    return (jax.nn.silu(x @ w_gate) * (x @ w_up)) @ w_down


def moe_swiglu(x, router_w, w_gate, w_up, w_down):
    Bsz, S, D = x.shape
    t = x.reshape(-1, D)
    logits = jnp.dot(t, router_w, preferred_element_type=jnp.float32)
    top_val, top_idx = lax.top_k(logits, TOP_K)
    top_w = jax.nn.softmax(top_val, axis=-1)
    combine = jnp.einsum('tk,tke->te', top_w, jax.nn.one_hot(top_idx, N_EXPERTS, dtype=jnp.float32))
    out = jnp.zeros_like(t)
    for e in range(N_EXPERTS):
        out = out + combine[:, e:e + 1].astype(t.dtype) * swiglu(t, w_gate[e], w_up[e], w_down[e])
    return out.reshape(Bsz, S, D)


def setup_inputs(seed: int = 0) -> dict:
    key = jax.random.key(seed)
    ks = iter(jax.random.split(key, 32))

    def nrm(shape, scale):
        return scale * jax.random.normal(next(ks), shape, jnp.float32)

    x = nrm((BATCH, SEQ, D_MODEL), 1.0)
    ln_g = 1.0 + nrm((DEPTH, 2, D_MODEL), 0.02)
    ln_b = nrm((DEPTH, 2, D_MODEL), 0.02)
    mix_w_in = nrm((N_EVEN, D_MODEL, IN_WIDTH), D_MODEL ** -0.5)
    attn_sink = nrm((N_EVEN, A_Q_HEADS), 0.5)
    sgu_w = nrm((N_EVEN, B_GROUPS, CHUNK, CHUNK), 0.5 * CHUNK ** -0.5)
    sgu_b = 1.0 + nrm((N_EVEN, B_GROUPS, CHUNK), 0.02)
    sgu_ln_g = 1.0 + nrm((N_EVEN, B_GROUPS, B_GROUP_DIM), 0.02)
    sgu_ln_b = nrm((N_EVEN, B_GROUPS, B_GROUP_DIM), 0.02)
    mix_w_out = nrm((N_EVEN, MIX_WIDTH, D_MODEL), BETA * MIX_WIDTH ** -0.5)
    ffn_w_gate = nrm((N_EVEN, D_MODEL, D_FF), D_MODEL ** -0.5)
    ffn_w_up = nrm((N_EVEN, D_MODEL, D_FF), D_MODEL ** -0.5)
    ffn_w_down = nrm((N_EVEN, D_FF, D_MODEL), BETA * D_FF ** -0.5)
    n = jnp.arange(S5_STATE, dtype=jnp.float32)
    s5_lam_re = -0.5 + nrm((N_ODD, 2, S5_GROUPS, S5_STATE), 0.01)
    s5_lam_im = math.pi * n + nrm((N_ODD, 2, S5_GROUPS, S5_STATE), 0.01)
    s5_log_dt = jax.random.uniform(next(ks), (N_ODD, 2, S5_GROUPS), jnp.float32, math.log(1e-3), math.log(1e-1))
    s5_b_re = nrm((N_ODD, 2, S5_GROUPS, S5_STATE, S5_GROUP), (2 * S5_GROUP) ** -0.5)
    s5_b_im = nrm((N_ODD, 2, S5_GROUPS, S5_STATE, S5_GROUP), (2 * S5_GROUP) ** -0.5)
    s5_c_re = nrm((N_ODD, 2, S5_GROUPS, S5_GROUP, S5_STATE), S5_STATE ** -0.5)
    s5_c_im = nrm((N_ODD, 2, S5_GROUPS, S5_GROUP, S5_STATE), S5_STATE ** -0.5)
    s5_d = nrm((N_ODD, S5_GROUPS, S5_GROUP), 1.0)
    glu_w_val = nrm((N_ODD, D_MODEL, D_MODEL), BETA * D_MODEL ** -0.5)
    glu_w_gate = nrm((N_ODD, D_MODEL, D_MODEL), D_MODEL ** -0.5)
    router_w = nrm((N_ODD, D_MODEL, N_EXPERTS), D_MODEL ** -0.5)
    moe_w_gate = nrm((N_ODD, N_EXPERTS, D_MODEL, D_FF), D_MODEL ** -0.5)
    moe_w_up = nrm((N_ODD, N_EXPERTS, D_MODEL, D_FF), D_MODEL ** -0.5)
    moe_w_down = nrm((N_ODD, N_EXPERTS, D_FF, D_MODEL), BETA * D_FF ** -0.5)
    return {'x': x, 'ln_g': ln_g, 'ln_b': ln_b, 'mix_w_in': mix_w_in, 'attn_sink': attn_sink,
            'sgu_w': sgu_w, 'sgu_b': sgu_b, 'sgu_ln_g': sgu_ln_g, 'sgu_ln_b': sgu_ln_b, 'mix_w_out': mix_w_out,
            'ffn_w_gate': ffn_w_gate, 'ffn_w_up': ffn_w_up, 'ffn_w_down': ffn_w_down,
            's5_lam_re': s5_lam_re, 's5_lam_im': s5_lam_im, 's5_log_dt': s5_log_dt,
            's5_b_re': s5_b_re, 's5_b_im': s5_b_im, 's5_c_re': s5_c_re, 's5_c_im': s5_c_im, 's5_d': s5_d,
            'glu_w_val': glu_w_val, 'glu_w_gate': glu_w_gate, 'router_w': router_w,
            'moe_w_gate': moe_w_gate, 'moe_w_up': moe_w_up, 'moe_w_down': moe_w_down}


def reference(x, ln_g, ln_b, mix_w_in, attn_sink, sgu_w, sgu_b, sgu_ln_g, sgu_ln_b, mix_w_out,
              ffn_w_gate, ffn_w_up, ffn_w_down, s5_lam_re, s5_lam_im, s5_log_dt,
              s5_b_re, s5_b_im, s5_c_re, s5_c_im, s5_d, glu_w_val, glu_w_gate, router_w,
              moe_w_gate, moe_w_up, moe_w_down):
    cos, sin = rope_tables(x.shape[1])
    for layer in range(DEPTH):
        i = layer // 2
        if layer % 2 == 0:
            mixed = mixer_ab(x, mix_w_in[i], attn_sink[i], sgu_w[i], sgu_b[i], sgu_ln_g[i], sgu_ln_b[i],
                             mix_w_out[i], cos, sin)
            x = layer_norm(ALPHA * x + mixed, ln_g[layer, 0], ln_b[layer, 0])
            ffn = swiglu(x, ffn_w_gate[i], ffn_w_up[i], ffn_w_down[i])
            x = layer_norm(ALPHA * x + ffn, ln_g[layer, 1], ln_b[layer, 1])
        else:
            mixed = mixer_c(x, s5_lam_re[i], s5_lam_im[i], s5_log_dt[i], s5_b_re[i], s5_b_im[i],
                            s5_c_re[i], s5_c_im[i], s5_d[i], glu_w_val[i], glu_w_gate[i])
            x = layer_norm(ALPHA * x + mixed, ln_g[layer, 0], ln_b[layer, 0])
            ffn = moe_swiglu(x, router_w[i], moe_w_gate[i], moe_w_up[i], moe_w_down[i])
            x = layer_norm(ALPHA * x + ffn, ln_g[layer, 1], ln_b[layer, 1])
    return x
```

```cpp
#include <hip/hip_runtime.h>
#include <cstdio>
#include <cstdint>

#define LAS __attribute__((address_space(3)))
typedef unsigned short bf16;
typedef short bf16x8 __attribute__((ext_vector_type(8)));
typedef short s16x4 __attribute__((ext_vector_type(4)));
typedef float f32x4 __attribute__((ext_vector_type(4)));
typedef float f32x2 __attribute__((ext_vector_type(2)));
typedef float f32x16 __attribute__((ext_vector_type(16)));
typedef unsigned u32x4 __attribute__((ext_vector_type(4)));
typedef unsigned u32x2 __attribute__((ext_vector_type(2)));
typedef int i32x4 __attribute__((ext_vector_type(4)));
typedef __bf16 bf2_t __attribute__((ext_vector_type(2)));
#define DI __device__ __forceinline__
#ifndef PHM
#define PHM 0xFFFFF
#endif
#define PH(b) if (PHM & (1 << (b)))
#define UFRESH(F) do { asm volatile("" : "+s"((F).ws), "+s"((F).out), "+s"((F).G), "+s"((F).bid)); (F).ctl = (unsigned*)((F).ws + WS_CTL); } while (0)
#define FRESH(F) do { UFRESH(F); int l_ = lane_id(); asm volatile("" : "+v"(l_)); (F).lane = l_; (F).tid = (F).wave * 64 + l_; } while (0)

constexpr int NWAVES = 8;
constexpr int BATCH = 32, SEQ = 2048, D = 1024, T = BATCH * SEQ;
constexpr int INW = 1792, FF = 2816, NE = 8;
constexpr float ALPHA = 1.6817928305074290f;
constexpr float LN_EPS = 1e-5f;
constexpr float QSCALE = 0.18033688011112042f;
constexpr float LOG2E = 1.4426950408889634f;

constexpr size_t MiB = 1u << 20;
constexpr size_t WS_CTL = 0, CTL_ZERO_BYTES = 1 * MiB;
constexpr size_t WS_ROPE = 1 * MiB;
constexpr size_t WS_RECI = 2 * MiB;
constexpr size_t WS_RECW = 3 * MiB;
constexpr size_t WS_SGUW = 4 * MiB;
constexpr size_t WS_W = 16 * MiB;
constexpr size_t WS_XB = 156 * MiB;
constexpr size_t WS_Y = 284 * MiB;
constexpr size_t WS_R = 412 * MiB;
constexpr size_t WS_Q = WS_R, WS_K = WS_Q + 64 * MiB, WS_V = WS_K + 16 * MiB, WS_ZU = WS_V + 16 * MiB, WS_ZV = WS_ZU + 64 * MiB, WS_MIX = WS_ZV + 64 * MiB;
constexpr size_t WS_H = WS_R;
constexpr size_t WS_YF = WS_R;
constexpr size_t WS_YG = WS_R + 256 * MiB;
constexpr int XS_ROWS = 2 * T + NE * 256;
constexpr int TC_MAX = 130;
constexpr size_t WS_XS = 284 * MiB;
constexpr size_t WS_HS = 544 * MiB;
constexpr size_t WS_YS = 724 * MiB;
constexpr size_t WS_END = 984 * MiB;
constexpr size_t W_IN = 0, W_OUT = 4 * MiB, W_GU = 6 * MiB, W_DN = 17 * MiB;
constexpr size_t W_GLU = 0, W_MGU = 4 * MiB, W_MDN = 92 * MiB;
constexpr int CW_TMO = 0, CW_DBG = 2, CW_BAR = 4096, CW_CNT = 8192;

constexpr int RING_BYTES = 131072;
constexpr int LDSCTL_OFF = RING_BYTES, MISC_OFF = LDSCTL_OFF + 320;
constexpr int LDS_BYTES = 147456;

DI unsigned pk2(float lo, float hi) { f32x2 v = {lo, hi}; return __builtin_bit_cast(unsigned, __builtin_convertvector(v, bf2_t)); }
DI float bf_lo(unsigned w) { return __uint_as_float(w << 16); }
DI float bf_hi(unsigned w) { return __uint_as_float(w & 0xffff0000u); }
DI float fast_exp2(float x) { return __builtin_amdgcn_exp2f(x); }
DI float fast_rcp(float x) { return __builtin_amdgcn_rcpf(x); }
DI float sigmoidf_(float x) { return fast_rcp(1.0f + fast_exp2(-LOG2E * x)); }
DI float gelu_tanh(float x) { const float z = x + 0.044715f * x * x * x; return x * fast_rcp(1.0f + fast_exp2(-2.302208198f * z)); }
#define dpp_f(v, ctrl) __int_as_float(__builtin_amdgcn_mov_dpp(__float_as_int(v), (ctrl), 0xf, 0xf, true))
#define DPP_XOR1 0xB1
#define DPP_XOR2 0x4E
#define DPP_HMIRROR 0x141
#define DPP_MIRROR 0x140
DI float swz16_f(float v) { return __int_as_float(__builtin_amdgcn_ds_swizzle(__float_as_int(v), 0x401F)); }
DI float sum_x32(float v) { auto r = __builtin_amdgcn_permlane32_swap(__float_as_uint(v), __float_as_uint(v), false, false); return __uint_as_float(r[0]) + __uint_as_float(r[1]); }
DI float max_x32(float v) { auto r = __builtin_amdgcn_permlane32_swap(__float_as_uint(v), __float_as_uint(v), false, false); return fmaxf(__uint_as_float(r[0]), __uint_as_float(r[1])); }
DI float wave_sum(float v) {
    v += dpp_f(v, DPP_XOR1); v += dpp_f(v, DPP_XOR2); v += dpp_f(v, DPP_HMIRROR); v += dpp_f(v, DPP_MIRROR); v += swz16_f(v); return sum_x32(v);
}
#define LDS_WAIT() asm volatile("s_waitcnt lgkmcnt(0)" ::: "memory")
#define VM_WAIT() asm volatile("s_waitcnt vmcnt(0)" ::: "memory")
DI int lane_id() { unsigned ones = ~0u; asm volatile("" : "+s"(ones)); return (int)__builtin_amdgcn_mbcnt_hi(ones, __builtin_amdgcn_mbcnt_lo(ones, 0u)); }
DI int crow(int reg, int h) { return (reg & 3) + 8 * (reg >> 2) + 4 * h; }
#define MFMA32(a, b, c) __builtin_amdgcn_mfma_f32_32x32x16_bf16((a), (b), (c), 0, 0, 0)
#define MFMA16(a, b, c) __builtin_amdgcn_mfma_f32_16x16x32_bf16((a), (b), (c), 0, 0, 0)

DI void sincos_d(double th, double& s, double& c) {
    const double tq = th * 0.63661977236758134308;
    const double q = rint(tq);
    const double f = (tq - q) * 1.57079632679489661923;
    const double f2 = f * f;
    const double sp = f * (1.0 + f2 * (-1.0 / 6 + f2 * (1.0 / 120 + f2 * (-1.0 / 5040 + f2 * (1.0 / 362880 + f2 * (-1.0 / 39916800 + f2 * (1.0 / 6227020800.0)))))));
    const double cp = 1.0 + f2 * (-0.5 + f2 * (1.0 / 24 + f2 * (-1.0 / 720 + f2 * (1.0 / 40320 + f2 * (-1.0 / 3628800 + f2 * (1.0 / 479001600.0 + f2 * (-1.0 / 87178291200.0)))))));
    const int qi = ((int)q) & 3;
    s = (qi == 0) ? sp : (qi == 1) ? cp : (qi == 2) ? -sp : -cp;
    c = (qi == 0) ? cp : (qi == 1) ? -sp : (qi == 2) ? -cp : sp;
}
DI double exp_d(double x) {
    const double n = rint(x * 1.4426950408889634074);
    const double r = x - n * 0.69314718055994530942;
    double p = 1.0 / 87178291200.0;
    p = p * r + 1.0 / 6227020800.0; p = p * r + 1.0 / 479001600.0; p = p * r + 1.0 / 39916800.0; p = p * r + 1.0 / 3628800.0; p = p * r + 1.0 / 362880.0;
    p = p * r + 1.0 / 40320.0; p = p * r + 1.0 / 5040.0; p = p * r + 1.0 / 720.0; p = p * r + 1.0 / 120.0; p = p * r + 1.0 / 24.0; p = p * r + 1.0 / 6.0; p = p * r + 0.5; p = p * r + 1.0; p = p * r + 1.0;
    const long long bits = (long long)((int)n + 1023) << 52;
    return p * __builtin_bit_cast(double, bits);
}

namespace pg8 {
constexpr int BM = 256, BK = 64, HALF = 128, HTB = HALF * BK * 2, STAGE_BYTES = 8 * HTB, NXCD = 8, WGM = 8;
DI int lds_byte(int r, int c) { const int st = (r >> 4) * 2 + (c >> 5), rr = r & 15, cc = c & 31, ob = rr * 64 + cc * 2; return st * 1024 + (ob ^ (((ob >> 9) & 1) << 5)); }
DI void stage_rc(int b, int& R, int& C) { const int st = b / 1024, sb = b % 1024, swz = sb ^ (((sb >> 9) & 1) << 5); R = (st >> 1) * 16 + swz / 64; C = (st & 1) * 32 + (swz % 64) / 2; }
DI int perm32(int rho) { const int n = rho >> 4, i = rho & 15; return 8 * (i >> 2) + 4 * n + (i & 3); }

struct Unit { int pm, pn, row0; const char* a; const char* b; };
struct Order {
    int nM, nN, nwg, G, c, atile0, otile0, etile0;
    const char* A; const char* Bt; size_t tstep, estride;
    int tb[8];
    DI bool next(int i, Unit& u) const {
        const long L = (long)i * G + c; if (L >= nwg) return false;
        int wgid = (int)L; { const int q = nwg / NXCD, r = nwg % NXCD, xcd = wgid % NXCD, off = wgid / NXCD; wgid = (xcd < r ? xcd * (q + 1) : r * (q + 1) + (xcd - r) * q) + off; }
        const int nig = WGM * nN, gid = wgid / nig, fm = gid * WGM, gsz = (nM - fm) < WGM ? (nM - fm) : WGM;
        u.pm = fm + ((wgid % nig) % gsz); u.pn = (wgid % nig) / gsz;
        u.row0 = (otile0 + u.pm) * BM;
        int e = 0;
        if (estride) { const int t = etile0 + u.pm;
#pragma unroll
            for (int j = 1; j < 8; ++j) e += (t >= tb[j]) ? 1 : 0; }
        u.a = A + (size_t)(atile0 + u.pm) * tstep; u.b = Bt + (size_t)e * estride + (size_t)u.pn * tstep;
        return true;
    }
};

template <class Epi>
DI void gemm_phase(LAS unsigned char* lds, const int K, const Order& S, const Epi& E, const int wid) {
    int lane = lane_id(); asm volatile("" : "+v"(lane));
    const int tid = wid * 64 + lane, wr = wid >> 2, wc = wid & 3, fr = lane & 15, fq = lane >> 4;
    const int nt = K / BK;
    unsigned voffA[2], voffB[2];
#pragma unroll
    for (int i = 0; i < 2; ++i) { int R, C; stage_rc(tid * 16 + i * 8192, R, C); const int Rb = (R & ~31) + perm32(R & 31);
        voffA[i] = (unsigned)(R * K + C) * 2u; voffB[i] = (unsigned)(Rb * K + C) * 2u; }
    const size_t kstep = (size_t)(BK * 2);
    const size_t hstep = (size_t)HALF * K * 2;
    const unsigned ldsw = (unsigned)wid * 1024u;
    const int aoff = lds_byte(wr * 64 + fr, fq * 8), boff = lds_byte(wc * 32 + fr, fq * 8);
#define PG8_SA(b, h) (((b) * 2 + (h)) * HTB)
#define PG8_SB(b, h) ((4 + (b) * 2 + (h)) * HTB)
#define PG8_STAGE(bufoff, gbase, voff) do { _Pragma("unroll") for (int _i = 0; _i < 2; ++_i) \
        __builtin_amdgcn_global_load_lds((const unsigned*)((const char*)(gbase) + (voff)[_i]), (LAS unsigned*)(lds + (bufoff) + ldsw + _i * 8192), 16, 0, 0); } while (0)
#define PG8_LDA(dst, b, h) do { _Pragma("unroll") for (int m = 0; m < 4; ++m) _Pragma("unroll") for (int k = 0; k < 2; ++k) dst[m][k] = *(const LAS bf16x8*)(lds + PG8_SA(b, h) + aoff + m * 2048 + k * 1024); } while (0)
#define PG8_LDB(dst, b, h) do { _Pragma("unroll") for (int n = 0; n < 2; ++n) _Pragma("unroll") for (int k = 0; k < 2; ++k) dst[n][k] = *(const LAS bf16x8*)(lds + PG8_SB(b, h) + boff + n * 2048 + k * 1024); } while (0)
#define PG8_MMA(ai, bj, At, Bt) do { __builtin_amdgcn_s_setprio(1); _Pragma("unroll") for (int m = 0; m < 4; ++m) _Pragma("unroll") for (int n = 0; n < 2; ++n) _Pragma("unroll") for (int k = 0; k < 2; ++k) \
        acc[ai][bj][m][n] = __builtin_amdgcn_mfma_f32_16x16x32_bf16(Bt[n][k], At[m][k], acc[ai][bj][m][n], 0, 0, 0); __builtin_amdgcn_s_setprio(0); } while (0)
#define PG8_WAIT_V(n) asm volatile("s_waitcnt vmcnt(" #n ")" ::: "memory")
#define PG8_WAIT_L(n) asm volatile("s_waitcnt lgkmcnt(" #n ")" ::: "memory")
#define PG8_BAR __builtin_amdgcn_s_barrier()
#define PG8_SCHED __builtin_amdgcn_sched_barrier(0)
    Unit cur, nxt; int ui = 0;
    if (!S.next(0, cur)) return;
    f32x4 acc[2][2][4][2];
#pragma unroll
    for (int a = 0; a < 2; ++a)
#pragma unroll
        for (int b = 0; b < 2; ++b)
#pragma unroll
            for (int m = 0; m < 4; ++m)
#pragma unroll
                for (int n = 0; n < 2; ++n) acc[a][b][m][n] = (f32x4){0.f, 0.f, 0.f, 0.f};
    bf16x8 At[4][2], B0[2][2], B1[2][2];
    const char* cA = cur.a; const char* cB = cur.b;
    PG8_STAGE(PG8_SB(0, 0), cB, voffB); PG8_STAGE(PG8_SB(0, 1), cB + hstep, voffB); PG8_STAGE(PG8_SA(0, 0), cA, voffA); PG8_STAGE(PG8_SA(0, 1), cA + hstep, voffA);
    if (wr == 1) PG8_BAR;
    PG8_WAIT_V(2); PG8_BAR;
    PG8_STAGE(PG8_SB(1, 0), cB + kstep, voffB); PG8_STAGE(PG8_SA(1, 0), cA + kstep, voffA); PG8_STAGE(PG8_SB(1, 1), cB + hstep + kstep, voffB);
    PG8_WAIT_V(6); PG8_BAR;
    for (;;) {
        const bool has_next = S.next(ui + 1, nxt);
        const char* nA = has_next ? nxt.a : cA; const char* nB = has_next ? nxt.b : cB;
        for (int t = 0; t < nt; t += 2) {
            const bool last = (t == nt - 2);
            const char* a1 = cA + (size_t)(t + 1) * kstep;
            const char* a2 = last ? nA : cA + (size_t)(t + 2) * kstep; const char* b2 = last ? nB : cB + (size_t)(t + 2) * kstep;
            const char* a3 = a2 + kstep; const char* b3 = b2 + kstep;
            PG8_LDB(B0, 0, 0); PG8_LDB(B1, 0, 1); PG8_SCHED; PG8_LDA(At, 0, 0); PG8_STAGE(PG8_SA(1, 1), a1 + hstep, voffA);
            PG8_WAIT_V(8); PG8_WAIT_L(0); PG8_BAR; PG8_MMA(0, 0, At, B0); PG8_MMA(0, 1, At, B1); PG8_BAR; PG8_SCHED;
            PG8_LDA(At, 0, 1); PG8_STAGE(PG8_SB(0, 0), b2, voffB); PG8_STAGE(PG8_SB(0, 1), b2 + hstep, voffB); PG8_STAGE(PG8_SA(0, 0), a2, voffA);
            PG8_WAIT_V(8); PG8_WAIT_L(0); PG8_BAR; PG8_MMA(1, 0, At, B0); PG8_MMA(1, 1, At, B1); PG8_BAR; PG8_SCHED;
            PG8_LDB(B0, 1, 0); PG8_LDB(B1, 1, 1); PG8_SCHED; PG8_LDA(At, 1, 0); PG8_STAGE(PG8_SA(0, 1), a2 + hstep, voffA);
            PG8_WAIT_V(8); PG8_WAIT_L(0); PG8_BAR; PG8_MMA(0, 0, At, B0); PG8_MMA(0, 1, At, B1); PG8_BAR; PG8_SCHED;
            PG8_LDA(At, 1, 1); PG8_STAGE(PG8_SB(1, 0), b3, voffB); PG8_STAGE(PG8_SB(1, 1), b3 + hstep, voffB); PG8_STAGE(PG8_SA(1, 0), a3, voffA);
            PG8_WAIT_V(8); PG8_WAIT_L(0); PG8_BAR; PG8_MMA(1, 0, At, B0); PG8_MMA(1, 1, At, B1); PG8_BAR; PG8_SCHED;
        }
        if (wr == 0) PG8_BAR;
        E(acc, cur, wr, wc, fr, fq);
        if (!has_next) break;
#pragma unroll
        for (int a = 0; a < 2; ++a)
#pragma unroll
            for (int b = 0; b < 2; ++b)
#pragma unroll
                for (int m = 0; m < 4; ++m)
#pragma unroll
                    for (int n = 0; n < 2; ++n) acc[a][b][m][n] = (f32x4){0.f, 0.f, 0.f, 0.f};
        cur = nxt; cA = nA; cB = nB; ++ui;
        if (wr == 1) PG8_BAR;
    }
    PG8_WAIT_V(0);
    PG8_BAR;
#undef PG8_SA
#undef PG8_SB
#undef PG8_STAGE
#undef PG8_LDA
#undef PG8_LDB
#undef PG8_MMA
#undef PG8_WAIT_V
#undef PG8_WAIT_L
#undef PG8_BAR
#undef PG8_SCHED
}

DI u32x4 pack8(const f32x4 a, const f32x4 b) { u32x4 w; w.x = pk2(a[0], a[1]); w.y = pk2(a[2], a[3]); w.z = pk2(b[0], b[1]); w.w = pk2(b[2], b[3]); return w; }

struct EpiPlain {
    bf16* O; int ldc;
    DI void operator()(const f32x4 (&acc)[2][2][4][2], const Unit& u, int wr, int wc, int fr, int fq) const {
        asm volatile("" : "+v"(fr), "+v"(fq));
        const int row0 = u.row0 + wr * 64 + fr, col0 = u.pn * BM + wc * 32 + 8 * fq;
#pragma unroll
        for (int ai = 0; ai < 2; ++ai)
#pragma unroll
            for (int m = 0; m < 4; ++m) { bf16* rowp = O + (size_t)(row0 + ai * HALF + m * 16) * ldc + col0;
#pragma unroll
                for (int bj = 0; bj < 2; ++bj) *(u32x4*)(rowp + bj * HALF) = pack8(acc[ai][bj][m][0], acc[ai][bj][m][1]); }
    }
};
template <int ACT> struct EpiPair {
    bf16* O; int ldc;
    DI void operator()(const f32x4 (&acc)[2][2][4][2], const Unit& u, int wr, int wc, int fr, int fq) const {
        asm volatile("" : "+v"(fr), "+v"(fq));
        const int row0 = u.row0 + wr * 64 + fr, col0 = u.pn * HALF + wc * 32 + 8 * fq;
#pragma unroll
        for (int ai = 0; ai < 2; ++ai)
#pragma unroll
            for (int m = 0; m < 4; ++m) {
                f32x4 o[2];
#pragma unroll
                for (int n = 0; n < 2; ++n) { const f32x4 a = acc[ai][0][m][n], b = acc[ai][1][m][n];
#pragma unroll
                    for (int j = 0; j < 4; ++j) o[n][j] = (ACT == 0) ? a[j] * sigmoidf_(a[j]) * b[j] : a[j] * sigmoidf_(b[j]); }
                *(u32x4*)(O + (size_t)(row0 + ai * HALF + m * 16) * ldc + col0) = pack8(o[0], o[1]); }
    }
};
struct EpiWin {
    bf16 *Q, *Kb, *Vb, *ZU, *ZV; const float *cosT, *sinT, *lng, *lnb;
    DI void operator()(const f32x4 (&acc)[2][2][4][2], const Unit& u, int wr, int wc, int fr, int fq) const {
        asm volatile("" : "+v"(fr), "+v"(fq));
        const int rbase = u.row0 + wr * 64 + fr, pn = u.pn;
        if (pn < 2 || (pn == 2 && wc < 2)) {
            bf16* dst; int ld, colb; float sc;
            if (pn < 2) { dst = Q; ld = 512; colb = 64 * (4 * pn + wc); sc = QSCALE; } else { dst = Kb; ld = 128; colb = 64 * wc; sc = 1.0f; }
#pragma unroll
            for (int ai = 0; ai < 2; ++ai)
#pragma unroll
                for (int m = 0; m < 4; ++m) { int row = rbase + ai * HALF + m * 16; asm volatile("" : "+v"(row) :: "memory"); const int pos = row & (SEQ - 1);
                    f32x4 o1[2], o2[2];
#pragma unroll
                    for (int n = 0; n < 2; ++n) { const f32x4 c = *(const f32x4*)(cosT + pos * 32 + 8 * fq + 4 * n), s = *(const f32x4*)(sinT + pos * 32 + 8 * fq + 4 * n);
                        const f32x4 x1 = acc[ai][0][m][n], x2 = acc[ai][1][m][n];
                        o1[n] = (x1 * c - x2 * s) * sc; o2[n] = (x2 * c + x1 * s) * sc; }
                    bf16* rp = dst + (size_t)row * ld + colb + 8 * fq;
                    *(u32x4*)(rp) = pack8(o1[0], o1[1]); *(u32x4*)(rp + 32) = pack8(o2[0], o2[1]); asm volatile("" ::: "memory"); }
        } else if (pn == 2) {
#pragma unroll
            for (int ai = 0; ai < 2; ++ai)
#pragma unroll
                for (int m = 0; m < 4; ++m) { int row = rbase + ai * HALF + m * 16; asm volatile("" : "+v"(row) :: "memory"); bf16* rp = Vb + (size_t)row * 128 + 64 * (wc - 2) + 8 * fq;
#pragma unroll
                    for (int bj = 0; bj < 2; ++bj) *(u32x4*)(rp + 32 * bj) = pack8(acc[ai][bj][m][0], acc[ai][bj][m][1]); }
        } else if (pn < 5) {
#pragma unroll
            for (int ai = 0; ai < 2; ++ai)
#pragma unroll
                for (int m = 0; m < 4; ++m) { int row = rbase + ai * HALF + m * 16; asm volatile("" : "+v"(row) :: "memory"); bf16* rp = ZU + (size_t)row * 512 + 256 * (pn - 3) + 64 * wc + 8 * fq;
#pragma unroll
                    for (int bj = 0; bj < 2; ++bj) { f32x4 a = acc[ai][bj][m][0], b = acc[ai][bj][m][1];
#pragma unroll
                        for (int j = 0; j < 4; ++j) { a[j] = gelu_tanh(a[j]); b[j] = gelu_tanh(b[j]); }
                        *(u32x4*)(rp + 32 * bj) = pack8(a, b); } }
        } else {
            const int gi = 4 * (pn - 5) + wc;
            f32x4 gg[2][2], bb[2][2];
#pragma unroll
            for (int bj = 0; bj < 2; ++bj)
#pragma unroll
                for (int n = 0; n < 2; ++n) { gg[bj][n] = *(const f32x4*)(lng + gi * 64 + 32 * bj + 8 * fq + 4 * n); bb[bj][n] = *(const f32x4*)(lnb + gi * 64 + 32 * bj + 8 * fq + 4 * n); }
#pragma unroll
            for (int ai = 0; ai < 2; ++ai)
#pragma unroll
                for (int m = 0; m < 4; ++m) { int row = rbase + ai * HALF + m * 16; asm volatile("" : "+v"(row) :: "memory");
                    f32x4 z[2][2]; float s = 0.f;
#pragma unroll
                    for (int bj = 0; bj < 2; ++bj)
#pragma unroll
                        for (int n = 0; n < 2; ++n) {
#pragma unroll
                            for (int j = 0; j < 4; ++j) { z[bj][n][j] = gelu_tanh(acc[ai][bj][m][n][j]); s += z[bj][n][j]; } }
                    s += swz16_f(s); s = sum_x32(s);
                    const float mean = s * (1.0f / 64.0f); float q = 0.f;
#pragma unroll
                    for (int bj = 0; bj < 2; ++bj)
#pragma unroll
                        for (int n = 0; n < 2; ++n) { z[bj][n] = z[bj][n] - mean; q += (z[bj][n][0] * z[bj][n][0] + z[bj][n][1] * z[bj][n][1]) + (z[bj][n][2] * z[bj][n][2] + z[bj][n][3] * z[bj][n][3]); }
                    q += swz16_f(q); q = sum_x32(q);
                    const float rstd = 1.0f / sqrtf(q * (1.0f / 64.0f) + LN_EPS);
                    bf16* rp = ZV + (size_t)row * 512 + 64 * gi + 8 * fq;
#pragma unroll
                    for (int bj = 0; bj < 2; ++bj) *(u32x4*)(rp + 32 * bj) = pack8(z[bj][0] * rstd * gg[bj][0] + bb[bj][0], z[bj][1] * rstd * gg[bj][1] + bb[bj][1]); asm volatile("" ::: "memory"); }
        }
    }
};
}

#define XB_TMO      128
#define XB_XCNT(j)  (256  + 64 * (j))
#define XB_XSUB(j)  (1280 + 64 * (j))
#define XB_XGEN(j)  (2304 + 64 * (j))
#define XB_TOP      3328
#define XB_TOPGEN   3392
#define XCD_BAR_WORDS 3456
#define XB_SPIN_CAP (1u << 22)
DI unsigned xb_ld(unsigned* p)              { return __hip_atomic_load(p, __ATOMIC_RELAXED, __HIP_MEMORY_SCOPE_AGENT); }
DI unsigned xb_add(unsigned* p, unsigned v) { return __hip_atomic_fetch_add(p, v, __ATOMIC_RELAXED, __HIP_MEMORY_SCOPE_AGENT); }
DI unsigned xb_xcc_id() { return (unsigned)__builtin_amdgcn_s_getreg((3 << 11) | 20) & 0xFu; }
#define XB_SPIN(cond, bar) do { unsigned _sp = 0; while (cond) { __builtin_amdgcn_s_sleep(1); \
    if ((++_sp & 255u) == 0u) { if (xb_ld(&(bar)[XB_TMO])) break; if (_sp > XB_SPIN_CAP) { atomicAdd(&(bar)[XB_TMO], 1u); break; } } } } while (0)
struct XcdBarrier { unsigned* bar; unsigned x; volatile LAS unsigned* st; };
DI XcdBarrier xcd_barrier_post(unsigned* bar, volatile LAS unsigned* st, bool leader) {
    XcdBarrier b; b.bar = bar; b.x = xb_xcc_id(); b.st = st;
    if (leader) (void)xb_add(&bar[XB_XCNT(b.x)], 1u);
    return b;
}
DI void xcd_barrier_complete(unsigned* bar, unsigned x, unsigned& nloc, unsigned& nx) {
    const unsigned G = gridDim.x * gridDim.y * gridDim.z;
    unsigned sum, cnt, mine, sp = 0u;
    for (;;) {
        sum = 0u; cnt = 0u; mine = 0u;
#pragma unroll
        for (unsigned j = 0; j < 16; ++j) { const unsigned c = xb_ld(&bar[XB_XCNT(j)]); sum += c; cnt += (c > 0u) ? 1u : 0u; mine = (j == x) ? c : mine; }
        if (sum == G) break;
        __builtin_amdgcn_s_sleep(1);
        if ((++sp & 255u) == 0u) { if (xb_ld(&bar[XB_TMO])) break; if (sp > XB_SPIN_CAP) { atomicAdd(&bar[XB_TMO], 1u); break; } }
    }
    nloc = mine > 0u ? mine : 1u; nx = cnt > 0u ? cnt : 1u;
}
DI void xcd_barrier(const XcdBarrier& b, int wave) {
    asm volatile("s_waitcnt vmcnt(0)" ::: "memory");
    __syncthreads();
    if (wave == 0 && lane_id() == 0) {
        unsigned* bar = b.bar; unsigned bx = b.x; asm volatile("" : "+s"(bar), "+s"(bx));
        __builtin_amdgcn_s_waitcnt(0);
        unsigned nloc = b.st[0], nx = b.st[1];
        if (nloc == 0u) { xcd_barrier_complete(bar, bx, nloc, nx); b.st[0] = nloc; b.st[1] = nx; }
        const unsigned old = xb_add(&bar[XB_XSUB(bx)], 1u);
        const unsigned gen = old / nloc;
        if (old + 1u == (gen + 1u) * nloc) {
            __builtin_amdgcn_fence(__ATOMIC_RELEASE, "agent");
            asm volatile("s_waitcnt vmcnt(0)" ::: "memory");
            const unsigned og = xb_add(&bar[XB_TOP], 1u);
            const unsigned tg = og / nx;
            if (og + 1u == (tg + 1u) * nx) xb_add(&bar[XB_TOPGEN], 1u);
            else XB_SPIN(xb_ld(&bar[XB_TOPGEN]) == tg, bar);
            __builtin_amdgcn_fence(__ATOMIC_ACQUIRE, "agent");
            xb_add(&bar[XB_XGEN(bx)], 1u);
            asm volatile("s_waitcnt vmcnt(0)" ::: "memory");
        } else {
            XB_SPIN(xb_ld(&bar[XB_XGEN(bx)]) == gen, bar);
            __builtin_amdgcn_fence(__ATOMIC_ACQUIRE, "agent");
            asm volatile("s_waitcnt vmcnt(0)" ::: "memory");
        }
    }
    __syncthreads();
}

struct Frame {
    LAS unsigned char* lds;
    volatile LAS unsigned* MISC;
    unsigned* ctl;
    int tid, lane, wave, G, bid;
    unsigned char* ws;
    float* out;
};
struct Args { const float* in[27]; float* out; unsigned char* ws; };
typedef const unsigned char __attribute__((address_space(4)))* kptr_t;
DI const float* in_ptr(int k) { kptr_t p = (kptr_t)__builtin_amdgcn_kernarg_segment_ptr(); asm volatile("" : "+s"(p)); return *(const float* const __attribute__((address_space(4)))*)(p + 8 * k); }
struct ArgsRef { struct Acc { DI const float* operator[](int k) const { return in_ptr(k); } } in; };

DI void conv_item(const float* W, int ldw, int k0, int c0, bf16* drow0, int K, LAS float* scr, int lane) {
#pragma unroll 8
    for (int i = 0; i < 32; ++i) { const int kk = 2 * i + (lane >> 5); scr[kk * 33 + (lane & 31)] = W[(size_t)(k0 + kk) * ldw + c0 + (lane & 31)]; }
    LDS_WAIT();
    const int c = lane & 7;
#pragma unroll
    for (int j = 0; j < 4; ++j) { const int n = (lane >> 3) + 8 * j; const LAS float* s = scr + (8 * c) * 33 + n;
        u32x4 o; o.x = pk2(s[0 * 33], s[1 * 33]); o.y = pk2(s[2 * 33], s[3 * 33]); o.z = pk2(s[4 * 33], s[5 * 33]); o.w = pk2(s[6 * 33], s[7 * 33]);
        *(u32x4*)(drow0 + (size_t)n * K + k0 + 8 * c) = o; }
    LDS_WAIT();
}
template <int MAP>
DI void conv_job(Frame& F, const float* s1, const float* s2, bf16* dst, int K, int ldw, int nblk, int nexp) {
    LAS float* scr = (LAS float*)(F.lds + F.wave * 16384);
    const int gw = F.bid * NWAVES + F.wave, NGW = F.G * NWAVES;
    const int per = (K / 64) * nblk, total = per * nexp;
    for (int it = gw; it < total; it += NGW) {
        const int e = it / per, r = it - e * per, kb = r / nblk, nb = r - kb * nblk;
        const float* src = s1; int c0;
        if (MAP == 0) c0 = 32 * nb;
        else { const int pn = nb >> 3, bj = (nb >> 2) & 1, wc = nb & 3;
            if (MAP == 1) c0 = 256 * pn + 64 * wc + 32 * bj; else { c0 = 128 * pn + 32 * wc; if (bj) src = s2; } }
        conv_item(src + (size_t)e * K * ldw, ldw, 64 * kb, c0, dst + ((size_t)e * nblk * 32 + (size_t)nb * 32) * K, K, scr, F.lane);
    }
}
DI void conv_layer(Frame& F, const ArgsRef& a, int L) {
    FRESH(F);
    bf16* Wb = (bf16*)(F.ws + WS_W);
    const int i = L >> 1;
    if ((L & 1) == 0) {
        conv_job<1>(F, a.in[3] + (size_t)i * D * INW, nullptr, (bf16*)((char*)Wb + W_IN), D, INW, INW / 32, 1);
        conv_job<0>(F, a.in[9] + (size_t)i * D * D, nullptr, (bf16*)((char*)Wb + W_OUT), D, D, D / 32, 1);
        conv_job<2>(F, a.in[10] + (size_t)i * D * FF, a.in[11] + (size_t)i * D * FF, (bf16*)((char*)Wb + W_GU), D, FF, 2 * FF / 32, 1);
        conv_job<0>(F, a.in[12] + (size_t)i * FF * D, nullptr, (bf16*)((char*)Wb + W_DN), FF, D, D / 32, 1);
        const float* sw = a.in[5] + (size_t)i * 8 * 128 * 128; bf16* dw = (bf16*)(F.ws + WS_SGUW);
        for (int idx = F.bid * 512 + F.tid; idx < 8 * 128 * 128 / 4; idx += F.G * 512) { const f32x4 v = *(const f32x4*)(sw + 4 * idx); u32x2 o; o.x = pk2(v[0], v[1]); o.y = pk2(v[2], v[3]); *(u32x2*)(dw + 4 * idx) = o; }
    } else {
        conv_job<2>(F, a.in[21] + (size_t)i * D * D, a.in[22] + (size_t)i * D * D, (bf16*)((char*)Wb + W_GLU), D, D, 2 * D / 32, 1);
        conv_job<2>(F, a.in[24] + (size_t)i * NE * D * FF, a.in[25] + (size_t)i * NE * D * FF, (bf16*)((char*)Wb + W_MGU), D, FF, 2 * FF / 32, NE);
        conv_job<0>(F, a.in[26] + (size_t)i * NE * FF * D, nullptr, (bf16*)((char*)Wb + W_MDN), FF, D, D / 32, NE);
    }
}

DI void prologue(Frame& F, const ArgsRef& a) {
    FRESH(F);
    const float* x = a.in[0]; bf16* XB = (bf16*)(F.ws + WS_XB);
    const size_t nthr = (size_t)F.G * 512, t0 = (size_t)F.bid * 512 + F.tid;
    for (size_t i = t0; i < (size_t)T * D / 8; i += nthr) { const f32x4 v0 = *(const f32x4*)(x + 8 * i), v1 = *(const f32x4*)(x + 8 * i + 4); *(u32x4*)(XB + 8 * i) = pg8::pack8(v0, v1); }
    float* cosT = (float*)(F.ws + WS_ROPE); float* sinT = cosT + SEQ * 32;
    for (size_t i = t0; i < (size_t)SEQ * 32; i += nthr) { const int pos = (int)(i >> 5), d = (int)(i & 31);
        const float invf = (float)exp_d(-(double)(2 * d) * (9.2103403719761836 / 64.0));
        const float ang = (float)pos * invf; double s, c; sincos_d((double)ang, s, c); cosT[i] = (float)c; sinT[i] = (float)s; }
}

DI void ln_core(f32x4 (&v)[4], const f32x4 (&g)[4], const f32x4 (&b)[4]) {
    float s = 0.f;
#pragma unroll
    for (int j = 0; j < 4; ++j) s += (v[j][0] + v[j][1]) + (v[j][2] + v[j][3]);
    const float mean = wave_sum(s) * (1.0f / D); float q = 0.f;
#pragma unroll
    for (int j = 0; j < 4; ++j) { v[j] = v[j] - mean; q += (v[j][0] * v[j][0] + v[j][1] * v[j][1]) + (v[j][2] * v[j][2] + v[j][3] * v[j][3]); }
    const float rstd = 1.0f / sqrtf(wave_sum(q) * (1.0f / D) + LN_EPS);
#pragma unroll
    for (int j = 0; j < 4; ++j) v[j] = v[j] * rstd * g[j] + b[j];
}
DI void ln_store(const f32x4 (&v)[4], float* X, bf16* XB, size_t row, int lane) {
#pragma unroll
    for (int j = 0; j < 4; ++j) { *(f32x4*)(X + row * D + 4 * lane + 256 * j) = v[j]; u32x2 o; o.x = pk2(v[j][0], v[j][1]); o.y = pk2(v[j][2], v[j][3]); *(u32x2*)(XB + row * D + 4 * lane + 256 * j) = o; }
}
DI void ln_pass_plain(Frame& F, const float* xin, const float* g_, const float* b_) {
    FRESH(F);
    const bf16* Y = (const bf16*)(F.ws + WS_Y); bf16* XB = (bf16*)(F.ws + WS_XB); float* X = F.out;
    f32x4 g[4], b[4];
#pragma unroll
    for (int j = 0; j < 4; ++j) { g[j] = *(const f32x4*)(g_ + 4 * F.lane + 256 * j); b[j] = *(const f32x4*)(b_ + 4 * F.lane + 256 * j); }
    const int gw = F.bid * NWAVES + F.wave, NGW = F.G * NWAVES;
    for (int row = gw; row < T; row += NGW) {
        f32x4 v[4];
#pragma unroll
        for (int j = 0; j < 4; ++j) { const f32x4 xv = *(const f32x4*)(xin + (size_t)row * D + 4 * F.lane + 256 * j); const u32x2 yv = *(const u32x2*)(Y + (size_t)row * D + 4 * F.lane + 256 * j);
            v[j][0] = ALPHA * xv[0] + bf_lo(yv.x); v[j][1] = ALPHA * xv[1] + bf_hi(yv.x); v[j][2] = ALPHA * xv[2] + bf_lo(yv.y); v[j][3] = ALPHA * xv[3] + bf_hi(yv.y); }
        ln_core(v, g, b);
        ln_store(v, X, XB, (size_t)row, F.lane);
    }
}
DI void ln_pass_router(Frame& F, const float* g_, const float* b_, const float* rw_, unsigned* cnt) {
    FRESH(F);
    const bf16* Y = (const bf16*)(F.ws + WS_Y); bf16* XB = (bf16*)(F.ws + WS_XB); float* X = F.out;
    i32x4* RECI = (i32x4*)(F.ws + WS_RECI); f32x2* RECW = (f32x2*)(F.ws + WS_RECW);
    LAS int* lcnt = (LAS int*)(F.lds); LAS int* lbase = lcnt + 8;
    LAS int* re0 = lcnt + 64; LAS int* re1 = re0 + 256; LAS int* rp0 = re1 + 256; LAS int* rp1 = rp0 + 256; LAS float* rw0 = (LAS float*)(rp1 + 256); LAS float* rw1 = rw0 + 256;
    f32x4 g[4], b[4];
#pragma unroll
    for (int j = 0; j < 4; ++j) { g[j] = *(const f32x4*)(g_ + 4 * F.lane + 256 * j); b[j] = *(const f32x4*)(b_ + 4 * F.lane + 256 * j); }
    f32x4 rwa[4][4], rwb[4][4];
#pragma unroll
    for (int j = 0; j < 4; ++j)
#pragma unroll
        for (int c = 0; c < 4; ++c) { const float* p = rw_ + (size_t)(4 * F.lane + 256 * j + c) * 8; rwa[j][c] = *(const f32x4*)p; rwb[j][c] = *(const f32x4*)(p + 4); }
    for (int pnl = F.bid; pnl < T / 256; pnl += F.G) {
        if (F.tid < 8) lcnt[F.tid] = 0;
        __syncthreads();
        for (int rr = 0; rr < 32; ++rr) {
            const int lr = F.wave + 8 * rr; const size_t row = (size_t)pnl * 256 + lr;
            f32x4 v[4];
#pragma unroll
            for (int j = 0; j < 4; ++j) { const f32x4 xv = *(const f32x4*)(X + row * D + 4 * F.lane + 256 * j); const u32x2 yv = *(const u32x2*)(Y + row * D + 4 * F.lane + 256 * j);
                v[j][0] = ALPHA * xv[0] + bf_lo(yv.x); v[j][1] = ALPHA * xv[1] + bf_hi(yv.x); v[j][2] = ALPHA * xv[2] + bf_lo(yv.y); v[j][3] = ALPHA * xv[3] + bf_hi(yv.y); }
            ln_core(v, g, b);
            ln_store(v, X, XB, row, F.lane);
            f32x4 la = {0.f, 0.f, 0.f, 0.f}, lb = {0.f, 0.f, 0.f, 0.f};
#pragma unroll
            for (int j = 0; j < 4; ++j)
#pragma unroll
                for (int c = 0; c < 4; ++c) { la += rwa[j][c] * v[j][c]; lb += rwb[j][c] * v[j][c]; }
            float lg[8];
#pragma unroll
            for (int e = 0; e < 4; ++e) { lg[e] = wave_sum(la[e]); lg[4 + e] = wave_sum(lb[e]); }
            int i0 = 0; float l0 = lg[0];
#pragma unroll
            for (int e = 1; e < 8; ++e) if (lg[e] > l0) { l0 = lg[e]; i0 = e; }
            int i1 = -1; float l1 = -3.0e38f;
#pragma unroll
            for (int e = 0; e < 8; ++e) if (e != i0 && lg[e] > l1) { l1 = lg[e]; i1 = e; }
            const float w0 = 1.0f / (1.0f + __expf(l1 - l0)), w1 = 1.0f - w0;
            if (F.lane == 0) { const int p0 = atomicAdd((int*)(lcnt + i0), 1), p1 = atomicAdd((int*)(lcnt + i1), 1);
                re0[lr] = i0; re1[lr] = i1; rp0[lr] = p0; rp1[lr] = p1; rw0[lr] = w0; rw1[lr] = w1; }
        }
        __syncthreads();
        if (F.tid < 8) lbase[F.tid] = (int)xb_add(cnt + F.tid, (unsigned)lcnt[F.tid]);
        __syncthreads();
        if (F.tid < 256) { const int e0 = re0[F.tid], e1 = re1[F.tid]; const size_t row = (size_t)pnl * 256 + F.tid;
            RECI[row] = (i32x4){e0, lbase[e0] + rp0[F.tid], e1, lbase[e1] + rp1[F.tid]}; RECW[row] = (f32x2){rw0[F.tid], rw1[F.tid]}; }
        __syncthreads();
    }
}
DI void moe_tiles(const unsigned* cnt, int (&tb)[9], int (&cn)[8]) {
    int acc = 0;
#pragma unroll
    for (int e = 0; e < 8; ++e) { cn[e] = __builtin_amdgcn_readfirstlane((int)__hip_atomic_load(cnt + e, __ATOMIC_RELAXED, __HIP_MEMORY_SCOPE_AGENT)); tb[e] = acc; acc += (cn[e] + 255) >> 8; }
    tb[8] = acc;
}
DI void moe_gather(Frame& F, const unsigned* cnt) {
    FRESH(F);
    int tb[9], cn[8]; moe_tiles(cnt, tb, cn);
    const bf16* XB = (const bf16*)(F.ws + WS_XB); bf16* XS = (bf16*)(F.ws + WS_XS); const i32x4* RECI = (const i32x4*)(F.ws + WS_RECI);
    const int gw = F.bid * NWAVES + F.wave, NGW = F.G * NWAVES;
    for (int t = gw; t < T; t += NGW) {
        const i32x4 r = RECI[t];
        int b0 = 0, b1 = 0;
#pragma unroll
        for (int e = 0; e < 8; ++e) { b0 = (r[0] == e) ? tb[e] : b0; b1 = (r[2] == e) ? tb[e] : b1; }
        const size_t r0 = (size_t)b0 * 256 + r[1], r1 = (size_t)b1 * 256 + r[3];
        const u32x4 v0 = *(const u32x4*)(XB + (size_t)t * D + 8 * F.lane), v1 = *(const u32x4*)(XB + (size_t)t * D + 512 + 8 * F.lane);
        *(u32x4*)(XS + r0 * D + 8 * F.lane) = v0; *(u32x4*)(XS + r0 * D + 512 + 8 * F.lane) = v1;
        *(u32x4*)(XS + r1 * D + 8 * F.lane) = v0; *(u32x4*)(XS + r1 * D + 512 + 8 * F.lane) = v1;
    }
#pragma unroll
    for (int e = 0; e < 8; ++e) { const int first = tb[e] * 256 + cn[e], last = tb[e + 1] * 256;
        for (int r = first + gw; r < last; r += NGW) { const u32x4 z = {0u, 0u, 0u, 0u}; *(u32x4*)(XS + (size_t)r * D + 8 * F.lane) = z; *(u32x4*)(XS + (size_t)r * D + 512 + 8 * F.lane) = z; } }
}
DI void ln_pass_combine(Frame& F, const float* g_, const float* b_, const unsigned* cnt) {
    FRESH(F);
    int tb[9], cn[8]; moe_tiles(cnt, tb, cn);
    const bf16* YS = (const bf16*)(F.ws + WS_YS); bf16* XB = (bf16*)(F.ws + WS_XB); float* X = F.out;
    const i32x4* RECI = (const i32x4*)(F.ws + WS_RECI); const f32x2* RECW = (const f32x2*)(F.ws + WS_RECW);
    f32x4 g[4], b[4];
#pragma unroll
    for (int j = 0; j < 4; ++j) { g[j] = *(const f32x4*)(g_ + 4 * F.lane + 256 * j); b[j] = *(const f32x4*)(b_ + 4 * F.lane + 256 * j); }
    const int gw = F.bid * NWAVES + F.wave, NGW = F.G * NWAVES;
    for (int row = gw; row < T; row += NGW) {
        const i32x4 r = RECI[row]; const f32x2 w = RECW[row];
        int b0 = 0, b1 = 0;
#pragma unroll
        for (int e = 0; e < 8; ++e) { b0 = (r[0] == e) ? tb[e] : b0; b1 = (r[2] == e) ? tb[e] : b1; }
        const size_t r0 = (size_t)b0 * 256 + r[1], r1 = (size_t)b1 * 256 + r[3];
        f32x4 v[4];
#pragma unroll
        for (int j = 0; j < 4; ++j) { const f32x4 xv = *(const f32x4*)(X + (size_t)row * D + 4 * F.lane + 256 * j);
            const u32x2 ya = *(const u32x2*)(YS + r0 * D + 4 * F.lane + 256 * j), yb = *(const u32x2*)(YS + r1 * D + 4 * F.lane + 256 * j);
            v[j][0] = ALPHA * xv[0] + (w[0] * bf_lo(ya.x) + w[1] * bf_lo(yb.x)); v[j][1] = ALPHA * xv[1] + (w[0] * bf_hi(ya.x) + w[1] * bf_hi(yb.x));
            v[j][2] = ALPHA * xv[2] + (w[0] * bf_lo(ya.y) + w[1] * bf_lo(yb.y)); v[j][3] = ALPHA * xv[3] + (w[0] * bf_hi(ya.y) + w[1] * bf_hi(yb.y)); }
        ln_core(v, g, b);
        ln_store(v, X, XB, (size_t)row, F.lane);
    }
}

constexpr int KL_STRIDE = 144, VT_STRIDE = 776, VT_OFF = 384 * KL_STRIDE;
DI void attn_phase(Frame& F, const float* sink) {
    FRESH(F);
    const bf16* Q = (const bf16*)(F.ws + WS_Q); const bf16* Kb = (const bf16*)(F.ws + WS_K); const bf16* Vb = (const bf16*)(F.ws + WS_V); bf16* MIX = (bf16*)(F.ws + WS_MIX);
    LAS unsigned char* Kl = F.lds; LAS unsigned char* Vt = F.lds + VT_OFF;
    const int lane = F.lane, l31 = lane & 31, h = lane >> 5, w = F.wave;
    for (int unit = F.bid; unit < BATCH * 2 * 16; unit += F.G) {
        const int b = unit >> 5, kvh = (unit >> 4) & 1, n = unit & 15;
        __syncthreads();
        for (int idx = F.tid; idx < 384 * 8; idx += 512) {
            const int key = idx >> 3, ch = idx & 7, kp = (n - 1) * 128 + key;
            u32x4 kv = {0u, 0u, 0u, 0u}, vv = {0u, 0u, 0u, 0u};
            if (kp >= 0 && kp < SEQ) { const size_t off = (size_t)(b * SEQ + kp) * 128 + kvh * 64 + ch * 8; kv = *(const u32x4*)(Kb + off); vv = *(const u32x4*)(Vb + off); }
            *(LAS u32x4*)(Kl + key * KL_STRIDE + ch * 16) = kv;
            LAS unsigned short* vd = (LAS unsigned short*)(Vt + (ch * 8) * VT_STRIDE + key * 2);
            constexpr int RS = VT_STRIDE / 2;
            vd[0 * RS] = (unsigned short)(vv.x & 0xffffu); vd[1 * RS] = (unsigned short)(vv.x >> 16); vd[2 * RS] = (unsigned short)(vv.y & 0xffffu); vd[3 * RS] = (unsigned short)(vv.y >> 16);
            vd[4 * RS] = (unsigned short)(vv.z & 0xffffu); vd[5 * RS] = (unsigned short)(vv.z >> 16); vd[6 * RS] = (unsigned short)(vv.w & 0xffffu); vd[7 * RS] = (unsigned short)(vv.w >> 16);
        }
        __syncthreads();
        const int hq = kvh * 4 + (w >> 1);
        const float m0 = sink[hq] * LOG2E;
        for (int qb = 0; qb < 2; ++qb) {
            const int q0 = 64 * (w & 1) + 32 * qb;
            const size_t qrow = (size_t)(b * SEQ + n * 128 + q0 + l31);
            bf16x8 bq[4];
#pragma unroll
            for (int ks = 0; ks < 4; ++ks) bq[ks] = *(const bf16x8*)(Q + qrow * 512 + hq * 64 + 16 * ks + 8 * h);
            float m2 = m0, l = 1.0f;
            f32x16 O0, O1;
#pragma unroll
            for (int i = 0; i < 16; ++i) { O0[i] = 0.f; O1[i] = 0.f; }
            const int kt0 = q0 >> 5, qk = q0 + l31;
            for (int kt = kt0; kt <= kt0 + 8; ++kt) {
                f32x16 X;
#pragma unroll
                for (int i = 0; i < 16; ++i) X[i] = 0.f;
#pragma unroll
                for (int ks = 0; ks < 4; ++ks) { const bf16x8 a = *(const LAS bf16x8*)(Kl + (32 * kt + l31) * KL_STRIDE + (16 * ks + 8 * h) * 2); X = MFMA32(a, bq[ks], X); }
                float mx = -1.0e30f;
#pragma unroll
                for (int i = 0; i < 16; ++i) { const int kk = 32 * kt + crow(i, h); const int kp = (n - 1) * 128 + kk;
                    const bool valid = (kk >= qk) && (kk <= qk + 256) && (kp >= 0) && (kp < SEQ);
                    X[i] = valid ? X[i] : -1.0e30f; mx = fmaxf(mx, X[i]); }
                mx = max_x32(mx);
                const float mn = fmaxf(m2, mx), alpha = fast_exp2(m2 - mn); m2 = mn;
                float ps = 0.f;
#pragma unroll
                for (int i = 0; i < 16; ++i) { X[i] = fast_exp2(X[i] - mn); ps += X[i]; }
                ps = sum_x32(ps);
                l = l * alpha + ps;
#pragma unroll
                for (int i = 0; i < 16; ++i) { O0[i] *= alpha; O1[i] *= alpha; }
#pragma unroll
                for (int s = 0; s < 2; ++s) {
                    u32x4 pw; pw.x = pk2(X[8 * s + 0], X[8 * s + 1]); pw.y = pk2(X[8 * s + 2], X[8 * s + 3]); pw.z = pk2(X[8 * s + 4], X[8 * s + 5]); pw.w = pk2(X[8 * s + 6], X[8 * s + 7]);
                    const bf16x8 pf = __builtin_bit_cast(bf16x8, pw);
                    const int kb = (32 * kt + 16 * s + 4 * h) * 2;
                    { const s16x4 lo = *(const LAS s16x4*)(Vt + l31 * VT_STRIDE + kb), hi = *(const LAS s16x4*)(Vt + l31 * VT_STRIDE + kb + 16);
                      O0 = MFMA32(__builtin_shufflevector(lo, hi, 0, 1, 2, 3, 4, 5, 6, 7), pf, O0); }
                    { const s16x4 lo = *(const LAS s16x4*)(Vt + (32 + l31) * VT_STRIDE + kb), hi = *(const LAS s16x4*)(Vt + (32 + l31) * VT_STRIDE + kb + 16);
                      O1 = MFMA32(__builtin_shufflevector(lo, hi, 0, 1, 2, 3, 4, 5, 6, 7), pf, O1); }
                }
            }
            const float inv = 1.0f / l;
            bf16* orow = MIX + qrow * D + hq * 64;
#pragma unroll
            for (int g4 = 0; g4 < 4; ++g4) {
                u32x2 o; o.x = pk2(O0[4 * g4] * inv, O0[4 * g4 + 1] * inv); o.y = pk2(O0[4 * g4 + 2] * inv, O0[4 * g4 + 3] * inv); *(u32x2*)(orow + 8 * g4 + 4 * h) = o;
                u32x2 p; p.x = pk2(O1[4 * g4] * inv, O1[4 * g4 + 1] * inv); p.y = pk2(O1[4 * g4 + 2] * inv, O1[4 * g4 + 3] * inv); *(u32x2*)(orow + 32 + 8 * g4 + 4 * h) = p;
            }
        }
    }
    __syncthreads();
}

constexpr int SG_STRIDE = 272;
DI void sgu_phase(Frame& F, const float* sgu_b) {
    FRESH(F);
    const bf16* ZU = (const bf16*)(F.ws + WS_ZU); const bf16* ZV = (const bf16*)(F.ws + WS_ZV); const bf16* Wsb = (const bf16*)(F.ws + WS_SGUW); bf16* MIX = (bf16*)(F.ws + WS_MIX);
    LAS unsigned char* VT = F.lds + F.wave * (32 * SG_STRIDE);
    const int lane = F.lane, l31 = lane & 31, h = lane >> 5;
    const int gw = F.bid * NWAVES + F.wave, NGW = F.G * NWAVES;
    for (int su = gw; su < BATCH * 16 * 8 * 2; su += NGW) {
        const int dh = su & 1, g = (su >> 1) & 7, n = (su >> 4) & 15, b = su >> 8;
        const size_t rowb = (size_t)(b * SEQ + n * 128);
#pragma unroll
        for (int i = 0; i < 8; ++i) { const int c = lane + 64 * i, q = c >> 2, ch = c & 3;
            const u32x4 vv = *(const u32x4*)(ZV + (rowb + q) * 512 + 64 * g + 32 * dh + 8 * ch);
            LAS unsigned short* vd = (LAS unsigned short*)(VT + (ch * 8) * SG_STRIDE + q * 2);
            constexpr int RS = SG_STRIDE / 2;
            vd[0 * RS] = (unsigned short)(vv.x & 0xffffu); vd[1 * RS] = (unsigned short)(vv.x >> 16); vd[2 * RS] = (unsigned short)(vv.y & 0xffffu); vd[3 * RS] = (unsigned short)(vv.y >> 16);
            vd[4 * RS] = (unsigned short)(vv.z & 0xffffu); vd[5 * RS] = (unsigned short)(vv.z >> 16); vd[6 * RS] = (unsigned short)(vv.w & 0xffffu); vd[7 * RS] = (unsigned short)(vv.w >> 16); }
        bf16x8 af[8];
#pragma unroll
        for (int ks = 0; ks < 8; ++ks) af[ks] = *(const LAS bf16x8*)(VT + l31 * SG_STRIDE + (16 * ks + 8 * h) * 2);
#pragma unroll
        for (int pt = 0; pt < 4; ++pt) {
            const int p = 32 * pt + l31;
            f32x16 acc;
#pragma unroll
            for (int i = 0; i < 16; ++i) acc[i] = 0.f;
#pragma unroll
            for (int ks = 0; ks < 8; ++ks) { const bf16x8 bw = *(const bf16x8*)(Wsb + ((size_t)g * 128 + p) * 128 + 16 * ks + 8 * h); acc = MFMA32(af[ks], bw, acc); }
            const float bias = sgu_b[g * 128 + p];
            const size_t row = rowb + p;
#pragma unroll
            for (int g4 = 0; g4 < 4; ++g4) { const int d = 32 * dh + 8 * g4 + 4 * h;
                const u32x2 uu = *(const u32x2*)(ZU + row * 512 + 64 * g + d);
                u32x2 o; o.x = pk2(bf_lo(uu.x) * (acc[4 * g4] + bias), bf_hi(uu.x) * (acc[4 * g4 + 1] + bias)); o.y = pk2(bf_lo(uu.y) * (acc[4 * g4 + 2] + bias), bf_hi(uu.y) * (acc[4 * g4 + 3] + bias));
                *(u32x2*)(MIX + row * D + 512 + 64 * g + d) = o; }
        }
        LDS_WAIT();
    }
}

constexpr int S5_STRIDE = 272;
DI void sincos_f(float th, float& s, float& c) {
    const float tq = th * 0.636619772367581f, q = rintf(tq), f = (tq - q) * 1.5707963267948966f, f2 = f * f;
    const float sp = f * (1.0f + f2 * (-1.6666667e-1f + f2 * (8.3333333e-3f + f2 * (-1.9841270e-4f + f2 * 2.7557319e-6f))));
    const float cp = 1.0f + f2 * (-0.5f + f2 * (4.1666667e-2f + f2 * (-1.3888889e-3f + f2 * (2.4801587e-5f + f2 * (-2.7557319e-7f)))));
    const int qi = ((int)q) & 3;
    s = (qi == 0) ? sp : (qi == 1) ? cp : (qi == 2) ? -sp : -cp;
    c = (qi == 0) ? cp : (qi == 1) ? -sp : (qi == 2) ? -cp : sp;
}
DI void zoh_params(float lr, float li, float logdt, float& br, float& bi, float& cr, float& ci) {
    const float dt = expf(logdt);
    const float ea = expf(lr * dt);
    float sn, cs; sincos_f(li * dt, sn, cs);
    br = ea * cs; bi = ea * sn;
    const float nr = br - 1.0f, rden = 1.0f / (lr * lr + li * li);
    cr = (nr * lr + bi * li) * rden; ci = (bi * lr - nr * li) * rden;
}
DI void s5_phase(Frame& F, const ArgsRef& a, int i) {
    FRESH(F);
    const bf16* XB = (const bf16*)(F.ws + WS_XB); float* YF = (float*)(F.ws + WS_YF); bf16* YG = (bf16*)(F.ws + WS_YG);
    LAS unsigned char* xs = F.lds + F.wave * (32 * S5_STRIDE);
    const int lane = F.lane, l31 = lane & 31, h = lane >> 5, l15 = lane & 15, q4 = lane >> 4;
    const int gw = F.bid * NWAVES + F.wave, NGW = F.G * NWAVES;
    for (int unit = gw; unit < BATCH * 64; unit += NGW) {
        const int b = unit >> 6, g = unit & 63;
        const f32x4 dsk = *(const f32x4*)(a.in[20] + ((size_t)i * 64 + g) * 16 + 4 * q4);
#pragma unroll 1
        for (int dir = 0; dir < 2; ++dir) {
            const size_t pg = ((size_t)(i * 2 + dir) * 64 + g);
            const float logdt = a.in[15][pg];
            float lbr, lbi, cr_, ci_;
            zoh_params(a.in[13][pg * 64 + lane], a.in[14][pg * 64 + lane], logdt, lbr, lbi, cr_, ci_);
            bf16x8 fre[2], fim[2];
#pragma unroll
            for (int ph = 0; ph < 2; ++ph) { const int pp = 32 * ph + l31; float tbr, tbi, tcr, tci;
                zoh_params(a.in[13][pg * 64 + pp], a.in[14][pg * 64 + pp], logdt, tbr, tbi, tcr, tci);
                const float* brp = a.in[16] + (pg * 64 + pp) * 16 + 8 * h; const float* bip = a.in[17] + (pg * 64 + pp) * 16 + 8 * h;
                const f32x4 r0 = *(const f32x4*)brp, r1 = *(const f32x4*)(brp + 4), m0 = *(const f32x4*)bip, m1 = *(const f32x4*)(bip + 4);
                const f32x4 re0 = r0 * tcr - m0 * tci, re1 = r1 * tcr - m1 * tci, im0 = m0 * tcr + r0 * tci, im1 = m1 * tcr + r1 * tci;
                fre[ph] = __builtin_bit_cast(bf16x8, pg8::pack8(re0, re1)); fim[ph] = __builtin_bit_cast(bf16x8, pg8::pack8(im0, im1)); }
            bf16x8 cf[4];
#pragma unroll
            for (int ks = 0; ks < 4; ++ks) { const size_t co = (pg * 16 + l15) * 64 + 16 * ks + 4 * q4;
                const f32x4 cre = *(const f32x4*)(a.in[18] + co), cim = *(const f32x4*)(a.in[19] + co);
                u32x4 wv; wv.x = pk2(cre[0], -cim[0]); wv.y = pk2(cre[1], -cim[1]); wv.z = pk2(cre[2], -cim[2]); wv.w = pk2(cre[3], -cim[3]);
                cf[ks] = __builtin_bit_cast(bf16x8, wv); }
            float xr = 0.f, xi = 0.f;
#pragma unroll 1
            for (int ci2 = 0; ci2 < 64; ++ci2) {
                const int cidx = dir ? 63 - ci2 : ci2, s0 = 32 * cidx;
                const size_t rowb = (size_t)(b * SEQ + s0);
                const bf16x8 au = *(const bf16x8*)(XB + (rowb + l31) * D + 16 * g + 8 * h);
                f32x16 z16;
#pragma unroll
                for (int k = 0; k < 16; ++k) z16[k] = 0.f;
                f32x16 Pr0 = MFMA32(au, fre[0], z16), Pr1 = MFMA32(au, fre[1], z16), Pi0 = MFMA32(au, fim[0], z16), Pi1 = MFMA32(au, fim[1], z16);
                float rlo[16], rhi[16], ilo[16], ihi[16];
#pragma unroll
                for (int r = 0; r < 16; ++r) {
                    auto sr = __builtin_amdgcn_permlane32_swap(__float_as_uint(Pr0[r]), __float_as_uint(Pr1[r]), false, false); rlo[r] = __uint_as_float(sr[0]); rhi[r] = __uint_as_float(sr[1]);
                    auto si = __builtin_amdgcn_permlane32_swap(__float_as_uint(Pi0[r]), __float_as_uint(Pi1[r]), false, false); ilo[r] = __uint_as_float(si[0]); ihi[r] = __uint_as_float(si[1]); }
                if (dir == 0) {
#pragma unroll
                    for (int t = 0; t < 32; ++t) { const int r = (t & 3) + 4 * (t >> 3); const bool hh = (t >> 2) & 1;
                        const float ur = hh ? rhi[r] : rlo[r], ui = hh ? ihi[r] : ilo[r];
                        const float nr = lbr * xr - lbi * xi + ur, ni = lbr * xi + lbi * xr + ui; xr = nr; xi = ni;
                        *(LAS unsigned*)(xs + t * S5_STRIDE + 4 * lane) = pk2(xr, xi); }
                } else {
#pragma unroll
                    for (int t = 31; t >= 0; --t) { const int r = (t & 3) + 4 * (t >> 3); const bool hh = (t >> 2) & 1;
                        const float ur = hh ? rhi[r] : rlo[r], ui = hh ? ihi[r] : ilo[r];
                        const float nr = lbr * xr - lbi * xi + ur, ni = lbr * xi + lbi * xr + ui; xr = nr; xi = ni;
                        *(LAS unsigned*)(xs + t * S5_STRIDE + 4 * lane) = pk2(xr, xi); }
                }
#pragma unroll
                for (int mt = 0; mt < 2; ++mt) {
                    f32x4 y4 = {0.f, 0.f, 0.f, 0.f};
#pragma unroll
                    for (int ks = 0; ks < 4; ++ks) { const bf16x8 bx = *(const LAS bf16x8*)(xs + (16 * mt + l15) * S5_STRIDE + (32 * ks + 8 * q4) * 2); y4 = MFMA16(cf[ks], bx, y4); }
                    const size_t o = (rowb + 16 * mt + l15) * D + 16 * g + 4 * q4;
                    if (dir == 0) *(f32x4*)(YF + o) = y4;
                    else { const f32x4 yf = *(const f32x4*)(YF + o); const u32x2 uu = *(const u32x2*)(XB + o);
                        const f32x4 uv = {bf_lo(uu.x), bf_hi(uu.x), bf_lo(uu.y), bf_hi(uu.y)};
                        const f32x4 y = yf + y4 + dsk * uv;
                        u32x2 ov; ov.x = pk2(gelu_tanh(y[0]), gelu_tanh(y[1])); ov.y = pk2(gelu_tanh(y[2]), gelu_tanh(y[3])); *(u32x2*)(YG + o) = ov; }
                }
                LDS_WAIT();
            }
        }
    }
}

__global__ void __launch_bounds__(NWAVES * 64, 2) fwd_kernel(Args args_by_value) {
    extern __shared__ __attribute__((aligned(16))) unsigned char lds[];
    Frame F;
    F.lds = (LAS unsigned char*)lds;
    F.MISC = (volatile LAS unsigned*)(F.lds + MISC_OFF);
    F.tid = threadIdx.x; F.lane = F.tid & 63; F.wave = __builtin_amdgcn_readfirstlane(F.tid >> 6);
    F.G = gridDim.x; F.bid = blockIdx.x;
    { kptr_t kp = (kptr_t)__builtin_amdgcn_kernarg_segment_ptr(); F.out = *(float* const __attribute__((address_space(4)))*)(kp + 8 * 27); F.ws = *(unsigned char* const __attribute__((address_space(4)))*)(kp + 8 * 28); }
    F.ctl = (unsigned*)(F.ws + WS_CTL);
    const ArgsRef args{};
    for (int u = F.tid; u < (LDS_BYTES - LDSCTL_OFF) / 4; u += NWAVES * 64) ((LAS unsigned*)(F.lds + LDSCTL_OFF))[u] = 0u;
    __syncthreads();
    XcdBarrier bar = xcd_barrier_post(F.ctl + CW_BAR, F.MISC + 8, F.tid == 0);
#define GRID_BAR() xcd_barrier(bar, F.wave)
#define XB ((bf16*)(F.ws + WS_XB))
#define Yb ((bf16*)(F.ws + WS_Y))
#define Wb ((const char*)(F.ws + WS_W))
#define cosT ((const float*)(F.ws + WS_ROPE))
#define sinT ((const float*)(F.ws + WS_ROPE) + SEQ * 32)

    PH(0) prologue(F, args);
    PH(1) conv_layer(F, args, 0);
    GRID_BAR();

#pragma unroll 1
    for (int lp = 0; lp < 2; ++lp) {
        {
            const int L = 2 * lp, i = lp;
            { UFRESH(F); pg8::Order S{}; S.nM = T / 256; S.nN = INW / 256; S.nwg = S.nM * S.nN; S.G = F.G; S.c = F.bid; S.A = (const char*)XB; S.Bt = Wb + W_IN; S.tstep = (size_t)256 * D * 2; S.estride = 0;
              PH(2) { pg8::EpiWin E{(bf16*)(F.ws + WS_Q), (bf16*)(F.ws + WS_K), (bf16*)(F.ws + WS_V), (bf16*)(F.ws + WS_ZU), (bf16*)(F.ws + WS_ZV), cosT, sinT, args.in[7] + (size_t)i * 512, args.in[8] + (size_t)i * 512};
              pg8::gemm_phase(F.lds, D, S, E, F.wave); } }
            GRID_BAR();
            PH(3) attn_phase(F, args.in[4] + (size_t)i * 8);
            PH(4) sgu_phase(F, args.in[6] + (size_t)i * 8 * 128);
            GRID_BAR();
            { UFRESH(F); pg8::Order S{}; S.nM = T / 256; S.nN = D / 256; S.nwg = S.nM * S.nN; S.G = F.G; S.c = F.bid; S.A = (const char*)(F.ws + WS_MIX); S.Bt = Wb + W_OUT; S.tstep = (size_t)256 * D * 2; S.estride = 0;
              pg8::EpiPlain E{Yb, D};
              PH(10) pg8::gemm_phase(F.lds, D, S, E, F.wave); }
            GRID_BAR();
            PH(5) ln_pass_plain(F, (L == 0) ? args.in[0] : (const float*)F.out, args.in[1] + (size_t)(L * 2 + 0) * D, args.in[2] + (size_t)(L * 2 + 0) * D);
            GRID_BAR();
            { UFRESH(F); pg8::Order S{}; S.nM = T / 256; S.nN = 2 * FF / 256; S.nwg = S.nM * S.nN; S.G = F.G; S.c = F.bid; S.A = (const char*)XB; S.Bt = Wb + W_GU; S.tstep = (size_t)256 * D * 2; S.estride = 0;
              pg8::EpiPair<0> E{(bf16*)(F.ws + WS_H), FF};
              PH(11) pg8::gemm_phase(F.lds, D, S, E, F.wave); }
            GRID_BAR();
            { UFRESH(F); pg8::Order S{}; S.nM = T / 256; S.nN = D / 256; S.nwg = S.nM * S.nN; S.G = F.G; S.c = F.bid; S.A = (const char*)(F.ws + WS_H); S.Bt = Wb + W_DN; S.tstep = (size_t)256 * FF * 2; S.estride = 0;
              pg8::EpiPlain E{Yb, D};
              PH(10) pg8::gemm_phase(F.lds, FF, S, E, F.wave); }
            GRID_BAR();
            PH(5) ln_pass_plain(F, (const float*)F.out, args.in[1] + (size_t)(L * 2 + 1) * D, args.in[2] + (size_t)(L * 2 + 1) * D);
            PH(1) conv_layer(F, args, L + 1);
            GRID_BAR();
        }
        {
            const int L = 2 * lp + 1, i = lp;
            unsigned* cnt = F.ctl + CW_CNT + 64 * i;
            PH(6) s5_phase(F, args, i);
            GRID_BAR();
            { UFRESH(F); pg8::Order S{}; S.nM = T / 256; S.nN = 2 * D / 256; S.nwg = S.nM * S.nN; S.G = F.G; S.c = F.bid; S.A = (const char*)(F.ws + WS_YG); S.Bt = Wb + W_GLU; S.tstep = (size_t)256 * D * 2; S.estride = 0;
              pg8::EpiPair<1> E{Yb, D};
              PH(12) pg8::gemm_phase(F.lds, D, S, E, F.wave); }
            GRID_BAR();
            PH(7) ln_pass_router(F, args.in[1] + (size_t)(L * 2 + 0) * D, args.in[2] + (size_t)(L * 2 + 0) * D, args.in[23] + (size_t)i * D * 8, cnt);
            GRID_BAR();
            PH(8) moe_gather(F, cnt);
            GRID_BAR();
            {
                int tb[9], cn[8]; moe_tiles(cnt, tb, cn);
                const int ntt = tb[8], TC = (ntt + 3) >> 2;
#pragma unroll 1
                for (int ch = 0; ch < 4; ++ch) {
                    const int t0 = ch * TC, t1 = (t0 + TC < ntt) ? t0 + TC : ntt, nM = (t1 > t0) ? t1 - t0 : 0;
                    { UFRESH(F); pg8::Order S{}; S.nM = nM; S.nN = 2 * FF / 256; S.nwg = S.nM * S.nN; S.G = F.G; S.c = F.bid; S.atile0 = t0; S.otile0 = 0; S.etile0 = t0;
                      S.A = (const char*)(F.ws + WS_XS); S.Bt = Wb + W_MGU; S.tstep = (size_t)256 * D * 2; S.estride = (size_t)2 * FF * D * 2;
#pragma unroll
                      for (int e = 0; e < 8; ++e) S.tb[e] = tb[e];
                      pg8::EpiPair<0> E{(bf16*)(F.ws + WS_HS), FF};
                      PH(13) pg8::gemm_phase(F.lds, D, S, E, F.wave); }
                    GRID_BAR();
                    { UFRESH(F); pg8::Order S{}; S.nM = nM; S.nN = D / 256; S.nwg = S.nM * S.nN; S.G = F.G; S.c = F.bid; S.atile0 = 0; S.otile0 = t0; S.etile0 = t0;
                      S.A = (const char*)(F.ws + WS_HS); S.Bt = Wb + W_MDN; S.tstep = (size_t)256 * FF * 2; S.estride = (size_t)D * FF * 2;
#pragma unroll
                      for (int e = 0; e < 8; ++e) S.tb[e] = tb[e];
                      pg8::EpiPlain E{(bf16*)(F.ws + WS_YS), D};
                      PH(14) pg8::gemm_phase(F.lds, FF, S, E, F.wave); }
                    GRID_BAR();
                }
            }
            PH(9) ln_pass_combine(F, args.in[1] + (size_t)(L * 2 + 1) * D, args.in[2] + (size_t)(L * 2 + 1) * D, cnt);
            if (L + 1 < 4) { PH(1) conv_layer(F, args, L + 1); GRID_BAR(); }
        }
    }
}

extern "C" void kernel_launch(void* const* d_in, const int* in_sizes, int n_in, void* d_out, int out_size, void* d_ws, size_t ws_size, hipStream_t stream) {
    static int grid = 0;
    if (grid == 0) {
        if (n_in != 27 || in_sizes[0] != T * D || out_size != T * D || ws_size < WS_END) {
            fprintf(stderr, "kernel_launch: unexpected shapes (n_in %d, in0 %d, out %d, ws %zu; need ws >= %zu); nothing launched\n", n_in, n_in > 0 ? in_sizes[0] : -1, out_size, ws_size, (size_t)WS_END); grid = -1; return; }
        int dev = 0, cus = 0, per_cu = 0;
        if (hipGetDevice(&dev) != hipSuccess || hipDeviceGetAttribute(&cus, hipDeviceAttributeMultiprocessorCount, dev) != hipSuccess) { grid = -1; return; }
        if (hipFuncSetAttribute((const void*)fwd_kernel, hipFuncAttributeMaxDynamicSharedMemorySize, LDS_BYTES) != hipSuccess) { fprintf(stderr, "kernel_launch: hipFuncSetAttribute failed\n"); grid = -1; return; }
        if (hipOccupancyMaxActiveBlocksPerMultiprocessor(&per_cu, (const void*)fwd_kernel, NWAVES * 64, LDS_BYTES) != hipSuccess || per_cu < 1)
            fprintf(stderr, "kernel_launch: note: occupancy query reports %d workgroups per CU\n", per_cu);
        (void)hipGetLastError();
        grid = cus;
    }
    if (grid < 0) return;
    if (hipMemsetAsync((char*)d_ws + WS_CTL, 0, CTL_ZERO_BYTES, stream) != hipSuccess) return;
    Args a{};
    for (int i = 0; i < 27; ++i) a.in[i] = (const float*)d_in[i];
    a.out = (float*)d_out; a.ws = (unsigned char*)d_ws;
    hipLaunchKernelGGL(fwd_kernel, dim3(grid), dim3(NWAVES * 64), LDS_BYTES, stream, a);
}
```

```cpp
#include <hip/hip_runtime.h>
#include <cstdio>
#include <cstdint>

#define LAS __attribute__((address_space(3)))
typedef unsigned short bf16;
typedef short bf16x8 __attribute__((ext_vector_type(8)));
typedef short s16x4 __attribute__((ext_vector_type(4)));
typedef float f32x4 __attribute__((ext_vector_type(4)));
typedef float f32x2 __attribute__((ext_vector_type(2)));
typedef float f32x16 __attribute__((ext_vector_type(16)));
typedef unsigned u32x4 __attribute__((ext_vector_type(4)));
typedef unsigned u32x2 __attribute__((ext_vector_type(2)));
typedef int i32x4 __attribute__((ext_vector_type(4)));
typedef __bf16 bf2_t __attribute__((ext_vector_type(2)));
#define DI __device__ __forceinline__
#define GASP __attribute__((address_space(1)))
template <class T> DI T* as_global(T* p) { return (T*)(GASP T*)p; }
#ifndef PHM
#define PHM 0xFFFFF
#endif
#define PH(b) if (PHM & (1 << (b)))
#ifndef RG
#define RG 0
#endif
#define RPT(g) for (int rep_ = 0, nrep_ = rep_count(((RG) >> (g)) & 1); rep_ < nrep_; ++rep_)
#define UFRESH(F) do { asm volatile("" : "+s"((F).ws), "+s"((F).out), "+s"((F).G), "+s"((F).bid)); (F).ctl = (unsigned*)((F).ws + WS_CTL); } while (0)
#define FRESH(F) do { UFRESH(F); int l_ = lane_id(); asm volatile("" : "+v"(l_)); (F).lane = l_; (F).tid = (F).wave * 64 + l_; } while (0)

constexpr int NWAVES = 8;
constexpr int BATCH = 32, SEQ = 2048, D = 1024, T = BATCH * SEQ;
constexpr int INW = 1792, FF = 2816, NE = 8;
constexpr float ALPHA = 1.6817928305074290f;
constexpr float LN_EPS = 1e-5f;
constexpr float QSCALE = 0.18033688011112042f;
constexpr float LOG2E = 1.4426950408889634f;

constexpr size_t MiB = 1u << 20;
constexpr size_t WS_CTL = 0, CTL_ZERO_BYTES = 1 * MiB;
constexpr size_t WS_ROPE = 1 * MiB;
constexpr size_t WS_RECI = 2 * MiB;
constexpr size_t WS_RECW = 3 * MiB;
constexpr size_t WS_SGUW = 4 * MiB;
constexpr size_t WS_W = 16 * MiB;
constexpr size_t WS_XB = 156 * MiB;
constexpr size_t WS_Y = 284 * MiB;
constexpr size_t WS_R = 412 * MiB;
constexpr size_t WS_Q = WS_R, WS_K = WS_Q + 64 * MiB, WS_V = WS_K + 16 * MiB, WS_ZU = WS_V + 16 * MiB, WS_ZV = WS_ZU + 64 * MiB, WS_MIX = WS_ZV + 64 * MiB;
constexpr size_t WS_H = WS_R;
constexpr size_t WS_YF = WS_R;
constexpr size_t WS_YG = WS_R + 256 * MiB;
constexpr int XS_ROWS = 2 * T + NE * 256;
constexpr int TC_MAX = 130;
constexpr size_t WS_XS = 284 * MiB;
constexpr size_t WS_HS = 544 * MiB;
constexpr size_t WS_YS = 724 * MiB;
constexpr size_t WS_END = 984 * MiB;
constexpr size_t W_IN = 0, W_OUT = 4 * MiB, W_GU = 6 * MiB, W_DN = 17 * MiB;
constexpr size_t W_GLU = 0, W_MGU = 4 * MiB, W_MDN = 92 * MiB;
constexpr int CW_TMO = 0, CW_DBG = 2, CW_BAR = 4096, CW_CNT = 8192;

constexpr int RING_BYTES = 131072;
constexpr int LDSCTL_OFF = RING_BYTES, MISC_OFF = LDSCTL_OFF + 320;
constexpr int LDS_BYTES = 147456;

DI unsigned pk2(float lo, float hi) { f32x2 v = {lo, hi}; return __builtin_bit_cast(unsigned, __builtin_convertvector(v, bf2_t)); }
DI float bf_lo(unsigned w) { return __uint_as_float(w << 16); }
DI float bf_hi(unsigned w) { return __uint_as_float(w & 0xffff0000u); }
DI float fast_exp2(float x) { return __builtin_amdgcn_exp2f(x); }
DI float fast_rcp(float x) { return __builtin_amdgcn_rcpf(x); }
DI float sigmoidf_(float x) { return fast_rcp(1.0f + fast_exp2(-LOG2E * x)); }
DI float gelu_tanh(float x) { const float z = x + 0.044715f * x * x * x; return x * fast_rcp(1.0f + fast_exp2(-2.302208198f * z)); }
#define dpp_f(v, ctrl) __int_as_float(__builtin_amdgcn_mov_dpp(__float_as_int(v), (ctrl), 0xf, 0xf, true))
#define DPP_XOR1 0xB1
#define DPP_XOR2 0x4E
#define DPP_HMIRROR 0x141
#define DPP_MIRROR 0x140
DI float swz16_f(float v) { return __int_as_float(__builtin_amdgcn_ds_swizzle(__float_as_int(v), 0x401F)); }
DI float sum_x32(float v) { auto r = __builtin_amdgcn_permlane32_swap(__float_as_uint(v), __float_as_uint(v), false, false); return __uint_as_float(r[0]) + __uint_as_float(r[1]); }
DI float max_x32(float v) { auto r = __builtin_amdgcn_permlane32_swap(__float_as_uint(v), __float_as_uint(v), false, false); return fmaxf(__uint_as_float(r[0]), __uint_as_float(r[1])); }
DI float wave_sum(float v) {
    v += dpp_f(v, DPP_XOR1); v += dpp_f(v, DPP_XOR2); v += dpp_f(v, DPP_HMIRROR); v += dpp_f(v, DPP_MIRROR); v += swz16_f(v); return sum_x32(v);
}
#define LDS_WAIT() asm volatile("s_waitcnt lgkmcnt(0)" ::: "memory")
#define VM_WAIT() asm volatile("s_waitcnt vmcnt(0)" ::: "memory")
DI int lane_id() { unsigned ones = ~0u; asm volatile("" : "+s"(ones)); return (int)__builtin_amdgcn_mbcnt_hi(ones, __builtin_amdgcn_mbcnt_lo(ones, 0u)); }
DI int rep_count(int extra) { int n = 1 + extra; asm volatile("" : "+s"(n)); return n; }
DI int crow(int reg, int h) { return (reg & 3) + 8 * (reg >> 2) + 4 * h; }
#define MFMA32(a, b, c) __builtin_amdgcn_mfma_f32_32x32x16_bf16((a), (b), (c), 0, 0, 0)
#define MFMA16(a, b, c) __builtin_amdgcn_mfma_f32_16x16x32_bf16((a), (b), (c), 0, 0, 0)

DI void sincos_d(double th, double& s, double& c) {
    const double tq = th * 0.63661977236758134308;
    const double q = rint(tq);
    const double f = (tq - q) * 1.57079632679489661923;
    const double f2 = f * f;
    const double sp = f * (1.0 + f2 * (-1.0 / 6 + f2 * (1.0 / 120 + f2 * (-1.0 / 5040 + f2 * (1.0 / 362880 + f2 * (-1.0 / 39916800 + f2 * (1.0 / 6227020800.0)))))));
    const double cp = 1.0 + f2 * (-0.5 + f2 * (1.0 / 24 + f2 * (-1.0 / 720 + f2 * (1.0 / 40320 + f2 * (-1.0 / 3628800 + f2 * (1.0 / 479001600.0 + f2 * (-1.0 / 87178291200.0)))))));
    const int qi = ((int)q) & 3;
    s = (qi == 0) ? sp : (qi == 1) ? cp : (qi == 2) ? -sp : -cp;
    c = (qi == 0) ? cp : (qi == 1) ? -sp : (qi == 2) ? -cp : sp;
}
DI double exp_d(double x) {
    const double n = rint(x * 1.4426950408889634074);
    const double r = x - n * 0.69314718055994530942;
    double p = 1.0 / 87178291200.0;
    p = p * r + 1.0 / 6227020800.0; p = p * r + 1.0 / 479001600.0; p = p * r + 1.0 / 39916800.0; p = p * r + 1.0 / 3628800.0; p = p * r + 1.0 / 362880.0;
    p = p * r + 1.0 / 40320.0; p = p * r + 1.0 / 5040.0; p = p * r + 1.0 / 720.0; p = p * r + 1.0 / 120.0; p = p * r + 1.0 / 24.0; p = p * r + 1.0 / 6.0; p = p * r + 0.5; p = p * r + 1.0; p = p * r + 1.0;
    const long long bits = (long long)((int)n + 1023) << 52;
    return p * __builtin_bit_cast(double, bits);
}

namespace pg8 {
constexpr int BM = 256, BK = 64, HALF = 128, HTB = HALF * BK * 2, STAGE_BYTES = 8 * HTB, NXCD = 8, WGM = 8;
DI int lds_byte(int r, int c) { const int st = (r >> 4) * 2 + (c >> 5), rr = r & 15, cc = c & 31, ob = rr * 64 + cc * 2; return st * 1024 + (ob ^ (((ob >> 9) & 1) << 5)); }
DI void stage_rc(int b, int& R, int& C) { const int st = b / 1024, sb = b % 1024, swz = sb ^ (((sb >> 9) & 1) << 5); R = (st >> 1) * 16 + swz / 64; C = (st & 1) * 32 + (swz % 64) / 2; }
DI int perm32(int rho) { const int n = rho >> 4, i = rho & 15; return 8 * (i >> 2) + 4 * n + (i & 3); }

struct Unit { int pm, pn, row0; const char* a; const char* b; };
struct Order {
    int nM, nN, nwg, G, c, atile0, otile0, etile0;
    const char* A; const char* Bt; size_t tstep, estride;
    int tb[8];
    DI bool next(int i, Unit& u) const {
        const long L = (long)i * G + c; if (L >= nwg) return false;
        int wgid = (int)L; { const int q = nwg / NXCD, r = nwg % NXCD, xcd = wgid % NXCD, off = wgid / NXCD; wgid = (xcd < r ? xcd * (q + 1) : r * (q + 1) + (xcd - r) * q) + off; }
        const int nig = WGM * nN, gid = wgid / nig, fm = gid * WGM, gsz = (nM - fm) < WGM ? (nM - fm) : WGM;
        u.pm = fm + ((wgid % nig) % gsz); u.pn = (wgid % nig) / gsz;
        u.row0 = (otile0 + u.pm) * BM;
        int e = 0;
        if (estride) { const int t = etile0 + u.pm;
#pragma unroll
            for (int j = 1; j < 8; ++j) e += (t >= tb[j]) ? 1 : 0; }
        u.a = A + (size_t)(atile0 + u.pm) * tstep; u.b = Bt + (size_t)e * estride + (size_t)u.pn * tstep;
        return true;
    }
};

template <class Epi>
DI void gemm_phase(LAS unsigned char* lds, const int K, const Order& S, const Epi& E, const int wid) {
    int lane = lane_id(); asm volatile("" : "+v"(lane));
    const int tid = wid * 64 + lane, wr = wid >> 2, wc = wid & 3, fr = lane & 15, fq = lane >> 4;
    const int nt = K / BK;
    unsigned voffA[2], voffB[2];
#pragma unroll
    for (int i = 0; i < 2; ++i) { int R, C; stage_rc(tid * 16 + i * 8192, R, C); const int Rb = (R & ~31) + perm32(R & 31);
        voffA[i] = (unsigned)(R * K + C) * 2u; voffB[i] = (unsigned)(Rb * K + C) * 2u; }
    const size_t kstep = (size_t)(BK * 2);
    const size_t hstep = (size_t)HALF * K * 2;
    const unsigned ldsw = (unsigned)wid * 1024u;
    const int aoff = lds_byte(wr * 64 + fr, fq * 8), boff = lds_byte(wc * 32 + fr, fq * 8);
#define PG8_SA(b, h) (((b) * 2 + (h)) * HTB)
#define PG8_SB(b, h) ((4 + (b) * 2 + (h)) * HTB)
#define PG8_STAGE(bufoff, gbase, voff) do { _Pragma("unroll") for (int _i = 0; _i < 2; ++_i) \
        __builtin_amdgcn_global_load_lds((const unsigned*)((const char*)(gbase) + (voff)[_i]), (LAS unsigned*)(lds + (bufoff) + ldsw + _i * 8192), 16, 0, 0); } while (0)
#define PG8_LDA(dst, b, h) do { _Pragma("unroll") for (int m = 0; m < 4; ++m) _Pragma("unroll") for (int k = 0; k < 2; ++k) dst[m][k] = *(const LAS bf16x8*)(lds + PG8_SA(b, h) + aoff + m * 2048 + k * 1024); } while (0)
#define PG8_LDB(dst, b, h) do { _Pragma("unroll") for (int n = 0; n < 2; ++n) _Pragma("unroll") for (int k = 0; k < 2; ++k) dst[n][k] = *(const LAS bf16x8*)(lds + PG8_SB(b, h) + boff + n * 2048 + k * 1024); } while (0)
#define PG8_MMA(ai, bj, At, Bt) do { __builtin_amdgcn_s_setprio(1); _Pragma("unroll") for (int m = 0; m < 4; ++m) _Pragma("unroll") for (int n = 0; n < 2; ++n) _Pragma("unroll") for (int k = 0; k < 2; ++k) \
        acc[ai][bj][m][n] = __builtin_amdgcn_mfma_f32_16x16x32_bf16(Bt[n][k], At[m][k], acc[ai][bj][m][n], 0, 0, 0); __builtin_amdgcn_s_setprio(0); } while (0)
#define PG8_WAIT_V(n) asm volatile("s_waitcnt vmcnt(" #n ")" ::: "memory")
#define PG8_WAIT_L(n) asm volatile("s_waitcnt lgkmcnt(" #n ")" ::: "memory")
#define PG8_BAR __builtin_amdgcn_s_barrier()
#define PG8_SCHED __builtin_amdgcn_sched_barrier(0)
    Unit cur, nxt; int ui = 0;
    if (!S.next(0, cur)) return;
    f32x4 acc[2][2][4][2];
#pragma unroll
    for (int a = 0; a < 2; ++a)
#pragma unroll
        for (int b = 0; b < 2; ++b)
#pragma unroll
            for (int m = 0; m < 4; ++m)
#pragma unroll
                for (int n = 0; n < 2; ++n) acc[a][b][m][n] = (f32x4){0.f, 0.f, 0.f, 0.f};
    bf16x8 At[4][2], B0[2][2], B1[2][2];
    const char* cA = cur.a; const char* cB = cur.b;
    PG8_STAGE(PG8_SB(0, 0), cB, voffB); PG8_STAGE(PG8_SB(0, 1), cB + hstep, voffB); PG8_STAGE(PG8_SA(0, 0), cA, voffA); PG8_STAGE(PG8_SA(0, 1), cA + hstep, voffA);
    if (wr == 1) PG8_BAR;
    PG8_WAIT_V(2); PG8_BAR;
    PG8_STAGE(PG8_SB(1, 0), cB + kstep, voffB); PG8_STAGE(PG8_SA(1, 0), cA + kstep, voffA); PG8_STAGE(PG8_SB(1, 1), cB + hstep + kstep, voffB);
    PG8_WAIT_V(6); PG8_BAR;
    for (;;) {
        const bool has_next = S.next(ui + 1, nxt);
        const char* nA = has_next ? nxt.a : cA; const char* nB = has_next ? nxt.b : cB;
        for (int t = 0; t < nt; t += 2) {
            const bool last = (t == nt - 2);
            const char* a1 = cA + (size_t)(t + 1) * kstep;
            const char* a2 = last ? nA : cA + (size_t)(t + 2) * kstep; const char* b2 = last ? nB : cB + (size_t)(t + 2) * kstep;
            const char* a3 = a2 + kstep; const char* b3 = b2 + kstep;
            PG8_LDB(B0, 0, 0); PG8_LDB(B1, 0, 1); PG8_SCHED; PG8_LDA(At, 0, 0); PG8_STAGE(PG8_SA(1, 1), a1 + hstep, voffA);
            PG8_WAIT_V(8); PG8_WAIT_L(0); PG8_BAR; PG8_MMA(0, 0, At, B0); PG8_MMA(0, 1, At, B1); PG8_BAR; PG8_SCHED;
            PG8_LDA(At, 0, 1); PG8_STAGE(PG8_SB(0, 0), b2, voffB); PG8_STAGE(PG8_SB(0, 1), b2 + hstep, voffB); PG8_STAGE(PG8_SA(0, 0), a2, voffA);
            PG8_WAIT_V(8); PG8_WAIT_L(0); PG8_BAR; PG8_MMA(1, 0, At, B0); PG8_MMA(1, 1, At, B1); PG8_BAR; PG8_SCHED;
            PG8_LDB(B0, 1, 0); PG8_LDB(B1, 1, 1); PG8_SCHED; PG8_LDA(At, 1, 0); PG8_STAGE(PG8_SA(0, 1), a2 + hstep, voffA);
            PG8_WAIT_V(8); PG8_WAIT_L(0); PG8_BAR; PG8_MMA(0, 0, At, B0); PG8_MMA(0, 1, At, B1); PG8_BAR; PG8_SCHED;
            PG8_LDA(At, 1, 1); PG8_STAGE(PG8_SB(1, 0), b3, voffB); PG8_STAGE(PG8_SB(1, 1), b3 + hstep, voffB); PG8_STAGE(PG8_SA(1, 0), a3, voffA);
            PG8_WAIT_V(8); PG8_WAIT_L(0); PG8_BAR; PG8_MMA(1, 0, At, B0); PG8_MMA(1, 1, At, B1); PG8_BAR; PG8_SCHED;
        }
        if (wr == 0) PG8_BAR;
        E(acc, cur, wr, wc, fr, fq);
        if (!has_next) break;
#pragma unroll
        for (int a = 0; a < 2; ++a)
#pragma unroll
            for (int b = 0; b < 2; ++b)
#pragma unroll
                for (int m = 0; m < 4; ++m)
#pragma unroll
                    for (int n = 0; n < 2; ++n) acc[a][b][m][n] = (f32x4){0.f, 0.f, 0.f, 0.f};
        cur = nxt; cA = nA; cB = nB; ++ui;
        if (wr == 1) PG8_BAR;
    }
    PG8_WAIT_V(0);
    PG8_BAR;
#undef PG8_SA
#undef PG8_SB
#undef PG8_STAGE
#undef PG8_LDA
#undef PG8_LDB
#undef PG8_MMA
#undef PG8_WAIT_V
#undef PG8_WAIT_L
#undef PG8_BAR
#undef PG8_SCHED
}

DI u32x4 pack8(const f32x4 a, const f32x4 b) { u32x4 w; w.x = pk2(a[0], a[1]); w.y = pk2(a[2], a[3]); w.z = pk2(b[0], b[1]); w.w = pk2(b[2], b[3]); return w; }

DI f32x4 bfx4_lo(const u32x4 w) { return (f32x4){bf_lo(w.x), bf_hi(w.x), bf_lo(w.y), bf_hi(w.y)}; }
DI f32x4 bfx4_hi(const u32x4 w) { return (f32x4){bf_lo(w.z), bf_hi(w.z), bf_lo(w.w), bf_hi(w.w)}; }
struct EpiPlain {
    bf16* O; int ldc; const bf16* R;
    DI void operator()(const f32x4 (&acc)[2][2][4][2], const Unit& u, int wr, int wc, int fr, int fq) const {
        asm volatile("" : "+v"(fr), "+v"(fq));
        const int row0 = u.row0 + wr * 64 + fr, col0 = u.pn * BM + wc * 32 + 8 * fq;
#pragma unroll
        for (int ai = 0; ai < 2; ++ai)
#pragma unroll
            for (int m = 0; m < 4; ++m) { const size_t off = (size_t)(row0 + ai * HALF + m * 16) * ldc + col0;
                if (R) { const u32x4 r0 = *(const u32x4*)(R + off), r1 = *(const u32x4*)(R + off + HALF);
                    *(u32x4*)(O + off) = pack8(acc[ai][0][m][0] + bfx4_lo(r0) * ALPHA, acc[ai][0][m][1] + bfx4_hi(r0) * ALPHA);
                    *(u32x4*)(O + off + HALF) = pack8(acc[ai][1][m][0] + bfx4_lo(r1) * ALPHA, acc[ai][1][m][1] + bfx4_hi(r1) * ALPHA);
                    asm volatile("" ::: "memory"); }
                else {
#pragma unroll
                    for (int bj = 0; bj < 2; ++bj) *(u32x4*)(O + off + bj * HALF) = pack8(acc[ai][bj][m][0], acc[ai][bj][m][1]); } }
    }
};
template <int ACT> struct EpiPair {
    bf16* O; int ldc; const bf16* R;
    DI void operator()(const f32x4 (&acc)[2][2][4][2], const Unit& u, int wr, int wc, int fr, int fq) const {
        asm volatile("" : "+v"(fr), "+v"(fq));
        const int row0 = u.row0 + wr * 64 + fr, col0 = u.pn * HALF + wc * 32 + 8 * fq;
#pragma unroll
        for (int ai = 0; ai < 2; ++ai)
#pragma unroll
            for (int m = 0; m < 4; ++m) {
                const size_t off = (size_t)(row0 + ai * HALF + m * 16) * ldc + col0;
                f32x4 o[2];
                if (R) { const u32x4 r = *(const u32x4*)(R + off); o[0] = bfx4_lo(r) * ALPHA; o[1] = bfx4_hi(r) * ALPHA; } else { o[0] = (f32x4){0.f, 0.f, 0.f, 0.f}; o[1] = o[0]; }
#pragma unroll
                for (int n = 0; n < 2; ++n) { const f32x4 a = acc[ai][0][m][n], b = acc[ai][1][m][n];
#pragma unroll
                    for (int j = 0; j < 4; ++j) o[n][j] += (ACT == 0) ? a[j] * sigmoidf_(a[j]) * b[j] : a[j] * sigmoidf_(b[j]); }
                *(u32x4*)(O + off) = pack8(o[0], o[1]);
                if (R) asm volatile("" ::: "memory"); }
    }
};
struct EpiWin {
    bf16 *Q, *Kb, *Vb, *ZU, *ZV; const float *cosT, *sinT, *lng, *lnb;
    DI void operator()(const f32x4 (&acc)[2][2][4][2], const Unit& u, int wr, int wc, int fr, int fq) const {
        asm volatile("" : "+v"(fr), "+v"(fq));
        const int rbase = u.row0 + wr * 64 + fr, pn = u.pn;
        if (pn < 2 || (pn == 2 && wc < 2)) {
            bf16* dst; int ld, colb; float sc;
            if (pn < 2) { dst = Q; ld = 512; colb = 64 * (4 * pn + wc); sc = QSCALE; } else { dst = Kb; ld = 128; colb = 64 * wc; sc = 1.0f; }
#pragma unroll
            for (int ai = 0; ai < 2; ++ai)
#pragma unroll
                for (int m = 0; m < 4; ++m) { int row = rbase + ai * HALF + m * 16; asm volatile("" : "+v"(row) :: "memory"); const int pos = row & (SEQ - 1);
                    f32x4 o1[2], o2[2];
#pragma unroll
                    for (int n = 0; n < 2; ++n) { const f32x4 c = *(const f32x4*)(cosT + pos * 32 + 8 * fq + 4 * n), s = *(const f32x4*)(sinT + pos * 32 + 8 * fq + 4 * n);
                        const f32x4 x1 = acc[ai][0][m][n], x2 = acc[ai][1][m][n];
                        o1[n] = (x1 * c - x2 * s) * sc; o2[n] = (x2 * c + x1 * s) * sc; }
                    bf16* rp = dst + (size_t)row * ld + colb + 8 * fq;
                    *(u32x4*)(rp) = pack8(o1[0], o1[1]); *(u32x4*)(rp + 32) = pack8(o2[0], o2[1]); asm volatile("" ::: "memory"); }
        } else if (pn == 2) {
#pragma unroll
            for (int ai = 0; ai < 2; ++ai)
#pragma unroll
                for (int m = 0; m < 4; ++m) { int row = rbase + ai * HALF + m * 16; asm volatile("" : "+v"(row) :: "memory"); bf16* rp = Vb + (size_t)row * 128 + 64 * (wc - 2) + 8 * fq;
#pragma unroll
                    for (int bj = 0; bj < 2; ++bj) *(u32x4*)(rp + 32 * bj) = pack8(acc[ai][bj][m][0], acc[ai][bj][m][1]); }
        } else if (pn < 5) {
#pragma unroll
            for (int ai = 0; ai < 2; ++ai)
#pragma unroll
                for (int m = 0; m < 4; ++m) { int row = rbase + ai * HALF + m * 16; asm volatile("" : "+v"(row) :: "memory"); bf16* rp = ZU + (size_t)row * 512 + 256 * (pn - 3) + 64 * wc + 8 * fq;
#pragma unroll
                    for (int bj = 0; bj < 2; ++bj) { f32x4 a = acc[ai][bj][m][0], b = acc[ai][bj][m][1];
#pragma unroll
                        for (int j = 0; j < 4; ++j) { a[j] = gelu_tanh(a[j]); b[j] = gelu_tanh(b[j]); }
                        *(u32x4*)(rp + 32 * bj) = pack8(a, b); } }
        } else {
            const int gi = 4 * (pn - 5) + wc;
            f32x4 gg[2][2], bb[2][2];
#pragma unroll
            for (int bj = 0; bj < 2; ++bj)
#pragma unroll
                for (int n = 0; n < 2; ++n) { gg[bj][n] = *(const f32x4*)(lng + gi * 64 + 32 * bj + 8 * fq + 4 * n); bb[bj][n] = *(const f32x4*)(lnb + gi * 64 + 32 * bj + 8 * fq + 4 * n); }
#pragma unroll
            for (int ai = 0; ai < 2; ++ai)
#pragma unroll
                for (int m = 0; m < 4; ++m) { int row = rbase + ai * HALF + m * 16; asm volatile("" : "+v"(row) :: "memory");
                    f32x4 z[2][2]; float s = 0.f;
#pragma unroll
                    for (int bj = 0; bj < 2; ++bj)
#pragma unroll
                        for (int n = 0; n < 2; ++n) {
#pragma unroll
                            for (int j = 0; j < 4; ++j) { z[bj][n][j] = gelu_tanh(acc[ai][bj][m][n][j]); s += z[bj][n][j]; } }
                    s += swz16_f(s); s = sum_x32(s);
                    const float mean = s * (1.0f / 64.0f); float q = 0.f;
#pragma unroll
                    for (int bj = 0; bj < 2; ++bj)
#pragma unroll
                        for (int n = 0; n < 2; ++n) { z[bj][n] = z[bj][n] - mean; q += (z[bj][n][0] * z[bj][n][0] + z[bj][n][1] * z[bj][n][1]) + (z[bj][n][2] * z[bj][n][2] + z[bj][n][3] * z[bj][n][3]); }
                    q += swz16_f(q); q = sum_x32(q);
                    const float rstd = 1.0f / sqrtf(q * (1.0f / 64.0f) + LN_EPS);
                    bf16* rp = ZV + (size_t)row * 512 + 64 * gi + 8 * fq;
#pragma unroll
                    for (int bj = 0; bj < 2; ++bj) *(u32x4*)(rp + 32 * bj) = pack8(z[bj][0] * rstd * gg[bj][0] + bb[bj][0], z[bj][1] * rstd * gg[bj][1] + bb[bj][1]); asm volatile("" ::: "memory"); }
        }
    }
};
}

#define XB_TMO      128
#define XB_XCNT(j)  (256  + 64 * (j))
#define XB_XSUB(j)  (1280 + 64 * (j))
#define XB_XGEN(j)  (2304 + 64 * (j))
#define XB_TOP      3328
#define XB_TOPGEN   3392
#define XCD_BAR_WORDS 3456
#define XB_SPIN_CAP (1u << 22)
DI unsigned xb_ld(unsigned* p)              { return __hip_atomic_load(p, __ATOMIC_RELAXED, __HIP_MEMORY_SCOPE_AGENT); }
DI unsigned xb_add(unsigned* p, unsigned v) { return __hip_atomic_fetch_add(p, v, __ATOMIC_RELAXED, __HIP_MEMORY_SCOPE_AGENT); }
DI unsigned xb_xcc_id() { return (unsigned)__builtin_amdgcn_s_getreg((3 << 11) | 20) & 0xFu; }
#define XB_SPIN(cond, bar) do { unsigned _sp = 0; while (cond) { __builtin_amdgcn_s_sleep(1); \
    if ((++_sp & 255u) == 0u) { if (xb_ld(&(bar)[XB_TMO])) break; if (_sp > XB_SPIN_CAP) { atomicAdd(&(bar)[XB_TMO], 1u); break; } } } } while (0)
struct XcdBarrier { GASP unsigned* bar; unsigned x; volatile LAS unsigned* st; };
DI XcdBarrier xcd_barrier_post(GASP unsigned* bar, volatile LAS unsigned* st, bool leader) {
    XcdBarrier b; b.bar = bar; b.x = xb_xcc_id(); b.st = st;
    if (leader) (void)xb_add((unsigned*)&bar[XB_XCNT(b.x)], 1u);
    return b;
}
DI void xcd_barrier_complete(unsigned* bar, unsigned x, unsigned& nloc, unsigned& nx) {
    const unsigned G = gridDim.x * gridDim.y * gridDim.z;
    unsigned sum, cnt, mine, sp = 0u;
    for (;;) {
        sum = 0u; cnt = 0u; mine = 0u;
#pragma unroll
        for (unsigned j = 0; j < 16; ++j) { const unsigned c = xb_ld(&bar[XB_XCNT(j)]); sum += c; cnt += (c > 0u) ? 1u : 0u; mine = (j == x) ? c : mine; }
        if (sum == G) break;
        __builtin_amdgcn_s_sleep(1);
        if ((++sp & 255u) == 0u) { if (xb_ld(&bar[XB_TMO])) break; if (sp > XB_SPIN_CAP) { atomicAdd(&bar[XB_TMO], 1u); break; } }
    }
    nloc = mine > 0u ? mine : 1u; nx = cnt > 0u ? cnt : 1u;
}
DI void xcd_barrier(const XcdBarrier& b, int wave) {
    asm volatile("s_waitcnt vmcnt(0)" ::: "memory");
    __syncthreads();
    if (wave == 0 && lane_id() == 0) {
        GASP unsigned* barg = b.bar; unsigned bx = b.x; asm volatile("" : "+s"(barg), "+s"(bx)); unsigned* bar = (unsigned*)barg;
        __builtin_amdgcn_s_waitcnt(0);
        unsigned nloc = b.st[0], nx = b.st[1];
        if (nloc == 0u) { xcd_barrier_complete(bar, bx, nloc, nx); b.st[0] = nloc; b.st[1] = nx; }
        const unsigned old = xb_add(&bar[XB_XSUB(bx)], 1u);
        const unsigned gen = old / nloc;
        if (old + 1u == (gen + 1u) * nloc) {
            __builtin_amdgcn_fence(__ATOMIC_RELEASE, "agent");
            asm volatile("s_waitcnt vmcnt(0)" ::: "memory");
            const unsigned og = xb_add(&bar[XB_TOP], 1u);
            const unsigned tg = og / nx;
            if (og + 1u == (tg + 1u) * nx) xb_add(&bar[XB_TOPGEN], 1u);
            else XB_SPIN(xb_ld(&bar[XB_TOPGEN]) == tg, bar);
            __builtin_amdgcn_fence(__ATOMIC_ACQUIRE, "agent");
            xb_add(&bar[XB_XGEN(bx)], 1u);
            asm volatile("s_waitcnt vmcnt(0)" ::: "memory");
        } else {
            XB_SPIN(xb_ld(&bar[XB_XGEN(bx)]) == gen, bar);
            __builtin_amdgcn_fence(__ATOMIC_ACQUIRE, "agent");
            asm volatile("s_waitcnt vmcnt(0)" ::: "memory");
        }
    }
    __syncthreads();
}

struct Frame {
    LAS unsigned char* lds;
    volatile LAS unsigned* MISC;
    unsigned* ctl;
    int tid, lane, wave, G, bid;
    GASP unsigned char* ws;
    GASP float* out;
};
struct Args { const float* in[27]; float* out; unsigned char* ws; };
typedef const unsigned char __attribute__((address_space(4)))* kptr_t;
DI const float* in_ptr(int k) { kptr_t p = (kptr_t)__builtin_amdgcn_kernarg_segment_ptr(); asm volatile("" : "+s"(p)); return (const float*)(*(GASP const float* const __attribute__((address_space(4)))*)(p + 8 * k)); }
struct ArgsRef { struct Acc { DI const float* operator[](int k) const { return in_ptr(k); } } in; };

DI void conv_item(const float* W, int ldw, int k0, int c0, bf16* drow0, int K, LAS float* scr, int lane) {
#pragma unroll 8
    for (int i = 0; i < 32; ++i) { const int kk = 2 * i + (lane >> 5); scr[kk * 33 + (lane & 31)] = W[(size_t)(k0 + kk) * ldw + c0 + (lane & 31)]; }
    LDS_WAIT();
    const int c = lane & 7;
#pragma unroll
    for (int j = 0; j < 4; ++j) { const int n = (lane >> 3) + 8 * j; const LAS float* s = scr + (8 * c) * 33 + n;
        u32x4 o; o.x = pk2(s[0 * 33], s[1 * 33]); o.y = pk2(s[2 * 33], s[3 * 33]); o.z = pk2(s[4 * 33], s[5 * 33]); o.w = pk2(s[6 * 33], s[7 * 33]);
        *(u32x4*)(drow0 + (size_t)n * K + k0 + 8 * c) = o; }
    LDS_WAIT();
}
template <int MAP>
DI void conv_job(Frame& F, const float* s1, const float* s2, bf16* dst, int K, int ldw, int nblk, int nexp) {
    LAS float* scr = (LAS float*)(F.lds + F.wave * 16384);
    const int gw = F.bid * NWAVES + F.wave, NGW = F.G * NWAVES;
    const int per = (K / 64) * nblk, total = per * nexp;
    for (int it = gw; it < total; it += NGW) {
        const int e = it / per, r = it - e * per, kb = r / nblk, nb = r - kb * nblk;
        const float* src = s1; int c0;
        if (MAP == 0) c0 = 32 * nb;
        else { const int pn = nb >> 3, bj = (nb >> 2) & 1, wc = nb & 3;
            if (MAP == 1) c0 = 256 * pn + 64 * wc + 32 * bj; else { c0 = 128 * pn + 32 * wc; if (bj) src = s2; } }
        conv_item(src + (size_t)e * K * ldw, ldw, 64 * kb, c0, dst + ((size_t)e * nblk * 32 + (size_t)nb * 32) * K, K, scr, F.lane);
    }
}
DI void conv_layer(Frame& F, const ArgsRef& a, int L) {
    FRESH(F);
    bf16* Wb = (bf16*)(F.ws + WS_W);
    const int i = L >> 1;
    if ((L & 1) == 0) {
        conv_job<1>(F, a.in[3] + (size_t)i * D * INW, nullptr, (bf16*)((char*)Wb + W_IN), D, INW, INW / 32, 1);
        conv_job<0>(F, a.in[9] + (size_t)i * D * D, nullptr, (bf16*)((char*)Wb + W_OUT), D, D, D / 32, 1);
        conv_job<2>(F, a.in[10] + (size_t)i * D * FF, a.in[11] + (size_t)i * D * FF, (bf16*)((char*)Wb + W_GU), D, FF, 2 * FF / 32, 1);
        conv_job<0>(F, a.in[12] + (size_t)i * FF * D, nullptr, (bf16*)((char*)Wb + W_DN), FF, D, D / 32, 1);
        const float* sw = a.in[5] + (size_t)i * 8 * 128 * 128; bf16* dw = (bf16*)(F.ws + WS_SGUW);
        for (int idx = F.bid * 512 + F.tid; idx < 8 * 128 * 128 / 4; idx += F.G * 512) { const f32x4 v = *(const f32x4*)(sw + 4 * idx); u32x2 o; o.x = pk2(v[0], v[1]); o.y = pk2(v[2], v[3]); *(u32x2*)(dw + 4 * idx) = o; }
    } else {
        conv_job<2>(F, a.in[21] + (size_t)i * D * D, a.in[22] + (size_t)i * D * D, (bf16*)((char*)Wb + W_GLU), D, D, 2 * D / 32, 1);
        conv_job<2>(F, a.in[24] + (size_t)i * NE * D * FF, a.in[25] + (size_t)i * NE * D * FF, (bf16*)((char*)Wb + W_MGU), D, FF, 2 * FF / 32, NE);
        conv_job<0>(F, a.in[26] + (size_t)i * NE * FF * D, nullptr, (bf16*)((char*)Wb + W_MDN), FF, D, D / 32, NE);
    }
}

DI void prologue(Frame& F, const ArgsRef& a) {
    FRESH(F);
    const float* x = a.in[0]; bf16* XB = (bf16*)(F.ws + WS_XB);
    const size_t nthr = (size_t)F.G * 512, t0 = (size_t)F.bid * 512 + F.tid;
    for (size_t i = t0; i < (size_t)T * D / 8; i += nthr) { const f32x4 v0 = *(const f32x4*)(x + 8 * i), v1 = *(const f32x4*)(x + 8 * i + 4); *(u32x4*)(XB + 8 * i) = pg8::pack8(v0, v1); }
    float* cosT = (float*)(F.ws + WS_ROPE); float* sinT = cosT + SEQ * 32;
    for (size_t i = t0; i < (size_t)SEQ * 32; i += nthr) { const int pos = (int)(i >> 5), d = (int)(i & 31);
        const float invf = (float)exp_d(-(double)(2 * d) * (9.2103403719761836 / 64.0));
        const float ang = (float)pos * invf; double s, c; sincos_d((double)ang, s, c); cosT[i] = (float)c; sinT[i] = (float)s; }
}

DI void ln_core(f32x4 (&v)[4], const f32x4 (&g)[4], const f32x4 (&b)[4]) {
    float s = 0.f;
#pragma unroll
    for (int j = 0; j < 4; ++j) s += (v[j][0] + v[j][1]) + (v[j][2] + v[j][3]);
    const float mean = wave_sum(s) * (1.0f / D); float q = 0.f;
#pragma unroll
    for (int j = 0; j < 4; ++j) { v[j] = v[j] - mean; q += (v[j][0] * v[j][0] + v[j][1] * v[j][1]) + (v[j][2] * v[j][2] + v[j][3] * v[j][3]); }
    const float rstd = 1.0f / sqrtf(wave_sum(q) * (1.0f / D) + LN_EPS);
#pragma unroll
    for (int j = 0; j < 4; ++j) v[j] = v[j] * rstd * g[j] + b[j];
}
DI void ln_store(const f32x4 (&v)[4], bf16* XB, size_t row, int lane) {
#pragma unroll
    for (int j = 0; j < 4; ++j) { u32x2 o; o.x = pk2(v[j][0], v[j][1]); o.y = pk2(v[j][2], v[j][3]); *(u32x2*)(XB + row * D + 4 * lane + 256 * j) = o; }
}
DI void ln_load(f32x4 (&v)[4], const bf16* Y, size_t row, int lane) {
#pragma unroll
    for (int j = 0; j < 4; ++j) { const u32x2 yv = *(const u32x2*)(Y + row * D + 4 * lane + 256 * j); v[j] = (f32x4){bf_lo(yv.x), bf_hi(yv.x), bf_lo(yv.y), bf_hi(yv.y)}; }
}
DI void ln_pass_plain(Frame& F, const float* g_, const float* b_) {
    FRESH(F);
    const bf16* Y = (const bf16*)(F.ws + WS_Y); bf16* XB = (bf16*)(F.ws + WS_XB);
    f32x4 g[4], b[4];
#pragma unroll
    for (int j = 0; j < 4; ++j) { g[j] = *(const f32x4*)(g_ + 4 * F.lane + 256 * j); b[j] = *(const f32x4*)(b_ + 4 * F.lane + 256 * j); }
    const int gw = F.bid * NWAVES + F.wave, NGW = F.G * NWAVES;
    for (int row = gw; row < T; row += NGW) {
        f32x4 v[4]; ln_load(v, Y, (size_t)row, F.lane);
        ln_core(v, g, b);
        ln_store(v, XB, (size_t)row, F.lane);
    }
}
DI void ln_pass_router(Frame& F, const float* g_, const float* b_, const float* rw_, unsigned* cnt, const size_t rec_off) {
    FRESH(F);
    const bf16* Y = (const bf16*)(F.ws + WS_Y); bf16* XB = (bf16*)(F.ws + WS_XB);
    i32x4* RECI = (i32x4*)(F.ws + WS_RECI + rec_off); f32x2* RECW = (f32x2*)(F.ws + WS_RECW + rec_off);
    LAS int* lcnt = (LAS int*)(F.lds); LAS int* lbase = lcnt + 8;
    LAS int* re0 = lcnt + 64; LAS int* re1 = re0 + 256; LAS int* rp0 = re1 + 256; LAS int* rp1 = rp0 + 256; LAS float* rw0 = (LAS float*)(rp1 + 256); LAS float* rw1 = rw0 + 256;
    f32x4 g[4], b[4];
#pragma unroll
    for (int j = 0; j < 4; ++j) { g[j] = *(const f32x4*)(g_ + 4 * F.lane + 256 * j); b[j] = *(const f32x4*)(b_ + 4 * F.lane + 256 * j); }
    f32x4 rwa[4][4], rwb[4][4];
#pragma unroll
    for (int j = 0; j < 4; ++j)
#pragma unroll
        for (int c = 0; c < 4; ++c) { const float* p = rw_ + (size_t)(4 * F.lane + 256 * j + c) * 8; rwa[j][c] = *(const f32x4*)p; rwb[j][c] = *(const f32x4*)(p + 4); }
    for (int pnl = F.bid; pnl < T / 256; pnl += F.G) {
        if (F.tid < 8) lcnt[F.tid] = 0;
        __syncthreads();
        for (int rr = 0; rr < 32; ++rr) {
            const int lr = F.wave + 8 * rr; const size_t row = (size_t)pnl * 256 + lr;
            f32x4 v[4]; ln_load(v, Y, row, F.lane);
            ln_core(v, g, b);
            ln_store(v, XB, row, F.lane);
            f32x4 la = {0.f, 0.f, 0.f, 0.f}, lb = {0.f, 0.f, 0.f, 0.f};
#pragma unroll
            for (int j = 0; j < 4; ++j)
#pragma unroll
                for (int c = 0; c < 4; ++c) { la += rwa[j][c] * v[j][c]; lb += rwb[j][c] * v[j][c]; }
            float lg[8];
#pragma unroll
            for (int e = 0; e < 4; ++e) { lg[e] = wave_sum(la[e]); lg[4 + e] = wave_sum(lb[e]); }
            int i0 = 0; float l0 = lg[0];
#pragma unroll
            for (int e = 1; e < 8; ++e) if (lg[e] > l0) { l0 = lg[e]; i0 = e; }
            int i1 = -1; float l1 = -3.0e38f;
#pragma unroll
            for (int e = 0; e < 8; ++e) if (e != i0 && lg[e] > l1) { l1 = lg[e]; i1 = e; }
            const float w0 = 1.0f / (1.0f + __expf(l1 - l0)), w1 = 1.0f - w0;
            if (F.lane == 0) { const int p0 = atomicAdd((int*)(lcnt + i0), 1), p1 = atomicAdd((int*)(lcnt + i1), 1);
                re0[lr] = i0; re1[lr] = i1; rp0[lr] = p0; rp1[lr] = p1; rw0[lr] = w0; rw1[lr] = w1; }
        }
        __syncthreads();
        if (F.tid < 8) lbase[F.tid] = (int)xb_add(cnt + F.tid, (unsigned)lcnt[F.tid]);
        __syncthreads();
        if (F.tid < 256) { const int e0 = re0[F.tid], e1 = re1[F.tid]; const size_t row = (size_t)pnl * 256 + F.tid;
            RECI[row] = (i32x4){e0, lbase[e0] + rp0[F.tid], e1, lbase[e1] + rp1[F.tid]}; RECW[row] = (f32x2){rw0[F.tid], rw1[F.tid]}; }
        __syncthreads();
    }
}
DI void moe_tiles(const unsigned* cnt, int (&tb)[9], int (&cn)[8]) {
    int acc = 0;
#pragma unroll
    for (int e = 0; e < 8; ++e) { cn[e] = __builtin_amdgcn_readfirstlane((int)__hip_atomic_load(cnt + e, __ATOMIC_RELAXED, __HIP_MEMORY_SCOPE_AGENT)); tb[e] = acc; acc += (cn[e] + 255) >> 8; }
    tb[8] = acc;
}
DI void moe_gather(Frame& F, const unsigned* cnt) {
    FRESH(F);
    int tb[9], cn[8]; moe_tiles(cnt, tb, cn);
    const bf16* XB = (const bf16*)(F.ws + WS_XB); bf16* XS = (bf16*)(F.ws + WS_XS); const i32x4* RECI = (const i32x4*)(F.ws + WS_RECI);
    const int gw = F.bid * NWAVES + F.wave, NGW = F.G * NWAVES;
    for (int t = gw; t < T; t += NGW) {
        const i32x4 r = RECI[t];
        int b0 = 0, b1 = 0;
#pragma unroll
        for (int e = 0; e < 8; ++e) { b0 = (r[0] == e) ? tb[e] : b0; b1 = (r[2] == e) ? tb[e] : b1; }
        const size_t r0 = (size_t)b0 * 256 + r[1], r1 = (size_t)b1 * 256 + r[3];
        const u32x4 v0 = *(const u32x4*)(XB + (size_t)t * D + 8 * F.lane), v1 = *(const u32x4*)(XB + (size_t)t * D + 512 + 8 * F.lane);
        *(u32x4*)(XS + r0 * D + 8 * F.lane) = v0; *(u32x4*)(XS + r0 * D + 512 + 8 * F.lane) = v1;
        *(u32x4*)(XS + r1 * D + 8 * F.lane) = v0; *(u32x4*)(XS + r1 * D + 512 + 8 * F.lane) = v1;
    }
#pragma unroll
    for (int e = 0; e < 8; ++e) { const int first = tb[e] * 256 + cn[e], last = tb[e + 1] * 256;
        for (int r = first + gw; r < last; r += NGW) { const u32x4 z = {0u, 0u, 0u, 0u}; *(u32x4*)(XS + (size_t)r * D + 8 * F.lane) = z; *(u32x4*)(XS + (size_t)r * D + 512 + 8 * F.lane) = z; } }
}
DI void ln_pass_combine(Frame& F, const float* g_, const float* b_, const unsigned* cnt, const bool final_, const bool dummy_) {
    FRESH(F);
    int tb[9], cn[8]; moe_tiles(cnt, tb, cn);
    const bf16* YS = (const bf16*)(F.ws + WS_YS); bf16* XB = (bf16*)(F.ws + WS_XB); float* X = (float*)F.out;
    const i32x4* RECI = (const i32x4*)(F.ws + WS_RECI); const f32x2* RECW = (const f32x2*)(F.ws + WS_RECW);
    f32x4 g[4], b[4];
#pragma unroll
    for (int j = 0; j < 4; ++j) { g[j] = *(const f32x4*)(g_ + 4 * F.lane + 256 * j); b[j] = *(const f32x4*)(b_ + 4 * F.lane + 256 * j); }
    const int gw = F.bid * NWAVES + F.wave, NGW = F.G * NWAVES;
    for (int row = gw; row < T; row += NGW) {
        const i32x4 r = RECI[row]; const f32x2 w = RECW[row];
        int b0 = 0, b1 = 0;
#pragma unroll
        for (int e = 0; e < 8; ++e) { b0 = (r[0] == e) ? tb[e] : b0; b1 = (r[2] == e) ? tb[e] : b1; }
        const size_t r0 = (size_t)b0 * 256 + r[1], r1 = (size_t)b1 * 256 + r[3];
        f32x4 v[4];
#pragma unroll
        for (int j = 0; j < 4; ++j) { const u32x2 xv = *(const u32x2*)(XB + (size_t)row * D + 4 * F.lane + 256 * j);
            const u32x2 ya = *(const u32x2*)(YS + r0 * D + 4 * F.lane + 256 * j), yb = *(const u32x2*)(YS + r1 * D + 4 * F.lane + 256 * j);
            v[j][0] = ALPHA * bf_lo(xv.x) + (w[0] * bf_lo(ya.x) + w[1] * bf_lo(yb.x)); v[j][1] = ALPHA * bf_hi(xv.x) + (w[0] * bf_hi(ya.x) + w[1] * bf_hi(yb.x));
            v[j][2] = ALPHA * bf_lo(xv.y) + (w[0] * bf_lo(ya.y) + w[1] * bf_lo(yb.y)); v[j][3] = ALPHA * bf_hi(xv.y) + (w[0] * bf_hi(ya.y) + w[1] * bf_hi(yb.y)); }
        ln_core(v, g, b);
        if (dummy_) ln_store(v, (bf16*)(F.ws + WS_XS), (size_t)row, F.lane);
        else if (final_) {
#pragma unroll
            for (int j = 0; j < 4; ++j) *(f32x4*)(X + (size_t)row * D + 4 * F.lane + 256 * j) = v[j];
        } else ln_store(v, XB, (size_t)row, F.lane);
    }
}

constexpr int KL_STRIDE = 144, VT_STRIDE = 776, VT_OFF = 384 * KL_STRIDE;
DI void attn_phase(Frame& F, const float* sink) {
    FRESH(F);
    const bf16* Q = (const bf16*)(F.ws + WS_Q); const bf16* Kb = (const bf16*)(F.ws + WS_K); const bf16* Vb = (const bf16*)(F.ws + WS_V); bf16* MIX = (bf16*)(F.ws + WS_MIX);
    LAS unsigned char* Kl = F.lds; LAS unsigned char* Vt = F.lds + VT_OFF;
    const int lane = F.lane, l31 = lane & 31, h = lane >> 5, w = F.wave;
    for (int unit = F.bid; unit < BATCH * 2 * 16; unit += F.G) {
        const int b = unit >> 5, kvh = (unit >> 4) & 1, n = unit & 15;
        __syncthreads();
        for (int idx = F.tid; idx < 384 * 8; idx += 512) {
            const int key = idx >> 3, ch = idx & 7, kp = (n - 1) * 128 + key;
            u32x4 kv = {0u, 0u, 0u, 0u}, vv = {0u, 0u, 0u, 0u};
            if (kp >= 0 && kp < SEQ) { const size_t off = (size_t)(b * SEQ + kp) * 128 + kvh * 64 + ch * 8; kv = *(const u32x4*)(Kb + off); vv = *(const u32x4*)(Vb + off); }
            *(LAS u32x4*)(Kl + key * KL_STRIDE + ch * 16) = kv;
            LAS unsigned short* vd = (LAS unsigned short*)(Vt + (ch * 8) * VT_STRIDE + key * 2);
            constexpr int RS = VT_STRIDE / 2;
            vd[0 * RS] = (unsigned short)(vv.x & 0xffffu); vd[1 * RS] = (unsigned short)(vv.x >> 16); vd[2 * RS] = (unsigned short)(vv.y & 0xffffu); vd[3 * RS] = (unsigned short)(vv.y >> 16);
            vd[4 * RS] = (unsigned short)(vv.z & 0xffffu); vd[5 * RS] = (unsigned short)(vv.z >> 16); vd[6 * RS] = (unsigned short)(vv.w & 0xffffu); vd[7 * RS] = (unsigned short)(vv.w >> 16);
        }
        __syncthreads();
        const int hq = kvh * 4 + (w >> 1);
        const float m0 = sink[hq] * LOG2E;
        for (int qb = 0; qb < 2; ++qb) {
            const int q0 = 64 * (w & 1) + 32 * qb;
            const size_t qrow = (size_t)(b * SEQ + n * 128 + q0 + l31);
            bf16x8 bq[4];
#pragma unroll
            for (int ks = 0; ks < 4; ++ks) bq[ks] = *(const bf16x8*)(Q + qrow * 512 + hq * 64 + 16 * ks + 8 * h);
            float m2 = m0, l = 1.0f;
            f32x16 O0, O1;
#pragma unroll
            for (int i = 0; i < 16; ++i) { O0[i] = 0.f; O1[i] = 0.f; }
            const int kt0 = q0 >> 5, qk = q0 + l31;
            for (int kt = kt0; kt <= kt0 + 8; ++kt) {
                f32x16 X;
#pragma unroll
                for (int i = 0; i < 16; ++i) X[i] = 0.f;
#pragma unroll
                for (int ks = 0; ks < 4; ++ks) { const bf16x8 a = *(const LAS bf16x8*)(Kl + (32 * kt + l31) * KL_STRIDE + (16 * ks + 8 * h) * 2); X = MFMA32(a, bq[ks], X); }
                float mx = -1.0e30f;
#pragma unroll
                for (int i = 0; i < 16; ++i) { const int kk = 32 * kt + crow(i, h); const int kp = (n - 1) * 128 + kk;
                    const bool valid = (kk >= qk) && (kk <= qk + 256) && (kp >= 0) && (kp < SEQ);
                    X[i] = valid ? X[i] : -1.0e30f; mx = fmaxf(mx, X[i]); }
                mx = max_x32(mx);
                const float mn = fmaxf(m2, mx), alpha = fast_exp2(m2 - mn); m2 = mn;
                float ps = 0.f;
#pragma unroll
                for (int i = 0; i < 16; ++i) { X[i] = fast_exp2(X[i] - mn); ps += X[i]; }
                ps = sum_x32(ps);
                l = l * alpha + ps;
#pragma unroll
                for (int i = 0; i < 16; ++i) { O0[i] *= alpha; O1[i] *= alpha; }
#pragma unroll
                for (int s = 0; s < 2; ++s) {
                    u32x4 pw; pw.x = pk2(X[8 * s + 0], X[8 * s + 1]); pw.y = pk2(X[8 * s + 2], X[8 * s + 3]); pw.z = pk2(X[8 * s + 4], X[8 * s + 5]); pw.w = pk2(X[8 * s + 6], X[8 * s + 7]);
                    const bf16x8 pf = __builtin_bit_cast(bf16x8, pw);
                    const int kb = (32 * kt + 16 * s + 4 * h) * 2;
                    { const s16x4 lo = *(const LAS s16x4*)(Vt + l31 * VT_STRIDE + kb), hi = *(const LAS s16x4*)(Vt + l31 * VT_STRIDE + kb + 16);
                      O0 = MFMA32(__builtin_shufflevector(lo, hi, 0, 1, 2, 3, 4, 5, 6, 7), pf, O0); }
                    { const s16x4 lo = *(const LAS s16x4*)(Vt + (32 + l31) * VT_STRIDE + kb), hi = *(const LAS s16x4*)(Vt + (32 + l31) * VT_STRIDE + kb + 16);
                      O1 = MFMA32(__builtin_shufflevector(lo, hi, 0, 1, 2, 3, 4, 5, 6, 7), pf, O1); }
                }
            }
            const float inv = 1.0f / l;
            bf16* orow = MIX + qrow * D + hq * 64;
#pragma unroll
            for (int g4 = 0; g4 < 4; ++g4) {
                u32x2 o; o.x = pk2(O0[4 * g4] * inv, O0[4 * g4 + 1] * inv); o.y = pk2(O0[4 * g4 + 2] * inv, O0[4 * g4 + 3] * inv); *(u32x2*)(orow + 8 * g4 + 4 * h) = o;
                u32x2 p; p.x = pk2(O1[4 * g4] * inv, O1[4 * g4 + 1] * inv); p.y = pk2(O1[4 * g4 + 2] * inv, O1[4 * g4 + 3] * inv); *(u32x2*)(orow + 32 + 8 * g4 + 4 * h) = p;
            }
        }
    }
    __syncthreads();
}

constexpr int SG_STRIDE = 272;
DI void sgu_phase(Frame& F, const float* sgu_b) {
    FRESH(F);
    const bf16* ZU = (const bf16*)(F.ws + WS_ZU); const bf16* ZV = (const bf16*)(F.ws + WS_ZV); const bf16* Wsb = (const bf16*)(F.ws + WS_SGUW); bf16* MIX = (bf16*)(F.ws + WS_MIX);
    LAS unsigned char* VT = F.lds + F.wave * (32 * SG_STRIDE);
    const int lane = F.lane, l31 = lane & 31, h = lane >> 5;
    const int gw = F.bid * NWAVES + F.wave, NGW = F.G * NWAVES;
    for (int su = gw; su < BATCH * 16 * 8 * 2; su += NGW) {
        const int dh = su & 1, g = (su >> 1) & 7, n = (su >> 4) & 15, b = su >> 8;
        const size_t rowb = (size_t)(b * SEQ + n * 128);
#pragma unroll
        for (int i = 0; i < 8; ++i) { const int c = lane + 64 * i, q = c >> 2, ch = c & 3;
            const u32x4 vv = *(const u32x4*)(ZV + (rowb + q) * 512 + 64 * g + 32 * dh + 8 * ch);
            LAS unsigned short* vd = (LAS unsigned short*)(VT + (ch * 8) * SG_STRIDE + q * 2);
            constexpr int RS = SG_STRIDE / 2;
            vd[0 * RS] = (unsigned short)(vv.x & 0xffffu); vd[1 * RS] = (unsigned short)(vv.x >> 16); vd[2 * RS] = (unsigned short)(vv.y & 0xffffu); vd[3 * RS] = (unsigned short)(vv.y >> 16);
            vd[4 * RS] = (unsigned short)(vv.z & 0xffffu); vd[5 * RS] = (unsigned short)(vv.z >> 16); vd[6 * RS] = (unsigned short)(vv.w & 0xffffu); vd[7 * RS] = (unsigned short)(vv.w >> 16); }
        bf16x8 af[8];
#pragma unroll
        for (int ks = 0; ks < 8; ++ks) af[ks] = *(const LAS bf16x8*)(VT + l31 * SG_STRIDE + (16 * ks + 8 * h) * 2);
#pragma unroll
        for (int pt = 0; pt < 4; ++pt) {
            const int p = 32 * pt + l31;
            f32x16 acc;
#pragma unroll
            for (int i = 0; i < 16; ++i) acc[i] = 0.f;
#pragma unroll
            for (int ks = 0; ks < 8; ++ks) { const bf16x8 bw = *(const bf16x8*)(Wsb + ((size_t)g * 128 + p) * 128 + 16 * ks + 8 * h); acc = MFMA32(af[ks], bw, acc); }
            const float bias = sgu_b[g * 128 + p];
            const size_t row = rowb + p;
#pragma unroll
            for (int g4 = 0; g4 < 4; ++g4) { const int d = 32 * dh + 8 * g4 + 4 * h;
                const u32x2 uu = *(const u32x2*)(ZU + row * 512 + 64 * g + d);
                u32x2 o; o.x = pk2(bf_lo(uu.x) * (acc[4 * g4] + bias), bf_hi(uu.x) * (acc[4 * g4 + 1] + bias)); o.y = pk2(bf_lo(uu.y) * (acc[4 * g4 + 2] + bias), bf_hi(uu.y) * (acc[4 * g4 + 3] + bias));
                *(u32x2*)(MIX + row * D + 512 + 64 * g + d) = o; }
        }
        LDS_WAIT();
    }
}

constexpr int S5_STRIDE = 272;
DI void sincos_f(float th, float& s, float& c) {
    const float tq = th * 0.636619772367581f, q = rintf(tq), f = (tq - q) * 1.5707963267948966f, f2 = f * f;
    const float sp = f * (1.0f + f2 * (-1.6666667e-1f + f2 * (8.3333333e-3f + f2 * (-1.9841270e-4f + f2 * 2.7557319e-6f))));
    const float cp = 1.0f + f2 * (-0.5f + f2 * (4.1666667e-2f + f2 * (-1.3888889e-3f + f2 * (2.4801587e-5f + f2 * (-2.7557319e-7f)))));
    const int qi = ((int)q) & 3;
    s = (qi == 0) ? sp : (qi == 1) ? cp : (qi == 2) ? -sp : -cp;
    c = (qi == 0) ? cp : (qi == 1) ? -sp : (qi == 2) ? -cp : sp;
}
DI void zoh_params(float lr, float li, float logdt, float& br, float& bi, float& cr, float& ci) {
    const float dt = expf(logdt);
    const float ea = expf(lr * dt);
    float sn, cs; sincos_f(li * dt, sn, cs);
    br = ea * cs; bi = ea * sn;
    const float nr = br - 1.0f, rden = 1.0f / (lr * lr + li * li);
    cr = (nr * lr + bi * li) * rden; ci = (bi * lr - nr * li) * rden;
}
DI void s5_phase(Frame& F, const ArgsRef& a, int i) {
    FRESH(F);
    const bf16* XB = (const bf16*)(F.ws + WS_XB); float* YF = (float*)(F.ws + WS_YF); bf16* YG = (bf16*)(F.ws + WS_YG);
    LAS unsigned char* xs = F.lds + F.wave * (32 * S5_STRIDE);
    const int lane = F.lane, l31 = lane & 31, h = lane >> 5, l15 = lane & 15, q4 = lane >> 4;
    const int gw = F.bid * NWAVES + F.wave, NGW = F.G * NWAVES;
    for (int unit = gw; unit < BATCH * 64; unit += NGW) {
        const int b = unit >> 6, g = unit & 63;
        const f32x4 dsk = *(const f32x4*)(a.in[20] + ((size_t)i * 64 + g) * 16 + 4 * q4);
#pragma unroll 1
        for (int dir = 0; dir < 2; ++dir) {
            const size_t pg = ((size_t)(i * 2 + dir) * 64 + g);
            const float logdt = a.in[15][pg];
            float lbr, lbi, cr_, ci_;
            zoh_params(a.in[13][pg * 64 + lane], a.in[14][pg * 64 + lane], logdt, lbr, lbi, cr_, ci_);
            bf16x8 fre[2], fim[2];
#pragma unroll
            for (int ph = 0; ph < 2; ++ph) { const int pp = 32 * ph + l31; float tbr, tbi, tcr, tci;
                zoh_params(a.in[13][pg * 64 + pp], a.in[14][pg * 64 + pp], logdt, tbr, tbi, tcr, tci);
                const float* brp = a.in[16] + (pg * 64 + pp) * 16 + 8 * h; const float* bip = a.in[17] + (pg * 64 + pp) * 16 + 8 * h;
                const f32x4 r0 = *(const f32x4*)brp, r1 = *(const f32x4*)(brp + 4), m0 = *(const f32x4*)bip, m1 = *(const f32x4*)(bip + 4);
                const f32x4 re0 = r0 * tcr - m0 * tci, re1 = r1 * tcr - m1 * tci, im0 = m0 * tcr + r0 * tci, im1 = m1 * tcr + r1 * tci;
                fre[ph] = __builtin_bit_cast(bf16x8, pg8::pack8(re0, re1)); fim[ph] = __builtin_bit_cast(bf16x8, pg8::pack8(im0, im1)); }
            bf16x8 cf[4];
#pragma unroll
            for (int ks = 0; ks < 4; ++ks) { const size_t co = (pg * 16 + l15) * 64 + 16 * ks + 4 * q4;
                const f32x4 cre = *(const f32x4*)(a.in[18] + co), cim = *(const f32x4*)(a.in[19] + co);
                u32x4 wv; wv.x = pk2(cre[0], -cim[0]); wv.y = pk2(cre[1], -cim[1]); wv.z = pk2(cre[2], -cim[2]); wv.w = pk2(cre[3], -cim[3]);
                cf[ks] = __builtin_bit_cast(bf16x8, wv); }
            float xr = 0.f, xi = 0.f;
            bf16x8 au_n = *(const bf16x8*)(XB + ((size_t)(b * SEQ + 32 * (dir ? 63 : 0)) + l31) * D + 16 * g + 8 * h);
#pragma unroll 1
            for (int ci2 = 0; ci2 < 64; ++ci2) {
                const int cidx = dir ? 63 - ci2 : ci2, s0 = 32 * cidx;
                const size_t rowb = (size_t)(b * SEQ + s0);
                const bf16x8 au = au_n;
                { const int nci = (ci2 < 63) ? ci2 + 1 : ci2, ncidx = dir ? 63 - nci : nci;
                  au_n = *(const bf16x8*)(XB + ((size_t)(b * SEQ + 32 * ncidx) + l31) * D + 16 * g + 8 * h); }
                f32x4 yfp[2]; u32x2 uup[2];
                if (dir) {
#pragma unroll
                    for (int mt = 0; mt < 2; ++mt) { const size_t o = (rowb + 16 * mt + l15) * D + 16 * g + 4 * q4; yfp[mt] = *(const f32x4*)(YF + o); uup[mt] = *(const u32x2*)(XB + o); }
                } else { yfp[0] = yfp[1] = (f32x4){0.f, 0.f, 0.f, 0.f}; uup[0] = uup[1] = (u32x2){0u, 0u}; }
                f32x16 z16;
#pragma unroll
                for (int k = 0; k < 16; ++k) z16[k] = 0.f;
                f32x16 Pr0 = MFMA32(au, fre[0], z16), Pr1 = MFMA32(au, fre[1], z16), Pi0 = MFMA32(au, fim[0], z16), Pi1 = MFMA32(au, fim[1], z16);
                float rlo[16], rhi[16], ilo[16], ihi[16];
#pragma unroll
                for (int r = 0; r < 16; ++r) {
                    auto sr = __builtin_amdgcn_permlane32_swap(__float_as_uint(Pr0[r]), __float_as_uint(Pr1[r]), false, false); rlo[r] = __uint_as_float(sr[0]); rhi[r] = __uint_as_float(sr[1]);
                    auto si = __builtin_amdgcn_permlane32_swap(__float_as_uint(Pi0[r]), __float_as_uint(Pi1[r]), false, false); ilo[r] = __uint_as_float(si[0]); ihi[r] = __uint_as_float(si[1]); }
                if (dir == 0) {
#pragma unroll
                    for (int t = 0; t < 32; ++t) { const int r = (t & 3) + 4 * (t >> 3); const bool hh = (t >> 2) & 1;
                        const float ur = hh ? rhi[r] : rlo[r], ui = hh ? ihi[r] : ilo[r];
                        const float nr = lbr * xr - lbi * xi + ur, ni = lbr * xi + lbi * xr + ui; xr = nr; xi = ni;
                        *(LAS unsigned*)(xs + t * S5_STRIDE + 4 * lane) = pk2(xr, xi); }
                } else {
#pragma unroll
                    for (int t = 31; t >= 0; --t) { const int r = (t & 3) + 4 * (t >> 3); const bool hh = (t >> 2) & 1;
                        const float ur = hh ? rhi[r] : rlo[r], ui = hh ? ihi[r] : ilo[r];
                        const float nr = lbr * xr - lbi * xi + ur, ni = lbr * xi + lbi * xr + ui; xr = nr; xi = ni;
                        *(LAS unsigned*)(xs + t * S5_STRIDE + 4 * lane) = pk2(xr, xi); }
                }
#pragma unroll
                for (int mt = 0; mt < 2; ++mt) {
                    f32x4 y4 = {0.f, 0.f, 0.f, 0.f};
#pragma unroll
                    for (int ks = 0; ks < 4; ++ks) { const bf16x8 bx = *(const LAS bf16x8*)(xs + (16 * mt + l15) * S5_STRIDE + (32 * ks + 8 * q4) * 2); y4 = MFMA16(cf[ks], bx, y4); }
                    const size_t o = (rowb + 16 * mt + l15) * D + 16 * g + 4 * q4;
                    if (dir == 0) *(f32x4*)(YF + o) = y4;
                    else { const f32x4 yf = yfp[mt]; const u32x2 uu = uup[mt];
                        const f32x4 uv = {bf_lo(uu.x), bf_hi(uu.x), bf_lo(uu.y), bf_hi(uu.y)};
                        const f32x4 y = yf + y4 + dsk * uv;
                        u32x2 ov; ov.x = pk2(gelu_tanh(y[0]), gelu_tanh(y[1])); ov.y = pk2(gelu_tanh(y[2]), gelu_tanh(y[3])); *(u32x2*)(YG + o) = ov; }
                }
                LDS_WAIT();
            }
        }
    }
}

__global__ void __launch_bounds__(NWAVES * 64, 2) fwd_kernel(Args args_by_value) {
    extern __shared__ __attribute__((aligned(16))) unsigned char lds[];
    Frame F;
    F.lds = (LAS unsigned char*)lds;
    F.MISC = (volatile LAS unsigned*)(F.lds + MISC_OFF);
    F.tid = threadIdx.x; F.lane = F.tid & 63; F.wave = __builtin_amdgcn_readfirstlane(F.tid >> 6);
    F.G = gridDim.x; F.bid = blockIdx.x;
    { kptr_t kp = (kptr_t)__builtin_amdgcn_kernarg_segment_ptr(); F.out = *(GASP float* const __attribute__((address_space(4)))*)(kp + 8 * 27); F.ws = *(GASP unsigned char* const __attribute__((address_space(4)))*)(kp + 8 * 28); }
    F.ctl = (unsigned*)(F.ws + WS_CTL);
    const ArgsRef args{};
    for (int u = F.tid; u < (LDS_BYTES - LDSCTL_OFF) / 4; u += NWAVES * 64) ((LAS unsigned*)(F.lds + LDSCTL_OFF))[u] = 0u;
    __syncthreads();
    XcdBarrier bar = xcd_barrier_post((GASP unsigned*)(F.ws + WS_CTL) + CW_BAR, F.MISC + 8, F.tid == 0);
#define GRID_BAR() xcd_barrier(bar, F.wave)
#define XB ((bf16*)(F.ws + WS_XB))
#define Yb ((bf16*)(F.ws + WS_Y))
#define Wb ((const char*)(F.ws + WS_W))
#define cosT ((const float*)(F.ws + WS_ROPE))
#define sinT ((const float*)(F.ws + WS_ROPE) + SEQ * 32)

    RPT(4) PH(0) prologue(F, args);
    RPT(4) PH(1) conv_layer(F, args, 0);
    GRID_BAR();

#pragma unroll 1
    for (int lp = 0; lp < 2; ++lp) {
        {
            const int L = 2 * lp, i = lp;
            { UFRESH(F); pg8::Order S{}; S.nM = T / 256; S.nN = INW / 256; S.nwg = S.nM * S.nN; S.G = F.G; S.c = F.bid; S.A = (const char*)XB; S.Bt = Wb + W_IN; S.tstep = (size_t)256 * D * 2; S.estride = 0;
              RPT(0) PH(2) { pg8::EpiWin E{(bf16*)(F.ws + WS_Q), (bf16*)(F.ws + WS_K), (bf16*)(F.ws + WS_V), (bf16*)(F.ws + WS_ZU), (bf16*)(F.ws + WS_ZV), cosT, sinT, args.in[7] + (size_t)i * 512, args.in[8] + (size_t)i * 512};
              pg8::gemm_phase(F.lds, D, S, E, F.wave); } }
            GRID_BAR();
            RPT(2) PH(3) attn_phase(F, args.in[4] + (size_t)i * 8);
            RPT(2) PH(4) sgu_phase(F, args.in[6] + (size_t)i * 8 * 128);
            GRID_BAR();
            { UFRESH(F); pg8::Order S{}; S.nM = T / 256; S.nN = D / 256; S.nwg = S.nM * S.nN; S.G = F.G; S.c = F.bid; S.A = (const char*)(F.ws + WS_MIX); S.Bt = Wb + W_OUT; S.tstep = (size_t)256 * D * 2; S.estride = 0;
              pg8::EpiPlain E{Yb, D, XB};
              RPT(0) PH(10) pg8::gemm_phase(F.lds, D, S, E, F.wave); }
            GRID_BAR();
            RPT(5) PH(5) ln_pass_plain(F, args.in[1] + (size_t)(L * 2 + 0) * D, args.in[2] + (size_t)(L * 2 + 0) * D);
            GRID_BAR();
            { UFRESH(F); pg8::Order S{}; S.nM = T / 256; S.nN = 2 * FF / 256; S.nwg = S.nM * S.nN; S.G = F.G; S.c = F.bid; S.A = (const char*)XB; S.Bt = Wb + W_GU; S.tstep = (size_t)256 * D * 2; S.estride = 0;
              pg8::EpiPair<0> E{(bf16*)(F.ws + WS_H), FF, nullptr};
              RPT(0) PH(11) pg8::gemm_phase(F.lds, D, S, E, F.wave); }
            GRID_BAR();
            { UFRESH(F); pg8::Order S{}; S.nM = T / 256; S.nN = D / 256; S.nwg = S.nM * S.nN; S.G = F.G; S.c = F.bid; S.A = (const char*)(F.ws + WS_H); S.Bt = Wb + W_DN; S.tstep = (size_t)256 * FF * 2; S.estride = 0;
              pg8::EpiPlain E{Yb, D, XB};
              RPT(0) PH(10) pg8::gemm_phase(F.lds, FF, S, E, F.wave); }
            GRID_BAR();
            RPT(5) PH(5) ln_pass_plain(F, args.in[1] + (size_t)(L * 2 + 1) * D, args.in[2] + (size_t)(L * 2 + 1) * D);
            RPT(4) PH(1) conv_layer(F, args, L + 1);
            GRID_BAR();
        }
        {
            const int L = 2 * lp + 1, i = lp;
            unsigned* cnt = F.ctl + CW_CNT + 64 * i;
            RPT(3) PH(6) s5_phase(F, args, i);
            GRID_BAR();
            { UFRESH(F); pg8::Order S{}; S.nM = T / 256; S.nN = 2 * D / 256; S.nwg = S.nM * S.nN; S.G = F.G; S.c = F.bid; S.A = (const char*)(F.ws + WS_YG); S.Bt = Wb + W_GLU; S.tstep = (size_t)256 * D * 2; S.estride = 0;
              pg8::EpiPair<1> E{Yb, D, XB};
              RPT(0) PH(12) pg8::gemm_phase(F.lds, D, S, E, F.wave); }
            GRID_BAR();
            if ((RG >> 6) & 1) { PH(7) ln_pass_router(F, args.in[1] + (size_t)(L * 2 + 0) * D, args.in[2] + (size_t)(L * 2 + 0) * D, args.in[23] + (size_t)i * D * 8, cnt + 1024, WS_YS - WS_RECI); }
            PH(7) ln_pass_router(F, args.in[1] + (size_t)(L * 2 + 0) * D, args.in[2] + (size_t)(L * 2 + 0) * D, args.in[23] + (size_t)i * D * 8, cnt, 0);
            GRID_BAR();
            RPT(4) PH(8) moe_gather(F, cnt);
            GRID_BAR();
            {
                int tb[9], cn[8]; moe_tiles(cnt, tb, cn);
                const int ntt = tb[8], TC = 128, nch = (ntt + TC - 1) / TC;
RPT(1)
#pragma unroll 1
                for (int ch = 0; ch < nch; ++ch) {
                    const int t0 = ch * TC, t1 = (t0 + TC < ntt) ? t0 + TC : ntt, nM = (t1 > t0) ? t1 - t0 : 0;
                    { UFRESH(F); pg8::Order S{}; S.nM = nM; S.nN = 2 * FF / 256; S.nwg = S.nM * S.nN; S.G = F.G; S.c = F.bid; S.atile0 = t0; S.otile0 = 0; S.etile0 = t0;
                      S.A = (const char*)(F.ws + WS_XS); S.Bt = Wb + W_MGU; S.tstep = (size_t)256 * D * 2; S.estride = (size_t)2 * FF * D * 2;
#pragma unroll
                      for (int e = 0; e < 8; ++e) S.tb[e] = tb[e];
                      pg8::EpiPair<0> E{(bf16*)(F.ws + WS_HS), FF, nullptr};
                      PH(13) pg8::gemm_phase(F.lds, D, S, E, F.wave); }
                    GRID_BAR();
                    { UFRESH(F); pg8::Order S{}; S.nM = nM; S.nN = D / 256; S.nwg = S.nM * S.nN; S.G = F.G; S.c = F.bid; S.atile0 = 0; S.otile0 = t0; S.etile0 = t0;
                      S.A = (const char*)(F.ws + WS_HS); S.Bt = Wb + W_MDN; S.tstep = (size_t)256 * FF * 2; S.estride = (size_t)D * FF * 2;
#pragma unroll
                      for (int e = 0; e < 8; ++e) S.tb[e] = tb[e];
                      pg8::EpiPlain E{(bf16*)(F.ws + WS_YS), D, nullptr};
                      PH(14) pg8::gemm_phase(F.lds, FF, S, E, F.wave); }
                    GRID_BAR();
                }
            }
            if ((RG >> 7) & 1) { PH(9) ln_pass_combine(F, args.in[1] + (size_t)(L * 2 + 1) * D, args.in[2] + (size_t)(L * 2 + 1) * D, cnt, L == 3, true); }
            PH(9) ln_pass_combine(F, args.in[1] + (size_t)(L * 2 + 1) * D, args.in[2] + (size_t)(L * 2 + 1) * D, cnt, L == 3, false);
            if (L + 1 < 4) { RPT(4) PH(1) conv_layer(F, args, L + 1); GRID_BAR(); }
        }
    }
}

extern "C" void kernel_launch(void* const* d_in, const int* in_sizes, int n_in, void* d_out, int out_size, void* d_ws, size_t ws_size, hipStream_t stream) {
    static int grid = 0;
    if (grid == 0) {
        if (n_in != 27 || in_sizes[0] != T * D || out_size != T * D || ws_size < WS_END) {
            fprintf(stderr, "kernel_launch: unexpected shapes (n_in %d, in0 %d, out %d, ws %zu; need ws >= %zu); nothing launched\n", n_in, n_in > 0 ? in_sizes[0] : -1, out_size, ws_size, (size_t)WS_END); grid = -1; return; }
        int dev = 0, cus = 0, per_cu = 0;
        if (hipGetDevice(&dev) != hipSuccess || hipDeviceGetAttribute(&cus, hipDeviceAttributeMultiprocessorCount, dev) != hipSuccess) { grid = -1; return; }
        if (hipFuncSetAttribute((const void*)fwd_kernel, hipFuncAttributeMaxDynamicSharedMemorySize, LDS_BYTES) != hipSuccess) { fprintf(stderr, "kernel_launch: hipFuncSetAttribute failed\n"); grid = -1; return; }
        if (hipOccupancyMaxActiveBlocksPerMultiprocessor(&per_cu, (const void*)fwd_kernel, NWAVES * 64, LDS_BYTES) != hipSuccess || per_cu < 1)
            fprintf(stderr, "kernel_launch: note: occupancy query reports %d workgroups per CU\n", per_cu);
        (void)hipGetLastError();
        grid = cus;
    }
    if (grid < 0) return;
    if (hipMemsetAsync((char*)d_ws + WS_CTL, 0, CTL_ZERO_BYTES, stream) != hipSuccess) return;
    Args a{};
    for (int i = 0; i < 27; ++i) a.in[i] = (const float*)d_in[i];
    a.out = (float*)d_out; a.ws = (unsigned char*)d_ws;
    hipLaunchKernelGGL(fwd_kernel, dim3(grid), dim3(NWAVES * 64), LDS_BYTES, stream, a);
}
```

```cpp
#include <hip/hip_runtime.h>
#include <cstdio>
#include <cstdint>

#define LAS __attribute__((address_space(3)))
typedef unsigned short bf16;
typedef short bf16x8 __attribute__((ext_vector_type(8)));
typedef short s16x4 __attribute__((ext_vector_type(4)));
typedef float f32x4 __attribute__((ext_vector_type(4)));
typedef float f32x2 __attribute__((ext_vector_type(2)));
typedef float f32x16 __attribute__((ext_vector_type(16)));
typedef unsigned u32x4 __attribute__((ext_vector_type(4)));
typedef unsigned u32x2 __attribute__((ext_vector_type(2)));
typedef int i32x4 __attribute__((ext_vector_type(4)));
typedef int i32x8 __attribute__((ext_vector_type(8)));
typedef __bf16 bf2_t __attribute__((ext_vector_type(2)));
#define DI __device__ __forceinline__
#define GASP __attribute__((address_space(1)))
template <class T> DI T* as_global(T* p) { return (T*)(GASP T*)p; }
#ifndef PHM
#define PHM 0xFFFFF
#endif
#define PH(b) if (PHM & (1 << (b)))
#ifndef RG
#define RG 0
#endif
#define RPT(g) for (int rep_ = 0, nrep_ = rep_count(((RG) >> (g)) & 1); rep_ < nrep_; ++rep_)
#define UFRESH(F) do { asm volatile("" : "+s"((F).ws), "+s"((F).out), "+s"((F).G), "+s"((F).bid)); (F).ctl = (unsigned*)((F).ws + WS_CTL); } while (0)
#define FRESH(F) do { UFRESH(F); int l_ = lane_id(); asm volatile("" : "+v"(l_)); (F).lane = l_; (F).tid = (F).wave * 64 + l_; } while (0)

constexpr int NWAVES = 8;
constexpr int BATCH = 32, SEQ = 2048, D = 1024, T = BATCH * SEQ;
constexpr int INW = 1792, FF = 2816, NE = 8;
constexpr float ALPHA = 1.6817928305074290f;
constexpr float LN_EPS = 1e-5f;
constexpr float QSCALE = 0.18033688011112042f;
constexpr float LOG2E = 1.4426950408889634f;

constexpr size_t MiB = 1u << 20;
constexpr size_t WS_CTL = 0, CTL_ZERO_BYTES = 1 * MiB;
constexpr size_t WS_ROPE = 1 * MiB;
constexpr size_t WS_RECI = 2 * MiB;
constexpr size_t WS_RECW = 3 * MiB;
constexpr size_t WS_SGUW = 4 * MiB;
constexpr size_t WS_SX = 5 * MiB;
constexpr size_t WS_SW = 6 * MiB;
constexpr size_t WS_SXS = 7 * MiB;
constexpr size_t WS_W = 16 * MiB;
constexpr size_t WS_XB = 156 * MiB;
constexpr size_t WS_Y = 284 * MiB;
constexpr size_t WS_R = 412 * MiB;
constexpr size_t WS_Q = WS_R, WS_K = WS_Q + 64 * MiB, WS_V = WS_K + 16 * MiB, WS_ZU = WS_V + 16 * MiB, WS_ZV = WS_ZU + 64 * MiB, WS_MIX = WS_ZV + 64 * MiB;
constexpr size_t WS_H = WS_R;
constexpr size_t WS_YF = WS_R;
constexpr size_t WS_YG = WS_R + 256 * MiB;
constexpr int XS_ROWS = 2 * T + NE * 256;
constexpr int TC_MAX = 130;
constexpr size_t WS_XB8 = 768 * MiB;
constexpr size_t WS_XS = 284 * MiB;
constexpr size_t WS_HS = 416 * MiB;
constexpr size_t WS_YS = 600 * MiB;
constexpr size_t WS_END = 860 * MiB;
constexpr size_t W_IN = 0, W_OUT = 4 * MiB, W_GU = 6 * MiB, W_DN = 17 * MiB;
constexpr size_t W_GLU = 0, W_MGU = 4 * MiB, W_MDN = 48 * MiB;
constexpr int CW_TMO = 0, CW_DBG = 2, CW_BAR = 4096, CW_CNT = 8192;

constexpr int RING_BYTES = 131072;
constexpr int LDSCTL_OFF = RING_BYTES, MISC_OFF = LDSCTL_OFF + 320;
constexpr int LDS_BYTES = 147456;

DI unsigned pk2(float lo, float hi) { f32x2 v = {lo, hi}; return __builtin_bit_cast(unsigned, __builtin_convertvector(v, bf2_t)); }
DI unsigned q8(float v, float inv) { return __float_as_uint(__builtin_fmaf(v, inv, 12582912.0f)) & 0xffu; }
DI unsigned pk4_i8(float a, float b, float c, float d, float inv) { return q8(a, inv) | (q8(b, inv) << 8) | (q8(c, inv) << 16) | (q8(d, inv) << 24); }
DI float bf_lo(unsigned w) { return __uint_as_float(w << 16); }
DI float bf_hi(unsigned w) { return __uint_as_float(w & 0xffff0000u); }
DI float fast_exp2(float x) { return __builtin_amdgcn_exp2f(x); }
DI float fast_rcp(float x) { return __builtin_amdgcn_rcpf(x); }
DI float sigmoidf_(float x) { return fast_rcp(1.0f + fast_exp2(-LOG2E * x)); }
DI float gelu_tanh(float x) { const float z = x + 0.044715f * x * x * x; return x * fast_rcp(1.0f + fast_exp2(-2.302208198f * z)); }
#define dpp_f(v, ctrl) __int_as_float(__builtin_amdgcn_mov_dpp(__float_as_int(v), (ctrl), 0xf, 0xf, true))
#define DPP_XOR1 0xB1
#define DPP_XOR2 0x4E
#define DPP_HMIRROR 0x141
#define DPP_MIRROR 0x140
DI float swz16_f(float v) { return __int_as_float(__builtin_amdgcn_ds_swizzle(__float_as_int(v), 0x401F)); }
DI float sum_x32(float v) { auto r = __builtin_amdgcn_permlane32_swap(__float_as_uint(v), __float_as_uint(v), false, false); return __uint_as_float(r[0]) + __uint_as_float(r[1]); }
DI float max_x32(float v) { auto r = __builtin_amdgcn_permlane32_swap(__float_as_uint(v), __float_as_uint(v), false, false); return fmaxf(__uint_as_float(r[0]), __uint_as_float(r[1])); }
DI float wave_max(float v) {
    v = fmaxf(v, dpp_f(v, DPP_XOR1)); v = fmaxf(v, dpp_f(v, DPP_XOR2)); v = fmaxf(v, dpp_f(v, DPP_HMIRROR)); v = fmaxf(v, dpp_f(v, DPP_MIRROR)); v = fmaxf(v, swz16_f(v)); return max_x32(v);
}
DI float wave_sum(float v) {
    v += dpp_f(v, DPP_XOR1); v += dpp_f(v, DPP_XOR2); v += dpp_f(v, DPP_HMIRROR); v += dpp_f(v, DPP_MIRROR); v += swz16_f(v); return sum_x32(v);
}
#define LDS_WAIT() asm volatile("s_waitcnt lgkmcnt(0)" ::: "memory")
#define VM_WAIT() asm volatile("s_waitcnt vmcnt(0)" ::: "memory")
DI int lane_id() { unsigned ones = ~0u; asm volatile("" : "+s"(ones)); return (int)__builtin_amdgcn_mbcnt_hi(ones, __builtin_amdgcn_mbcnt_lo(ones, 0u)); }
DI int rep_count(int extra) { int n = 1 + extra; asm volatile("" : "+s"(n)); return n; }
DI int crow(int reg, int h) { return (reg & 3) + 8 * (reg >> 2) + 4 * h; }
#define MFMA32(a, b, c) __builtin_amdgcn_mfma_f32_32x32x16_bf16((a), (b), (c), 0, 0, 0)
#define MFMA16(a, b, c) __builtin_amdgcn_mfma_f32_16x16x32_bf16((a), (b), (c), 0, 0, 0)

DI void sincos_d(double th, double& s, double& c) {
    const double tq = th * 0.63661977236758134308;
    const double q = rint(tq);
    const double f = (tq - q) * 1.57079632679489661923;
    const double f2 = f * f;
    const double sp = f * (1.0 + f2 * (-1.0 / 6 + f2 * (1.0 / 120 + f2 * (-1.0 / 5040 + f2 * (1.0 / 362880 + f2 * (-1.0 / 39916800 + f2 * (1.0 / 6227020800.0)))))));
    const double cp = 1.0 + f2 * (-0.5 + f2 * (1.0 / 24 + f2 * (-1.0 / 720 + f2 * (1.0 / 40320 + f2 * (-1.0 / 3628800 + f2 * (1.0 / 479001600.0 + f2 * (-1.0 / 87178291200.0)))))));
    const int qi = ((int)q) & 3;
    s = (qi == 0) ? sp : (qi == 1) ? cp : (qi == 2) ? -sp : -cp;
    c = (qi == 0) ? cp : (qi == 1) ? -sp : (qi == 2) ? -cp : sp;
}
DI double exp_d(double x) {
    const double n = rint(x * 1.4426950408889634074);
    const double r = x - n * 0.69314718055994530942;
    double p = 1.0 / 87178291200.0;
    p = p * r + 1.0 / 6227020800.0; p = p * r + 1.0 / 479001600.0; p = p * r + 1.0 / 39916800.0; p = p * r + 1.0 / 3628800.0; p = p * r + 1.0 / 362880.0;
    p = p * r + 1.0 / 40320.0; p = p * r + 1.0 / 5040.0; p = p * r + 1.0 / 720.0; p = p * r + 1.0 / 120.0; p = p * r + 1.0 / 24.0; p = p * r + 1.0 / 6.0; p = p * r + 0.5; p = p * r + 1.0; p = p * r + 1.0;
    const long long bits = (long long)((int)n + 1023) << 52;
    return p * __builtin_bit_cast(double, bits);
}

namespace pg8 {
constexpr int BM = 256, BK = 64, HALF = 128, HTB = HALF * BK * 2, STAGE_BYTES = 8 * HTB, NXCD = 8, WGM = 8;
DI int lds_byte(int r, int c) { const int st = (r >> 4) * 2 + (c >> 5), rr = r & 15, cc = c & 31, ob = rr * 64 + cc * 2; return st * 1024 + (ob ^ (((ob >> 9) & 1) << 5)); }
DI void stage_rc(int b, int& R, int& C) { const int st = b / 1024, sb = b % 1024, swz = sb ^ (((sb >> 9) & 1) << 5); R = (st >> 1) * 16 + swz / 64; C = (st & 1) * 32 + (swz % 64) / 2; }
DI int perm32(int rho) { const int n = rho >> 4, i = rho & 15; return 8 * (i >> 2) + 4 * n + (i & 3); }

struct Unit { int pm, pn, row0, arow0, e; const char* a; const char* b; };
struct Order {
    int nM, nN, nwg, G, c, atile0, otile0, etile0;
    const char* A; const char* Bt; size_t tstep, estride;
    int tb[8];
    DI bool next(int i, Unit& u) const {
        const long L = (long)i * G + c; if (L >= nwg) return false;
        int wgid = (int)L; { const int q = nwg / NXCD, r = nwg % NXCD, xcd = wgid % NXCD, off = wgid / NXCD; wgid = (xcd < r ? xcd * (q + 1) : r * (q + 1) + (xcd - r) * q) + off; }
        const int nig = WGM * nN, gid = wgid / nig, fm = gid * WGM, gsz = (nM - fm) < WGM ? (nM - fm) : WGM;
        u.pm = fm + ((wgid % nig) % gsz); u.pn = (wgid % nig) / gsz;
        u.row0 = (otile0 + u.pm) * BM;
        int e = 0;
        if (estride) { const int t = etile0 + u.pm;
#pragma unroll
            for (int j = 1; j < 8; ++j) e += (t >= tb[j]) ? 1 : 0; }
        u.e = e; u.arow0 = (atile0 + u.pm) * BM;
        u.a = A + (size_t)(atile0 + u.pm) * tstep; u.b = Bt + (size_t)e * estride + (size_t)u.pn * tstep;
        return true;
    }
};

template <class Epi, bool I8 = false>
DI void gemm_phase(LAS unsigned char* lds, const int K, const Order& S, const Epi& E, const int wid) {
    int lane = lane_id(); asm volatile("" : "+v"(lane));
    const int tid = wid * 64 + lane, wr = wid >> 2, wc = wid & 3, fr = lane & 15, fq = lane >> 4;
    const int nt = K / BK;
    unsigned voffA[2], voffB[2];
#pragma unroll
    for (int i = 0; i < 2; ++i) { int R, C; stage_rc(tid * 16 + i * 8192, R, C); const int Rb = (R & ~31) + perm32(R & 31);
        voffA[i] = (unsigned)(R * K + C) * 2u; voffB[i] = (unsigned)(Rb * K + C) * 2u; }
    const size_t kstep = (size_t)(BK * 2);
    const size_t hstep = (size_t)HALF * K * 2;
    const unsigned ldsw = (unsigned)wid * 1024u;
    const int aoff = lds_byte(wr * 64 + fr, fq * 8), boff = lds_byte(wc * 32 + fr, fq * 8);
#define PG8_SA(b, h) (((b) * 2 + (h)) * HTB)
#define PG8_SB(b, h) ((4 + (b) * 2 + (h)) * HTB)
#define PG8_STAGE(bufoff, gbase, voff) do { _Pragma("unroll") for (int _i = 0; _i < 2; ++_i) \
        __builtin_amdgcn_global_load_lds((const unsigned*)((const char*)(gbase) + (voff)[_i]), (LAS unsigned*)(lds + (bufoff) + ldsw + _i * 8192), 16, 0, 0); } while (0)
#define PG8_LDA(dst, b, h) do { _Pragma("unroll") for (int m = 0; m < 4; ++m) _Pragma("unroll") for (int k = 0; k < 2; ++k) dst[m][k] = *(const LAS bf16x8*)(lds + PG8_SA(b, h) + aoff + m * 2048 + k * 1024); } while (0)
#define PG8_LDB(dst, b, h) do { _Pragma("unroll") for (int n = 0; n < 2; ++n) _Pragma("unroll") for (int k = 0; k < 2; ++k) dst[n][k] = *(const LAS bf16x8*)(lds + PG8_SB(b, h) + boff + n * 2048 + k * 1024); } while (0)
#define PG8_MMA(ai, bj, At, Bt) do { __builtin_amdgcn_s_setprio(1); _Pragma("unroll") for (int m = 0; m < 4; ++m) _Pragma("unroll") for (int n = 0; n < 2; ++n) _Pragma("unroll") for (int k = 0; k < 2; ++k) \
        { if constexpr (I8) acc[ai][bj][m][n] = __builtin_bit_cast(f32x4, __builtin_amdgcn_mfma_i32_16x16x64_i8(__builtin_bit_cast(i32x4, Bt[n][k]), __builtin_bit_cast(i32x4, At[m][k]), __builtin_bit_cast(i32x4, acc[ai][bj][m][n]), 0, 0, 0)); \
          else acc[ai][bj][m][n] = __builtin_amdgcn_mfma_f32_16x16x32_bf16(Bt[n][k], At[m][k], acc[ai][bj][m][n], 0, 0, 0); } __builtin_amdgcn_s_setprio(0); } while (0)
#define PG8_WAIT_V(n) asm volatile("s_waitcnt vmcnt(" #n ")" ::: "memory")
#define PG8_WAIT_L(n) asm volatile("s_waitcnt lgkmcnt(" #n ")" ::: "memory")
#define PG8_BAR __builtin_amdgcn_s_barrier()
#define PG8_SCHED __builtin_amdgcn_sched_barrier(0)
    Unit cur, nxt; int ui = 0;
    if (!S.next(0, cur)) return;
    f32x4 acc[2][2][4][2];
#pragma unroll
    for (int a = 0; a < 2; ++a)
#pragma unroll
        for (int b = 0; b < 2; ++b)
#pragma unroll
            for (int m = 0; m < 4; ++m)
#pragma unroll
                for (int n = 0; n < 2; ++n) acc[a][b][m][n] = (f32x4){0.f, 0.f, 0.f, 0.f};
    bf16x8 At[4][2], B0[2][2], B1[2][2];
    const char* cA = cur.a; const char* cB = cur.b;
    PG8_STAGE(PG8_SB(0, 0), cB, voffB); PG8_STAGE(PG8_SB(0, 1), cB + hstep, voffB); PG8_STAGE(PG8_SA(0, 0), cA, voffA); PG8_STAGE(PG8_SA(0, 1), cA + hstep, voffA);
    if (wr == 1) PG8_BAR;
    PG8_WAIT_V(2); PG8_BAR;
    PG8_STAGE(PG8_SB(1, 0), cB + kstep, voffB); PG8_STAGE(PG8_SA(1, 0), cA + kstep, voffA); PG8_STAGE(PG8_SB(1, 1), cB + hstep + kstep, voffB);
    PG8_WAIT_V(6); PG8_BAR;
    for (;;) {
        const bool has_next = S.next(ui + 1, nxt);
        const char* nA = has_next ? nxt.a : cA; const char* nB = has_next ? nxt.b : cB;
#pragma unroll 1
        for (int t = 0; t < nt; t += 2) {
            const bool last = (t == nt - 2);
            const char* a1 = cA + (size_t)(t + 1) * kstep;
            const char* a2 = last ? nA : cA + (size_t)(t + 2) * kstep; const char* b2 = last ? nB : cB + (size_t)(t + 2) * kstep;
            const char* a3 = a2 + kstep; const char* b3 = b2 + kstep;
            PG8_LDB(B0, 0, 0); PG8_LDB(B1, 0, 1); PG8_SCHED; PG8_LDA(At, 0, 0); PG8_STAGE(PG8_SA(1, 1), a1 + hstep, voffA);
            PG8_WAIT_V(8); PG8_WAIT_L(0); PG8_BAR; PG8_MMA(0, 0, At, B0); PG8_MMA(0, 1, At, B1); PG8_BAR; PG8_SCHED;
            PG8_LDA(At, 0, 1); PG8_STAGE(PG8_SB(0, 0), b2, voffB); PG8_STAGE(PG8_SB(0, 1), b2 + hstep, voffB); PG8_STAGE(PG8_SA(0, 0), a2, voffA);
            PG8_WAIT_V(8); PG8_WAIT_L(0); PG8_BAR; PG8_MMA(1, 0, At, B0); PG8_MMA(1, 1, At, B1); PG8_BAR; PG8_SCHED;
            PG8_LDB(B0, 1, 0); PG8_LDB(B1, 1, 1); PG8_SCHED; PG8_LDA(At, 1, 0); PG8_STAGE(PG8_SA(0, 1), a2 + hstep, voffA);
            PG8_WAIT_V(8); PG8_WAIT_L(0); PG8_BAR; PG8_MMA(0, 0, At, B0); PG8_MMA(0, 1, At, B1); PG8_BAR; PG8_SCHED;
            PG8_LDA(At, 1, 1); PG8_STAGE(PG8_SB(1, 0), b3, voffB); PG8_STAGE(PG8_SB(1, 1), b3 + hstep, voffB); PG8_STAGE(PG8_SA(1, 0), a3, voffA);
            PG8_WAIT_V(8); PG8_WAIT_L(0); PG8_BAR; PG8_MMA(1, 0, At, B0); PG8_MMA(1, 1, At, B1); PG8_BAR; PG8_SCHED;
        }
        if (wr == 0) PG8_BAR;
        E(acc, cur, wr, wc, fr, fq);
        if (!has_next) break;
#pragma unroll
        for (int a = 0; a < 2; ++a)
#pragma unroll
            for (int b = 0; b < 2; ++b)
#pragma unroll
                for (int m = 0; m < 4; ++m)
#pragma unroll
                    for (int n = 0; n < 2; ++n) acc[a][b][m][n] = (f32x4){0.f, 0.f, 0.f, 0.f};
        cur = nxt; cA = nA; cB = nB; ++ui;
        if (wr == 1) PG8_BAR;
    }
    PG8_WAIT_V(0);
    PG8_BAR;
#undef PG8_SA
#undef PG8_SB
#undef PG8_STAGE
#undef PG8_LDA
#undef PG8_LDB
#undef PG8_MMA
#undef PG8_WAIT_V
#undef PG8_WAIT_L
#undef PG8_BAR
#undef PG8_SCHED
}

DI u32x4 pack8(const f32x4 a, const f32x4 b) { u32x4 w; w.x = pk2(a[0], a[1]); w.y = pk2(a[2], a[3]); w.z = pk2(b[0], b[1]); w.w = pk2(b[2], b[3]); return w; }

DI f32x4 bfx4_lo(const u32x4 w) { return (f32x4){bf_lo(w.x), bf_hi(w.x), bf_lo(w.y), bf_hi(w.y)}; }
DI f32x4 bfx4_hi(const u32x4 w) { return (f32x4){bf_lo(w.z), bf_hi(w.z), bf_lo(w.w), bf_hi(w.w)}; }
struct EpiPlain {
    bf16* O; int ldc; const bf16* R;
    DI void operator()(const f32x4 (&acc)[2][2][4][2], const Unit& u, int wr, int wc, int fr, int fq) const {
        asm volatile("" : "+v"(fr), "+v"(fq));
        const int row0 = u.row0 + wr * 64 + fr, col0 = u.pn * BM + wc * 32 + 8 * fq;
#pragma unroll
        for (int ai = 0; ai < 2; ++ai)
#pragma unroll
            for (int m = 0; m < 4; ++m) { const size_t off = (size_t)(row0 + ai * HALF + m * 16) * ldc + col0;
                if (R) { const u32x4 r0 = *(const u32x4*)(R + off), r1 = *(const u32x4*)(R + off + HALF);
                    *(u32x4*)(O + off) = pack8(acc[ai][0][m][0] + bfx4_lo(r0) * ALPHA, acc[ai][0][m][1] + bfx4_hi(r0) * ALPHA);
                    *(u32x4*)(O + off + HALF) = pack8(acc[ai][1][m][0] + bfx4_lo(r1) * ALPHA, acc[ai][1][m][1] + bfx4_hi(r1) * ALPHA);
                    asm volatile("" ::: "memory"); }
                else {
#pragma unroll
                    for (int bj = 0; bj < 2; ++bj) *(u32x4*)(O + off + bj * HALF) = pack8(acc[ai][bj][m][0], acc[ai][bj][m][1]); } }
    }
};
template <int ACT> struct EpiPair {
    bf16* O; int ldc; const bf16* R;
    DI void operator()(const f32x4 (&acc)[2][2][4][2], const Unit& u, int wr, int wc, int fr, int fq) const {
        asm volatile("" : "+v"(fr), "+v"(fq));
        const int row0 = u.row0 + wr * 64 + fr, col0 = u.pn * HALF + wc * 32 + 8 * fq;
#pragma unroll
        for (int ai = 0; ai < 2; ++ai)
#pragma unroll
            for (int m = 0; m < 4; ++m) {
                const size_t off = (size_t)(row0 + ai * HALF + m * 16) * ldc + col0;
                f32x4 o[2];
                if (R) { const u32x4 r = *(const u32x4*)(R + off); o[0] = bfx4_lo(r) * ALPHA; o[1] = bfx4_hi(r) * ALPHA; } else { o[0] = (f32x4){0.f, 0.f, 0.f, 0.f}; o[1] = o[0]; }
#pragma unroll
                for (int n = 0; n < 2; ++n) { const f32x4 a = acc[ai][0][m][n], b = acc[ai][1][m][n];
#pragma unroll
                    for (int j = 0; j < 4; ++j) o[n][j] += (ACT == 0) ? a[j] * sigmoidf_(a[j]) * b[j] : a[j] * sigmoidf_(b[j]); }
                *(u32x4*)(O + off) = pack8(o[0], o[1]);
                if (R) asm volatile("" ::: "memory"); }
    }
};
struct EpiPairI8 {
    bf16* O; int ldc; const float* sx; const float* sw;
    DI void operator()(const f32x4 (&acc)[2][2][4][2], const Unit& u, int wr, int wc, int fr, int fq) const {
        asm volatile("" : "+v"(fr), "+v"(fq));
        const int rloc = wr * 64 + fr, col0 = u.pn * HALF + wc * 32 + 8 * fq;
        const float* swp = sw + (size_t)u.e * (2 * FF) + u.pn * BM + wc * 32 + 8 * fq;
        f32x4 sg[2], su[2];
#pragma unroll
        for (int n = 0; n < 2; ++n) { sg[n] = *(const f32x4*)(swp + 4 * n); su[n] = *(const f32x4*)(swp + HALF + 4 * n); }
#pragma unroll
        for (int ai = 0; ai < 2; ++ai)
#pragma unroll
            for (int m = 0; m < 4; ++m) {
                const int rr = rloc + ai * HALF + m * 16;
                const float sr = sx[u.arow0 + rr];
                f32x4 o[2];
#pragma unroll
                for (int n = 0; n < 2; ++n) { const i32x4 ia = __builtin_bit_cast(i32x4, acc[ai][0][m][n]), ib = __builtin_bit_cast(i32x4, acc[ai][1][m][n]);
#pragma unroll
                    for (int j = 0; j < 4; ++j) { const float a = (float)ia[j] * (sr * sg[n][j]), b = (float)ib[j] * (sr * su[n][j]); o[n][j] = a * sigmoidf_(a) * b; } }
                *(u32x4*)(O + (size_t)(u.row0 + rr) * ldc + col0) = pack8(o[0], o[1]);
                asm volatile("" ::: "memory"); }
    }
};
struct EpiWin {
    bf16 *Q, *Kb, *Vb, *ZU, *ZV; const float *cosT, *sinT, *lng, *lnb;
    DI void operator()(const f32x4 (&acc)[2][2][4][2], const Unit& u, int wr, int wc, int fr, int fq) const {
        asm volatile("" : "+v"(fr), "+v"(fq));
        const int rbase = u.row0 + wr * 64 + fr, pn = u.pn;
        if (pn < 2 || (pn == 2 && wc < 2)) {
            bf16* dst; int ld, colb; float sc;
            if (pn < 2) { dst = Q; ld = 512; colb = 64 * (4 * pn + wc); sc = QSCALE; } else { dst = Kb; ld = 128; colb = 64 * wc; sc = 1.0f; }
#pragma unroll
            for (int ai = 0; ai < 2; ++ai)
#pragma unroll
                for (int m = 0; m < 4; ++m) { int row = rbase + ai * HALF + m * 16; asm volatile("" : "+v"(row) :: "memory"); const int pos = row & (SEQ - 1);
                    f32x4 o1[2], o2[2];
#pragma unroll
                    for (int n = 0; n < 2; ++n) { const f32x4 c = *(const f32x4*)(cosT + pos * 32 + 8 * fq + 4 * n), s = *(const f32x4*)(sinT + pos * 32 + 8 * fq + 4 * n);
                        const f32x4 x1 = acc[ai][0][m][n], x2 = acc[ai][1][m][n];
                        o1[n] = (x1 * c - x2 * s) * sc; o2[n] = (x2 * c + x1 * s) * sc; }
                    bf16* rp = dst + (size_t)row * ld + colb + 8 * fq;
                    *(u32x4*)(rp) = pack8(o1[0], o1[1]); *(u32x4*)(rp + 32) = pack8(o2[0], o2[1]); asm volatile("" ::: "memory"); }
        } else if (pn == 2) {
#pragma unroll
            for (int ai = 0; ai < 2; ++ai)
#pragma unroll
                for (int m = 0; m < 4; ++m) { int row = rbase + ai * HALF + m * 16; asm volatile("" : "+v"(row) :: "memory"); bf16* rp = Vb + (size_t)row * 128 + 64 * (wc - 2) + 8 * fq;
#pragma unroll
                    for (int bj = 0; bj < 2; ++bj) *(u32x4*)(rp + 32 * bj) = pack8(acc[ai][bj][m][0], acc[ai][bj][m][1]); }
        } else if (pn < 5) {
#pragma unroll
            for (int ai = 0; ai < 2; ++ai)
#pragma unroll
                for (int m = 0; m < 4; ++m) { int row = rbase + ai * HALF + m * 16; asm volatile("" : "+v"(row) :: "memory"); bf16* rp = ZU + (size_t)row * 512 + 256 * (pn - 3) + 64 * wc + 8 * fq;
#pragma unroll
                    for (int bj = 0; bj < 2; ++bj) { f32x4 a = acc[ai][bj][m][0], b = acc[ai][bj][m][1];
#pragma unroll
                        for (int j = 0; j < 4; ++j) { a[j] = gelu_tanh(a[j]); b[j] = gelu_tanh(b[j]); }
                        *(u32x4*)(rp + 32 * bj) = pack8(a, b); } }
        } else {
            const int gi = 4 * (pn - 5) + wc;
            f32x4 gg[2][2], bb[2][2];
#pragma unroll
            for (int bj = 0; bj < 2; ++bj)
#pragma unroll
                for (int n = 0; n < 2; ++n) { gg[bj][n] = *(const f32x4*)(lng + gi * 64 + 32 * bj + 8 * fq + 4 * n); bb[bj][n] = *(const f32x4*)(lnb + gi * 64 + 32 * bj + 8 * fq + 4 * n); }
#pragma unroll
            for (int ai = 0; ai < 2; ++ai)
#pragma unroll
                for (int m = 0; m < 4; ++m) { int row = rbase + ai * HALF + m * 16; asm volatile("" : "+v"(row) :: "memory");
                    f32x4 z[2][2]; float s = 0.f;
#pragma unroll
                    for (int bj = 0; bj < 2; ++bj)
#pragma unroll
                        for (int n = 0; n < 2; ++n) {
#pragma unroll
                            for (int j = 0; j < 4; ++j) { z[bj][n][j] = gelu_tanh(acc[ai][bj][m][n][j]); s += z[bj][n][j]; } }
                    s += swz16_f(s); s = sum_x32(s);
                    const float mean = s * (1.0f / 64.0f); float q = 0.f;
#pragma unroll
                    for (int bj = 0; bj < 2; ++bj)
#pragma unroll
                        for (int n = 0; n < 2; ++n) { z[bj][n] = z[bj][n] - mean; q += (z[bj][n][0] * z[bj][n][0] + z[bj][n][1] * z[bj][n][1]) + (z[bj][n][2] * z[bj][n][2] + z[bj][n][3] * z[bj][n][3]); }
                    q += swz16_f(q); q = sum_x32(q);
                    const float rstd = 1.0f / sqrtf(q * (1.0f / 64.0f) + LN_EPS);
                    bf16* rp = ZV + (size_t)row * 512 + 64 * gi + 8 * fq;
#pragma unroll
                    for (int bj = 0; bj < 2; ++bj) *(u32x4*)(rp + 32 * bj) = pack8(z[bj][0] * rstd * gg[bj][0] + bb[bj][0], z[bj][1] * rstd * gg[bj][1] + bb[bj][1]); asm volatile("" ::: "memory"); }
        }
    }
};
}

#define XB_TMO      128
#define XB_XCNT(j)  (256  + 64 * (j))
#define XB_XSUB(j)  (1280 + 64 * (j))
#define XB_XGEN(j)  (2304 + 64 * (j))
#define XB_TOP      3328
#define XB_TOPGEN   3392
#define XCD_BAR_WORDS 3456
#define XB_SPIN_CAP (1u << 22)
DI unsigned xb_ld(unsigned* p)              { return __hip_atomic_load(p, __ATOMIC_RELAXED, __HIP_MEMORY_SCOPE_AGENT); }
DI unsigned xb_add(unsigned* p, unsigned v) { return __hip_atomic_fetch_add(p, v, __ATOMIC_RELAXED, __HIP_MEMORY_SCOPE_AGENT); }
DI unsigned xb_xcc_id() { return (unsigned)__builtin_amdgcn_s_getreg((3 << 11) | 20) & 0xFu; }
#define XB_SPIN(cond, bar) do { unsigned _sp = 0; while (cond) { __builtin_amdgcn_s_sleep(1); \
    if ((++_sp & 255u) == 0u) { if (xb_ld(&(bar)[XB_TMO])) break; if (_sp > XB_SPIN_CAP) { atomicAdd(&(bar)[XB_TMO], 1u); break; } } } } while (0)
struct XcdBarrier { GASP unsigned* bar; unsigned x; volatile LAS unsigned* st; };
DI XcdBarrier xcd_barrier_post(GASP unsigned* bar, volatile LAS unsigned* st, bool leader) {
    XcdBarrier b; b.bar = bar; b.x = xb_xcc_id(); b.st = st;
    if (leader) (void)xb_add((unsigned*)&bar[XB_XCNT(b.x)], 1u);
    return b;
}
DI void xcd_barrier_complete(unsigned* bar, unsigned x, unsigned& nloc, unsigned& nx) {
    const unsigned G = gridDim.x * gridDim.y * gridDim.z;
    unsigned sum, cnt, mine, sp = 0u;
    for (;;) {
        sum = 0u; cnt = 0u; mine = 0u;
#pragma unroll
        for (unsigned j = 0; j < 16; ++j) { const unsigned c = xb_ld(&bar[XB_XCNT(j)]); sum += c; cnt += (c > 0u) ? 1u : 0u; mine = (j == x) ? c : mine; }
        if (sum == G) break;
        __builtin_amdgcn_s_sleep(1);
        if ((++sp & 255u) == 0u) { if (xb_ld(&bar[XB_TMO])) break; if (sp > XB_SPIN_CAP) { atomicAdd(&bar[XB_TMO], 1u); break; } }
    }
    nloc = mine > 0u ? mine : 1u; nx = cnt > 0u ? cnt : 1u;
}
DI void xcd_barrier(const XcdBarrier& b, int wave) {
    asm volatile("s_waitcnt vmcnt(0)" ::: "memory");
    __syncthreads();
    if (wave == 0 && lane_id() == 0) {
        GASP unsigned* barg = b.bar; unsigned bx = b.x; asm volatile("" : "+s"(barg), "+s"(bx)); unsigned* bar = (unsigned*)barg;
        __builtin_amdgcn_s_waitcnt(0);
        unsigned nloc = b.st[0], nx = b.st[1];
        if (nloc == 0u) { xcd_barrier_complete(bar, bx, nloc, nx); b.st[0] = nloc; b.st[1] = nx; }
        const unsigned old = xb_add(&bar[XB_XSUB(bx)], 1u);
        const unsigned gen = old / nloc;
        if (old + 1u == (gen + 1u) * nloc) {
            __builtin_amdgcn_fence(__ATOMIC_RELEASE, "agent");
            asm volatile("s_waitcnt vmcnt(0)" ::: "memory");
            const unsigned og = xb_add(&bar[XB_TOP], 1u);
            const unsigned tg = og / nx;
            if (og + 1u == (tg + 1u) * nx) xb_add(&bar[XB_TOPGEN], 1u);
            else XB_SPIN(xb_ld(&bar[XB_TOPGEN]) == tg, bar);
            __builtin_amdgcn_fence(__ATOMIC_ACQUIRE, "agent");
            xb_add(&bar[XB_XGEN(bx)], 1u);
            asm volatile("s_waitcnt vmcnt(0)" ::: "memory");
        } else {
            XB_SPIN(xb_ld(&bar[XB_XGEN(bx)]) == gen, bar);
            __builtin_amdgcn_fence(__ATOMIC_ACQUIRE, "agent");
            asm volatile("s_waitcnt vmcnt(0)" ::: "memory");
        }
    }
    __syncthreads();
}

struct Frame {
    LAS unsigned char* lds;
    volatile LAS unsigned* MISC;
    unsigned* ctl;
    int tid, lane, wave, G, bid;
    GASP unsigned char* ws;
    GASP float* out;
};
struct Args { const float* in[27]; float* out; unsigned char* ws; };
typedef const unsigned char __attribute__((address_space(4)))* kptr_t;
DI const float* in_ptr(int k) { kptr_t p = (kptr_t)__builtin_amdgcn_kernarg_segment_ptr(); asm volatile("" : "+s"(p)); return (const float*)(*(GASP const float* const __attribute__((address_space(4)))*)(p + 8 * k)); }
struct ArgsRef { struct Acc { DI const float* operator[](int k) const { return in_ptr(k); } } in; };

DI void conv_item(const float* W, int ldw, int k0, int c0, bf16* drow0, int K, LAS float* scr, int lane) {
#pragma unroll 8
    for (int i = 0; i < 32; ++i) { const int kk = 2 * i + (lane >> 5); scr[kk * 33 + (lane & 31)] = W[(size_t)(k0 + kk) * ldw + c0 + (lane & 31)]; }
    LDS_WAIT();
    const int c = lane & 7;
#pragma unroll
    for (int j = 0; j < 4; ++j) { const int n = (lane >> 3) + 8 * j; const LAS float* s = scr + (8 * c) * 33 + n;
        u32x4 o; o.x = pk2(s[0 * 33], s[1 * 33]); o.y = pk2(s[2 * 33], s[3 * 33]); o.z = pk2(s[4 * 33], s[5 * 33]); o.w = pk2(s[6 * 33], s[7 * 33]);
        *(u32x4*)(drow0 + (size_t)n * K + k0 + 8 * c) = o; }
    LDS_WAIT();
}
DI void conv_job_i8(Frame& F, const float* s1, const float* s2, unsigned char* dst, float* swout, int K, int ldw, int nblk, int nexp) {
    LAS float* scr = (LAS float*)(F.lds + F.wave * 16384);
    LAS float* sinv = scr + 64 * 33;
    const int gw = F.bid * NWAVES + F.wave, NGW = F.G * NWAVES, lane = F.lane;
    for (int it = gw; it < nblk * nexp; it += NGW) {
        const int e = it / nblk, nb = it - e * nblk;
        const int pn = nb >> 3, bj = (nb >> 2) & 1, wc = nb & 3, c0 = 128 * pn + 32 * wc;
        const float* W = (bj ? s2 : s1) + (size_t)e * K * ldw;
        float mx = 0.f;
        for (int k = (lane >> 5); k < K; k += 2) mx = fmaxf(mx, fabsf(W[(size_t)k * ldw + c0 + (lane & 31)]));
        mx = max_x32(mx);
        const float sc = mx * (1.0f / 127.0f), inv = mx > 0.f ? 127.0f / mx : 0.f;
        if (lane < 32) { swout[(size_t)e * nblk * 32 + nb * 32 + lane] = sc; sinv[lane] = inv; }
        LDS_WAIT();
        unsigned char* drow0 = dst + ((size_t)e * nblk * 32 + (size_t)nb * 32) * K;
        for (int k0 = 0; k0 < K; k0 += 64) {
#pragma unroll 8
            for (int i = 0; i < 32; ++i) { const int kk = 2 * i + (lane >> 5); scr[kk * 33 + (lane & 31)] = W[(size_t)(k0 + kk) * ldw + c0 + (lane & 31)]; }
            LDS_WAIT();
            const int c = lane & 3;
#pragma unroll
            for (int j = 0; j < 2; ++j) { const int n = (lane >> 2) + 16 * j; const LAS float* sp = scr + (16 * c) * 33 + n; const float iv = sinv[n];
                u32x4 o; o.x = pk4_i8(sp[0 * 33], sp[1 * 33], sp[2 * 33], sp[3 * 33], iv); o.y = pk4_i8(sp[4 * 33], sp[5 * 33], sp[6 * 33], sp[7 * 33], iv);
                o.z = pk4_i8(sp[8 * 33], sp[9 * 33], sp[10 * 33], sp[11 * 33], iv); o.w = pk4_i8(sp[12 * 33], sp[13 * 33], sp[14 * 33], sp[15 * 33], iv);
                *(u32x4*)(drow0 + (size_t)n * K + k0 + 16 * c) = o; }
            LDS_WAIT();
        }
    }
}
template <int MAP>
DI void conv_job(Frame& F, const float* s1, const float* s2, bf16* dst, int K, int ldw, int nblk, int nexp) {
    LAS float* scr = (LAS float*)(F.lds + F.wave * 16384);
    const int gw = F.bid * NWAVES + F.wave, NGW = F.G * NWAVES;
    const int per = (K / 64) * nblk, total = per * nexp;
    for (int it = gw; it < total; it += NGW) {
        const int e = it / per, r = it - e * per, kb = r / nblk, nb = r - kb * nblk;
        const float* src = s1; int c0;
        if (MAP == 0) c0 = 32 * nb;
        else { const int pn = nb >> 3, bj = (nb >> 2) & 1, wc = nb & 3;
            if (MAP == 1) c0 = 256 * pn + 64 * wc + 32 * bj; else { c0 = 128 * pn + 32 * wc; if (bj) src = s2; } }
        conv_item(src + (size_t)e * K * ldw, ldw, 64 * kb, c0, dst + ((size_t)e * nblk * 32 + (size_t)nb * 32) * K, K, scr, F.lane);
    }
}
DI void conv_layer(Frame& F, const ArgsRef& a, int L) {
    FRESH(F);
    bf16* Wb = (bf16*)(F.ws + WS_W);
    const int i = L >> 1;
    if ((L & 1) == 0) {
        conv_job<1>(F, a.in[3] + (size_t)i * D * INW, nullptr, (bf16*)((char*)Wb + W_IN), D, INW, INW / 32, 1);
        conv_job<0>(F, a.in[9] + (size_t)i * D * D, nullptr, (bf16*)((char*)Wb + W_OUT), D, D, D / 32, 1);
        conv_job_i8(F, a.in[10] + (size_t)i * D * FF, a.in[11] + (size_t)i * D * FF, (unsigned char*)Wb + W_GU, (float*)(F.ws + WS_SW), D, FF, 2 * FF / 32, 1);
        conv_job<0>(F, a.in[12] + (size_t)i * FF * D, nullptr, (bf16*)((char*)Wb + W_DN), FF, D, D / 32, 1);
        const float* sw = a.in[5] + (size_t)i * 8 * 128 * 128; bf16* dw = (bf16*)(F.ws + WS_SGUW);
        for (int idx = F.bid * 512 + F.tid; idx < 8 * 128 * 128 / 4; idx += F.G * 512) { const f32x4 v = *(const f32x4*)(sw + 4 * idx); u32x2 o; o.x = pk2(v[0], v[1]); o.y = pk2(v[2], v[3]); *(u32x2*)(dw + 4 * idx) = o; }
    } else {
        conv_job<2>(F, a.in[21] + (size_t)i * D * D, a.in[22] + (size_t)i * D * D, (bf16*)((char*)Wb + W_GLU), D, D, 2 * D / 32, 1);
        conv_job_i8(F, a.in[24] + (size_t)i * NE * D * FF, a.in[25] + (size_t)i * NE * D * FF, (unsigned char*)Wb + W_MGU, (float*)(F.ws + WS_SW), D, FF, 2 * FF / 32, NE);
        conv_job<0>(F, a.in[26] + (size_t)i * NE * FF * D, nullptr, (bf16*)((char*)Wb + W_MDN), FF, D, D / 32, NE);
    }
}

DI void prologue(Frame& F, const ArgsRef& a) {
    FRESH(F);
    const float* x = a.in[0]; bf16* XB = (bf16*)(F.ws + WS_XB);
    const size_t nthr = (size_t)F.G * 512, t0 = (size_t)F.bid * 512 + F.tid;
    for (size_t i = t0; i < (size_t)T * D / 8; i += nthr) { const f32x4 v0 = *(const f32x4*)(x + 8 * i), v1 = *(const f32x4*)(x + 8 * i + 4); *(u32x4*)(XB + 8 * i) = pg8::pack8(v0, v1); }
    float* cosT = (float*)(F.ws + WS_ROPE); float* sinT = cosT + SEQ * 32;
    for (size_t i = t0; i < (size_t)SEQ * 32; i += nthr) { const int pos = (int)(i >> 5), d = (int)(i & 31);
        const float invf = (float)exp_d(-(double)(2 * d) * (9.2103403719761836 / 64.0));
        const float ang = (float)pos * invf; double s, c; sincos_d((double)ang, s, c); cosT[i] = (float)c; sinT[i] = (float)s; }
}

DI void ln_core(f32x4 (&v)[4], const f32x4 (&g)[4], const f32x4 (&b)[4]) {
    float s = 0.f;
#pragma unroll
    for (int j = 0; j < 4; ++j) s += (v[j][0] + v[j][1]) + (v[j][2] + v[j][3]);
    const float mean = wave_sum(s) * (1.0f / D); float q = 0.f;
#pragma unroll
    for (int j = 0; j < 4; ++j) { v[j] = v[j] - mean; q += (v[j][0] * v[j][0] + v[j][1] * v[j][1]) + (v[j][2] * v[j][2] + v[j][3] * v[j][3]); }
    const float rstd = 1.0f / sqrtf(wave_sum(q) * (1.0f / D) + LN_EPS);
#pragma unroll
    for (int j = 0; j < 4; ++j) v[j] = v[j] * rstd * g[j] + b[j];
}
DI void ln_store(const f32x4 (&v)[4], bf16* XB, size_t row, int lane) {
#pragma unroll
    for (int j = 0; j < 4; ++j) { u32x2 o; o.x = pk2(v[j][0], v[j][1]); o.y = pk2(v[j][2], v[j][3]); *(u32x2*)(XB + row * D + 4 * lane + 256 * j) = o; }
}
DI void ln_load(f32x4 (&v)[4], const bf16* Y, size_t row, int lane) {
#pragma unroll
    for (int j = 0; j < 4; ++j) { const u32x2 yv = *(const u32x2*)(Y + row * D + 4 * lane + 256 * j); v[j] = (f32x4){bf_lo(yv.x), bf_hi(yv.x), bf_lo(yv.y), bf_hi(yv.y)}; }
}
DI void ln_pass_plain(Frame& F, const float* g_, const float* b_, const bool q8copy) {
    FRESH(F);
    const bf16* Y = (const bf16*)(F.ws + WS_Y); bf16* XB = (bf16*)(F.ws + WS_XB);
    f32x4 g[4], b[4];
#pragma unroll
    for (int j = 0; j < 4; ++j) { g[j] = *(const f32x4*)(g_ + 4 * F.lane + 256 * j); b[j] = *(const f32x4*)(b_ + 4 * F.lane + 256 * j); }
    const int gw = F.bid * NWAVES + F.wave, NGW = F.G * NWAVES;
    for (int row = gw; row < T; row += NGW) {
        f32x4 v[4]; ln_load(v, Y, (size_t)row, F.lane);
        ln_core(v, g, b);
        ln_store(v, XB, (size_t)row, F.lane);
        if (q8copy) {
            float mx = 0.f;
#pragma unroll
            for (int j = 0; j < 4; ++j) mx = fmaxf(mx, fmaxf(fmaxf(fabsf(v[j][0]), fabsf(v[j][1])), fmaxf(fabsf(v[j][2]), fabsf(v[j][3]))));
            mx = wave_max(mx);
            const float inv = mx > 0.f ? 127.0f / mx : 0.f;
            unsigned char* X8 = (unsigned char*)(F.ws + WS_XB8);
#pragma unroll
            for (int j = 0; j < 4; ++j) *(unsigned*)(X8 + (size_t)row * D + 4 * F.lane + 256 * j) = pk4_i8(v[j][0], v[j][1], v[j][2], v[j][3], inv);
            if (F.lane == 0) ((float*)(F.ws + WS_SX))[row] = mx * (1.0f / 127.0f);
        }
    }
}
DI void ln_pass_router(Frame& F, const float* g_, const float* b_, const float* rw_, unsigned* cnt, const size_t rec_off) {
    FRESH(F);
    const bf16* Y = (const bf16*)(F.ws + WS_Y); bf16* XB = (bf16*)(F.ws + WS_XB);
    i32x4* RECI = (i32x4*)(F.ws + WS_RECI + rec_off); f32x2* RECW = (f32x2*)(F.ws + WS_RECW + rec_off);
    LAS int* lcnt = (LAS int*)(F.lds); LAS int* lbase = lcnt + 8;
    LAS int* re0 = lcnt + 64; LAS int* re1 = re0 + 256; LAS int* rp0 = re1 + 256; LAS int* rp1 = rp0 + 256; LAS float* rw0 = (LAS float*)(rp1 + 256); LAS float* rw1 = rw0 + 256;
    f32x4 g[4], b[4];
#pragma unroll
    for (int j = 0; j < 4; ++j) { g[j] = *(const f32x4*)(g_ + 4 * F.lane + 256 * j); b[j] = *(const f32x4*)(b_ + 4 * F.lane + 256 * j); }
    f32x4 rwa[4][4], rwb[4][4];
#pragma unroll
    for (int j = 0; j < 4; ++j)
#pragma unroll
        for (int c = 0; c < 4; ++c) { const float* p = rw_ + (size_t)(4 * F.lane + 256 * j + c) * 8; rwa[j][c] = *(const f32x4*)p; rwb[j][c] = *(const f32x4*)(p + 4); }
    for (int pnl = F.bid; pnl < T / 256; pnl += F.G) {
        if (F.tid < 8) lcnt[F.tid] = 0;
        __syncthreads();
        for (int rr = 0; rr < 32; ++rr) {
            const int lr = F.wave + 8 * rr; const size_t row = (size_t)pnl * 256 + lr;
            f32x4 v[4]; ln_load(v, Y, row, F.lane);
            ln_core(v, g, b);
            ln_store(v, XB, row, F.lane);
            f32x4 la = {0.f, 0.f, 0.f, 0.f}, lb = {0.f, 0.f, 0.f, 0.f};
#pragma unroll
            for (int j = 0; j < 4; ++j)
#pragma unroll
                for (int c = 0; c < 4; ++c) { la += rwa[j][c] * v[j][c]; lb += rwb[j][c] * v[j][c]; }
            float lg[8];
#pragma unroll
            for (int e = 0; e < 4; ++e) { lg[e] = wave_sum(la[e]); lg[4 + e] = wave_sum(lb[e]); }
            int i0 = 0; float l0 = lg[0];
#pragma unroll
            for (int e = 1; e < 8; ++e) if (lg[e] > l0) { l0 = lg[e]; i0 = e; }
            int i1 = -1; float l1 = -3.0e38f;
#pragma unroll
            for (int e = 0; e < 8; ++e) if (e != i0 && lg[e] > l1) { l1 = lg[e]; i1 = e; }
            const float w0 = 1.0f / (1.0f + __expf(l1 - l0)), w1 = 1.0f - w0;
            if (F.lane == 0) { const int p0 = atomicAdd((int*)(lcnt + i0), 1), p1 = atomicAdd((int*)(lcnt + i1), 1);
                re0[lr] = i0; re1[lr] = i1; rp0[lr] = p0; rp1[lr] = p1; rw0[lr] = w0; rw1[lr] = w1; }
        }
        __syncthreads();
        if (F.tid < 8) lbase[F.tid] = (int)xb_add(cnt + F.tid, (unsigned)lcnt[F.tid]);
        __syncthreads();
        if (F.tid < 256) { const int e0 = re0[F.tid], e1 = re1[F.tid]; const size_t row = (size_t)pnl * 256 + F.tid;
            RECI[row] = (i32x4){e0, lbase[e0] + rp0[F.tid], e1, lbase[e1] + rp1[F.tid]}; RECW[row] = (f32x2){rw0[F.tid], rw1[F.tid]}; }
        __syncthreads();
    }
}
DI void moe_tiles(const unsigned* cnt, int (&tb)[9], int (&cn)[8]) {
    int acc = 0;
#pragma unroll
    for (int e = 0; e < 8; ++e) { cn[e] = __builtin_amdgcn_readfirstlane((int)__hip_atomic_load(cnt + e, __ATOMIC_RELAXED, __HIP_MEMORY_SCOPE_AGENT)); tb[e] = acc; acc += (cn[e] + 255) >> 8; }
    tb[8] = acc;
}
DI void moe_gather(Frame& F, const unsigned* cnt) {
    FRESH(F);
    int tb[9], cn[8]; moe_tiles(cnt, tb, cn);
    const bf16* XB = (const bf16*)(F.ws + WS_XB); unsigned char* XS = (unsigned char*)(F.ws + WS_XS); float* SXS = (float*)(F.ws + WS_SXS); const i32x4* RECI = (const i32x4*)(F.ws + WS_RECI);
    const int gw = F.bid * NWAVES + F.wave, NGW = F.G * NWAVES;
    for (int t = gw; t < T; t += NGW) {
        const i32x4 r = RECI[t];
        int b0 = 0, b1 = 0;
#pragma unroll
        for (int e = 0; e < 8; ++e) { b0 = (r[0] == e) ? tb[e] : b0; b1 = (r[2] == e) ? tb[e] : b1; }
        const size_t r0 = (size_t)b0 * 256 + r[1], r1 = (size_t)b1 * 256 + r[3];
        const u32x4 v0 = *(const u32x4*)(XB + (size_t)t * D + 8 * F.lane), v1 = *(const u32x4*)(XB + (size_t)t * D + 512 + 8 * F.lane);
        float f[16] = {bf_lo(v0.x), bf_hi(v0.x), bf_lo(v0.y), bf_hi(v0.y), bf_lo(v0.z), bf_hi(v0.z), bf_lo(v0.w), bf_hi(v0.w),
                       bf_lo(v1.x), bf_hi(v1.x), bf_lo(v1.y), bf_hi(v1.y), bf_lo(v1.z), bf_hi(v1.z), bf_lo(v1.w), bf_hi(v1.w)};
        float mx = 0.f;
#pragma unroll
        for (int k = 0; k < 16; ++k) mx = fmaxf(mx, fabsf(f[k]));
        mx = wave_max(mx);
        const float inv = mx > 0.f ? 127.0f / mx : 0.f, sc = mx * (1.0f / 127.0f);
        u32x2 q0, q1;
        q0.x = pk4_i8(f[0], f[1], f[2], f[3], inv); q0.y = pk4_i8(f[4], f[5], f[6], f[7], inv); q1.x = pk4_i8(f[8], f[9], f[10], f[11], inv); q1.y = pk4_i8(f[12], f[13], f[14], f[15], inv);
        *(u32x2*)(XS + r0 * D + 8 * F.lane) = q0; *(u32x2*)(XS + r0 * D + 512 + 8 * F.lane) = q1;
        *(u32x2*)(XS + r1 * D + 8 * F.lane) = q0; *(u32x2*)(XS + r1 * D + 512 + 8 * F.lane) = q1;
        if (F.lane == 0) { SXS[r0] = sc; SXS[r1] = sc; }
    }
#pragma unroll
    for (int e = 0; e < 8; ++e) { const int first = tb[e] * 256 + cn[e], last = tb[e + 1] * 256;
        for (int r = first + gw; r < last; r += NGW) { const u32x2 z = {0u, 0u}; *(u32x2*)(XS + (size_t)r * D + 8 * F.lane) = z; *(u32x2*)(XS + (size_t)r * D + 512 + 8 * F.lane) = z; if (F.lane == 0) SXS[r] = 0.f; } }
}
DI void ln_pass_combine(Frame& F, const float* g_, const float* b_, const unsigned* cnt, const bool final_, const bool dummy_) {
    FRESH(F);
    int tb[9], cn[8]; moe_tiles(cnt, tb, cn);
    const bf16* YS = (const bf16*)(F.ws + WS_YS); bf16* XB = (bf16*)(F.ws + WS_XB); float* X = (float*)F.out;
    const i32x4* RECI = (const i32x4*)(F.ws + WS_RECI); const f32x2* RECW = (const f32x2*)(F.ws + WS_RECW);
    f32x4 g[4], b[4];
#pragma unroll
    for (int j = 0; j < 4; ++j) { g[j] = *(const f32x4*)(g_ + 4 * F.lane + 256 * j); b[j] = *(const f32x4*)(b_ + 4 * F.lane + 256 * j); }
    const int gw = F.bid * NWAVES + F.wave, NGW = F.G * NWAVES;
    for (int row = gw; row < T; row += NGW) {
        const i32x4 r = RECI[row]; const f32x2 w = RECW[row];
        int b0 = 0, b1 = 0;
#pragma unroll
        for (int e = 0; e < 8; ++e) { b0 = (r[0] == e) ? tb[e] : b0; b1 = (r[2] == e) ? tb[e] : b1; }
        const size_t r0 = (size_t)b0 * 256 + r[1], r1 = (size_t)b1 * 256 + r[3];
        f32x4 v[4];
#pragma unroll
        for (int j = 0; j < 4; ++j) { const u32x2 xv = *(const u32x2*)(XB + (size_t)row * D + 4 * F.lane + 256 * j);
            const u32x2 ya = *(const u32x2*)(YS + r0 * D + 4 * F.lane + 256 * j), yb = *(const u32x2*)(YS + r1 * D + 4 * F.lane + 256 * j);
            v[j][0] = ALPHA * bf_lo(xv.x) + (w[0] * bf_lo(ya.x) + w[1] * bf_lo(yb.x)); v[j][1] = ALPHA * bf_hi(xv.x) + (w[0] * bf_hi(ya.x) + w[1] * bf_hi(yb.x));
            v[j][2] = ALPHA * bf_lo(xv.y) + (w[0] * bf_lo(ya.y) + w[1] * bf_lo(yb.y)); v[j][3] = ALPHA * bf_hi(xv.y) + (w[0] * bf_hi(ya.y) + w[1] * bf_hi(yb.y)); }
        ln_core(v, g, b);
        if (dummy_) ln_store(v, (bf16*)(F.ws + WS_XS), (size_t)row, F.lane);
        else if (final_) {
#pragma unroll
            for (int j = 0; j < 4; ++j) *(f32x4*)(X + (size_t)row * D + 4 * F.lane + 256 * j) = v[j];
        } else ln_store(v, XB, (size_t)row, F.lane);
    }
}

constexpr int KL_STRIDE = 144, VT_STRIDE = 776, VT_OFF = 384 * KL_STRIDE;
DI void attn_phase(Frame& F, const float* sink) {
    FRESH(F);
    const bf16* Q = (const bf16*)(F.ws + WS_Q); const bf16* Kb = (const bf16*)(F.ws + WS_K); const bf16* Vb = (const bf16*)(F.ws + WS_V); bf16* MIX = (bf16*)(F.ws + WS_MIX);
    LAS unsigned char* Kl = F.lds; LAS unsigned char* Vt = F.lds + VT_OFF;
    const int lane = F.lane, l31 = lane & 31, h = lane >> 5, w = F.wave;
    for (int unit = F.bid; unit < BATCH * 2 * 16; unit += F.G) {
        const int b = unit >> 5, kvh = (unit >> 4) & 1, n = unit & 15;
        __syncthreads();
        for (int idx = F.tid; idx < 384 * 8; idx += 512) {
            const int key = idx >> 3, ch = idx & 7, kp = (n - 1) * 128 + key;
            u32x4 kv = {0u, 0u, 0u, 0u}, vv = {0u, 0u, 0u, 0u};
            if (kp >= 0 && kp < SEQ) { const size_t off = (size_t)(b * SEQ + kp) * 128 + kvh * 64 + ch * 8; kv = *(const u32x4*)(Kb + off); vv = *(const u32x4*)(Vb + off); }
            *(LAS u32x4*)(Kl + key * KL_STRIDE + ch * 16) = kv;
            LAS unsigned short* vd = (LAS unsigned short*)(Vt + (ch * 8) * VT_STRIDE + key * 2);
            constexpr int RS = VT_STRIDE / 2;
            vd[0 * RS] = (unsigned short)(vv.x & 0xffffu); vd[1 * RS] = (unsigned short)(vv.x >> 16); vd[2 * RS] = (unsigned short)(vv.y & 0xffffu); vd[3 * RS] = (unsigned short)(vv.y >> 16);
            vd[4 * RS] = (unsigned short)(vv.z & 0xffffu); vd[5 * RS] = (unsigned short)(vv.z >> 16); vd[6 * RS] = (unsigned short)(vv.w & 0xffffu); vd[7 * RS] = (unsigned short)(vv.w >> 16);
        }
        __syncthreads();
        const int hq = kvh * 4 + (w >> 1);
        const float m0 = sink[hq] * LOG2E;
        for (int qb = 0; qb < 2; ++qb) {
            const int q0 = 64 * (w & 1) + 32 * qb;
            const size_t qrow = (size_t)(b * SEQ + n * 128 + q0 + l31);
            bf16x8 bq[4];
#pragma unroll
            for (int ks = 0; ks < 4; ++ks) bq[ks] = *(const bf16x8*)(Q + qrow * 512 + hq * 64 + 16 * ks + 8 * h);
            float m2 = m0, l = 1.0f;
            f32x16 O0, O1;
#pragma unroll
            for (int i = 0; i < 16; ++i) { O0[i] = 0.f; O1[i] = 0.f; }
            const int kt0 = q0 >> 5, qk = q0 + l31;
            for (int kt = kt0; kt <= kt0 + 8; ++kt) {
                f32x16 X;
#pragma unroll
                for (int i = 0; i < 16; ++i) X[i] = 0.f;
#pragma unroll
                for (int ks = 0; ks < 4; ++ks) { const bf16x8 a = *(const LAS bf16x8*)(Kl + (32 * kt + l31) * KL_STRIDE + (16 * ks + 8 * h) * 2); X = MFMA32(a, bq[ks], X); }
                float mx = -1.0e30f;
#pragma unroll
                for (int i = 0; i < 16; ++i) { const int kk = 32 * kt + crow(i, h); const int kp = (n - 1) * 128 + kk;
                    const bool valid = (kk >= qk) && (kk <= qk + 256) && (kp >= 0) && (kp < SEQ);
                    X[i] = valid ? X[i] : -1.0e30f; mx = fmaxf(mx, X[i]); }
                mx = max_x32(mx);
                const float mn = fmaxf(m2, mx), alpha = fast_exp2(m2 - mn); m2 = mn;
                float ps = 0.f;
#pragma unroll
                for (int i = 0; i < 16; ++i) { X[i] = fast_exp2(X[i] - mn); ps += X[i]; }
                ps = sum_x32(ps);
                l = l * alpha + ps;
#pragma unroll
                for (int i = 0; i < 16; ++i) { O0[i] *= alpha; O1[i] *= alpha; }
#pragma unroll
                for (int s = 0; s < 2; ++s) {
                    u32x4 pw; pw.x = pk2(X[8 * s + 0], X[8 * s + 1]); pw.y = pk2(X[8 * s + 2], X[8 * s + 3]); pw.z = pk2(X[8 * s + 4], X[8 * s + 5]); pw.w = pk2(X[8 * s + 6], X[8 * s + 7]);
                    const bf16x8 pf = __builtin_bit_cast(bf16x8, pw);
                    const int kb = (32 * kt + 16 * s + 4 * h) * 2;
                    { const s16x4 lo = *(const LAS s16x4*)(Vt + l31 * VT_STRIDE + kb), hi = *(const LAS s16x4*)(Vt + l31 * VT_STRIDE + kb + 16);
                      O0 = MFMA32(__builtin_shufflevector(lo, hi, 0, 1, 2, 3, 4, 5, 6, 7), pf, O0); }
                    { const s16x4 lo = *(const LAS s16x4*)(Vt + (32 + l31) * VT_STRIDE + kb), hi = *(const LAS s16x4*)(Vt + (32 + l31) * VT_STRIDE + kb + 16);
                      O1 = MFMA32(__builtin_shufflevector(lo, hi, 0, 1, 2, 3, 4, 5, 6, 7), pf, O1); }
                }
            }
            const float inv = 1.0f / l;
            bf16* orow = MIX + qrow * D + hq * 64;
#pragma unroll
            for (int g4 = 0; g4 < 4; ++g4) {
                u32x2 o; o.x = pk2(O0[4 * g4] * inv, O0[4 * g4 + 1] * inv); o.y = pk2(O0[4 * g4 + 2] * inv, O0[4 * g4 + 3] * inv); *(u32x2*)(orow + 8 * g4 + 4 * h) = o;
                u32x2 p; p.x = pk2(O1[4 * g4] * inv, O1[4 * g4 + 1] * inv); p.y = pk2(O1[4 * g4 + 2] * inv, O1[4 * g4 + 3] * inv); *(u32x2*)(orow + 32 + 8 * g4 + 4 * h) = p;
            }
        }
    }
    __syncthreads();
}

constexpr int SG_STRIDE = 272;
DI void sgu_phase(Frame& F, const float* sgu_b) {
    FRESH(F);
    const bf16* ZU = (const bf16*)(F.ws + WS_ZU); const bf16* ZV = (const bf16*)(F.ws + WS_ZV); const bf16* Wsb = (const bf16*)(F.ws + WS_SGUW); bf16* MIX = (bf16*)(F.ws + WS_MIX);
    LAS unsigned char* VT = F.lds + F.wave * (32 * SG_STRIDE);
    const int lane = F.lane, l31 = lane & 31, h = lane >> 5;
    const int gw = F.bid * NWAVES + F.wave, NGW = F.G * NWAVES;
    for (int su = gw; su < BATCH * 16 * 8 * 2; su += NGW) {
        const int dh = su & 1, g = (su >> 1) & 7, n = (su >> 4) & 15, b = su >> 8;
        const size_t rowb = (size_t)(b * SEQ + n * 128);
#pragma unroll
        for (int i = 0; i < 8; ++i) { const int c = lane + 64 * i, q = c >> 2, ch = c & 3;
            const u32x4 vv = *(const u32x4*)(ZV + (rowb + q) * 512 + 64 * g + 32 * dh + 8 * ch);
            LAS unsigned short* vd = (LAS unsigned short*)(VT + (ch * 8) * SG_STRIDE + q * 2);
            constexpr int RS = SG_STRIDE / 2;
            vd[0 * RS] = (unsigned short)(vv.x & 0xffffu); vd[1 * RS] = (unsigned short)(vv.x >> 16); vd[2 * RS] = (unsigned short)(vv.y & 0xffffu); vd[3 * RS] = (unsigned short)(vv.y >> 16);
            vd[4 * RS] = (unsigned short)(vv.z & 0xffffu); vd[5 * RS] = (unsigned short)(vv.z >> 16); vd[6 * RS] = (unsigned short)(vv.w & 0xffffu); vd[7 * RS] = (unsigned short)(vv.w >> 16); }
        bf16x8 af[8];
#pragma unroll
        for (int ks = 0; ks < 8; ++ks) af[ks] = *(const LAS bf16x8*)(VT + l31 * SG_STRIDE + (16 * ks + 8 * h) * 2);
#pragma unroll
        for (int pt = 0; pt < 4; ++pt) {
            const int p = 32 * pt + l31;
            f32x16 acc;
#pragma unroll
            for (int i = 0; i < 16; ++i) acc[i] = 0.f;
#pragma unroll
            for (int ks = 0; ks < 8; ++ks) { const bf16x8 bw = *(const bf16x8*)(Wsb + ((size_t)g * 128 + p) * 128 + 16 * ks + 8 * h); acc = MFMA32(af[ks], bw, acc); }
            const float bias = sgu_b[g * 128 + p];
            const size_t row = rowb + p;
#pragma unroll
            for (int g4 = 0; g4 < 4; ++g4) { const int d = 32 * dh + 8 * g4 + 4 * h;
                const u32x2 uu = *(const u32x2*)(ZU + row * 512 + 64 * g + d);
                u32x2 o; o.x = pk2(bf_lo(uu.x) * (acc[4 * g4] + bias), bf_hi(uu.x) * (acc[4 * g4 + 1] + bias)); o.y = pk2(bf_lo(uu.y) * (acc[4 * g4 + 2] + bias), bf_hi(uu.y) * (acc[4 * g4 + 3] + bias));
                *(u32x2*)(MIX + row * D + 512 + 64 * g + d) = o; }
        }
        LDS_WAIT();
    }
}

constexpr int S5_STRIDE = 272;
DI void sincos_f(float th, float& s, float& c) {
    const float tq = th * 0.636619772367581f, q = rintf(tq), f = (tq - q) * 1.5707963267948966f, f2 = f * f;
    const float sp = f * (1.0f + f2 * (-1.6666667e-1f + f2 * (8.3333333e-3f + f2 * (-1.9841270e-4f + f2 * 2.7557319e-6f))));
    const float cp = 1.0f + f2 * (-0.5f + f2 * (4.1666667e-2f + f2 * (-1.3888889e-3f + f2 * (2.4801587e-5f + f2 * (-2.7557319e-7f)))));
    const int qi = ((int)q) & 3;
    s = (qi == 0) ? sp : (qi == 1) ? cp : (qi == 2) ? -sp : -cp;
    c = (qi == 0) ? cp : (qi == 1) ? -sp : (qi == 2) ? -cp : sp;
}
DI void zoh_params(float lr, float li, float logdt, float& br, float& bi, float& cr, float& ci) {
    const float dt = expf(logdt);
    const float ea = expf(lr * dt);
    float sn, cs; sincos_f(li * dt, sn, cs);
    br = ea * cs; bi = ea * sn;
    const float nr = br - 1.0f, rden = 1.0f / (lr * lr + li * li);
    cr = (nr * lr + bi * li) * rden; ci = (bi * lr - nr * li) * rden;
}
DI void s5_phase(Frame& F, const ArgsRef& a, int i) {
    FRESH(F);
    const bf16* XB = (const bf16*)(F.ws + WS_XB); bf16* YF = (bf16*)(F.ws + WS_YF);     bf16* YG = (bf16*)(F.ws + WS_YG);
    LAS unsigned char* xs = F.lds + F.wave * (32 * S5_STRIDE);
    const int lane = F.lane, l31 = lane & 31, h = lane >> 5, l15 = lane & 15, q4 = lane >> 4;
    const int gw = F.bid * NWAVES + F.wave, NGW = F.G * NWAVES;
    const bool fwdrow = (l31 & 4) == 0; const int slot = (l31 & 3) + 4 * (l31 >> 3);
    for (int unit = gw; unit < BATCH * 64; unit += NGW) {
        const int b = unit >> 6, g = unit & 63;
        const f32x4 dsk = *(const f32x4*)(a.in[20] + ((size_t)i * 64 + g) * 16 + 4 * q4);
        bf16x8 bfr[2][2][2]; float lbr[2], lbi[2];
#pragma unroll
        for (int dir = 0; dir < 2; ++dir) { const size_t pg = ((size_t)(i * 2 + dir) * 64 + g); const float logdt = a.in[15][pg];
#pragma unroll
            for (int ph = 0; ph < 2; ++ph) { const int pp = 32 * ph + l31; float tbr, tbi, tcr, tci;
                zoh_params(a.in[13][pg * 64 + pp], a.in[14][pg * 64 + pp], logdt, tbr, tbi, tcr, tci);
                if (dir == 0) { lbr[ph] = tbr; lbi[ph] = tbi; } else { lbr[ph] = h ? tbr : lbr[ph]; lbi[ph] = h ? tbi : lbi[ph]; }
                const float* brp = a.in[16] + (pg * 64 + pp) * 16 + 8 * h; const float* bip = a.in[17] + (pg * 64 + pp) * 16 + 8 * h;
                const f32x4 r0 = *(const f32x4*)brp, r1 = *(const f32x4*)(brp + 4), m0 = *(const f32x4*)bip, m1 = *(const f32x4*)(bip + 4);
                bfr[dir][ph][0] = __builtin_bit_cast(bf16x8, pg8::pack8(r0 * tcr - m0 * tci, r1 * tcr - m1 * tci));
                bfr[dir][ph][1] = __builtin_bit_cast(bf16x8, pg8::pack8(m0 * tcr + r0 * tci, m1 * tcr + r1 * tci)); } }
        bf16x8 cf[2][4];
#pragma unroll
        for (int dir = 0; dir < 2; ++dir) { const size_t pg = ((size_t)(i * 2 + dir) * 64 + g);
#pragma unroll
            for (int ks = 0; ks < 4; ++ks) { const size_t co = (pg * 16 + l15) * 64 + 16 * ks + 4 * q4;
                const f32x4 cre = *(const f32x4*)(a.in[18] + co), cim = *(const f32x4*)(a.in[19] + co);
                u32x4 wv; wv.x = pk2(cre[0], -cim[0]); wv.y = pk2(cre[1], -cim[1]); wv.z = pk2(cre[2], -cim[2]); wv.w = pk2(cre[3], -cim[3]);
                cf[dir][ks] = __builtin_bit_cast(bf16x8, wv); } }
        float xr[2] = {0.f, 0.f}, xi[2] = {0.f, 0.f};
        const size_t seq0 = (size_t)b * SEQ;
        bf16x8 au_n = *(const bf16x8*)(XB + (seq0 + (fwdrow ? slot : 16 * 127 + 15 - slot)) * D + 16 * g + 8 * h);
#pragma unroll 1
        for (int j = 0; j < 128; ++j) {
            const bf16x8 au = au_n;
            const size_t orow_f = seq0 + 16 * j + l15, orow_b = seq0 + 16 * (127 - j) + l15;
            const size_t oo_f = orow_f * D + 16 * g + 4 * q4, oo_b = orow_b * D + 16 * g + 4 * q4;
            u32x2 yfp[2], uup[2];
            if (j >= 64) { yfp[0] = *(const u32x2*)(YF + oo_f); yfp[1] = *(const u32x2*)(YF + oo_b); uup[0] = *(const u32x2*)(XB + oo_f); uup[1] = *(const u32x2*)(XB + oo_b); }
            else { yfp[0] = yfp[1] = (u32x2){0u, 0u}; uup[0] = uup[1] = (u32x2){0u, 0u}; }
            const bf16x8 zero8 = {0, 0, 0, 0, 0, 0, 0, 0};
            const bf16x8 a0 = fwdrow ? au : zero8, a1 = fwdrow ? zero8 : au;
            f32x16 z16;
#pragma unroll
            for (int k = 0; k < 16; ++k) z16[k] = 0.f;
            f32x16 P[2][2];
#pragma unroll
            for (int ph = 0; ph < 2; ++ph)
#pragma unroll
                for (int ri = 0; ri < 2; ++ri) { P[ph][ri] = MFMA32(a0, bfr[0][ph][ri], z16); P[ph][ri] = MFMA32(a1, bfr[1][ph][ri], P[ph][ri]); }
            __builtin_amdgcn_sched_barrier(0);
            { const int jn = (j < 127) ? j + 1 : j;
              au_n = *(const bf16x8*)(XB + (seq0 + (fwdrow ? 16 * jn + slot : 16 * (127 - jn) + 15 - slot)) * D + 16 * g + 8 * h); }
#pragma unroll
            for (int t = 0; t < 16; ++t) {
#pragma unroll
                for (int ph = 0; ph < 2; ++ph) {
                    const float t1 = __builtin_fmaf(-lbi[ph], xi[ph], P[ph][0][t]), t2 = __builtin_fmaf(lbi[ph], xr[ph], P[ph][1][t]);
                    xr[ph] = __builtin_fmaf(lbr[ph], xr[ph], t1); xi[ph] = __builtin_fmaf(lbr[ph], xi[ph], t2);
                    asm volatile("" : "+v"(xr[ph]), "+v"(xi[ph]));
                    *(LAS unsigned*)(xs + (16 * h + t) * S5_STRIDE + 4 * (32 * ph + l31)) = pk2(xr[ph], xi[ph]);
                }
            }
            f32x4 y4[2];
#pragma unroll
            for (int dd = 0; dd < 2; ++dd) {
                y4[dd] = (f32x4){0.f, 0.f, 0.f, 0.f};
                const int srow = dd ? 16 + (15 - l15) : l15;
#pragma unroll
                for (int ks = 0; ks < 4; ++ks) { const bf16x8 bx = *(const LAS bf16x8*)(xs + srow * S5_STRIDE + (32 * ks + 8 * q4) * 2); y4[dd] = MFMA16(cf[dd][ks], bx, y4[dd]); }
            }
            if (j < 64) { u32x2 p0, p1; p0.x = pk2(y4[0][0], y4[0][1]); p0.y = pk2(y4[0][2], y4[0][3]); p1.x = pk2(y4[1][0], y4[1][1]); p1.y = pk2(y4[1][2], y4[1][3]); *(u32x2*)(YF + oo_f) = p0; *(u32x2*)(YF + oo_b) = p1; }
            else {
#pragma unroll
                for (int dd = 0; dd < 2; ++dd) { const u32x2 uu = uup[dd];
                    const f32x4 uv = {bf_lo(uu.x), bf_hi(uu.x), bf_lo(uu.y), bf_hi(uu.y)};
                    const f32x4 yp = {bf_lo(yfp[dd].x), bf_hi(yfp[dd].x), bf_lo(yfp[dd].y), bf_hi(yfp[dd].y)};
                    const f32x4 y = yp + y4[dd] + dsk * uv;
                    u32x2 ov; ov.x = pk2(gelu_tanh(y[0]), gelu_tanh(y[1])); ov.y = pk2(gelu_tanh(y[2]), gelu_tanh(y[3])); *(u32x2*)(YG + (dd ? oo_b : oo_f)) = ov; }
            }
            { u32x4 t_ = __builtin_bit_cast(u32x4, au_n); asm volatile("" : "+v"(t_.x), "+v"(t_.y), "+v"(t_.z), "+v"(t_.w)); au_n = __builtin_bit_cast(bf16x8, t_); }
            LDS_WAIT();
        }
    }
}

__global__ void __launch_bounds__(NWAVES * 64, 2) fwd_kernel(Args args_by_value) {
    extern __shared__ __attribute__((aligned(16))) unsigned char lds[];
    Frame F;
    F.lds = (LAS unsigned char*)lds;
    F.MISC = (volatile LAS unsigned*)(F.lds + MISC_OFF);
    F.tid = threadIdx.x; F.lane = F.tid & 63; F.wave = __builtin_amdgcn_readfirstlane(F.tid >> 6);
    F.G = gridDim.x; F.bid = blockIdx.x;
    { kptr_t kp = (kptr_t)__builtin_amdgcn_kernarg_segment_ptr(); F.out = *(GASP float* const __attribute__((address_space(4)))*)(kp + 8 * 27); F.ws = *(GASP unsigned char* const __attribute__((address_space(4)))*)(kp + 8 * 28); }
    F.ctl = (unsigned*)(F.ws + WS_CTL);
    const ArgsRef args{};
    for (int u = F.tid; u < (LDS_BYTES - LDSCTL_OFF) / 4; u += NWAVES * 64) ((LAS unsigned*)(F.lds + LDSCTL_OFF))[u] = 0u;
    __syncthreads();
    XcdBarrier bar = xcd_barrier_post((GASP unsigned*)(F.ws + WS_CTL) + CW_BAR, F.MISC + 8, F.tid == 0);
#define GRID_BAR() xcd_barrier(bar, F.wave)
#define XB ((bf16*)(F.ws + WS_XB))
#define Yb ((bf16*)(F.ws + WS_Y))
#define Wb ((const char*)(F.ws + WS_W))
#define cosT ((const float*)(F.ws + WS_ROPE))
#define sinT ((const float*)(F.ws + WS_ROPE) + SEQ * 32)

    RPT(4) PH(0) prologue(F, args);
    RPT(4) PH(1) conv_layer(F, args, 0);
    GRID_BAR();

#pragma unroll 1
    for (int lp = 0; lp < 2; ++lp) {
        {
            const int L = 2 * lp, i = lp;
            { UFRESH(F); pg8::Order S{}; S.nM = T / 256; S.nN = INW / 256; S.nwg = S.nM * S.nN; S.G = F.G; S.c = F.bid; S.A = (const char*)XB; S.Bt = Wb + W_IN; S.tstep = (size_t)256 * D * 2; S.estride = 0;
              RPT(0) PH(2) { pg8::EpiWin E{(bf16*)(F.ws + WS_Q), (bf16*)(F.ws + WS_K), (bf16*)(F.ws + WS_V), (bf16*)(F.ws + WS_ZU), (bf16*)(F.ws + WS_ZV), cosT, sinT, args.in[7] + (size_t)i * 512, args.in[8] + (size_t)i * 512};
              pg8::gemm_phase(F.lds, D, S, E, F.wave); } }
            GRID_BAR();
            RPT(2) PH(3) attn_phase(F, args.in[4] + (size_t)i * 8);
            RPT(2) PH(4) sgu_phase(F, args.in[6] + (size_t)i * 8 * 128);
            GRID_BAR();
            { UFRESH(F); pg8::Order S{}; S.nM = T / 256; S.nN = D / 256; S.nwg = S.nM * S.nN; S.G = F.G; S.c = F.bid; S.A = (const char*)(F.ws + WS_MIX); S.Bt = Wb + W_OUT; S.tstep = (size_t)256 * D * 2; S.estride = 0;
              pg8::EpiPlain E{Yb, D, XB};
              RPT(0) PH(10) pg8::gemm_phase(F.lds, D, S, E, F.wave); }
            GRID_BAR();
            RPT(5) PH(5) ln_pass_plain(F, args.in[1] + (size_t)(L * 2 + 0) * D, args.in[2] + (size_t)(L * 2 + 0) * D, true);
            GRID_BAR();
            { UFRESH(F); pg8::Order S{}; S.nM = T / 256; S.nN = 2 * FF / 256; S.nwg = S.nM * S.nN; S.G = F.G; S.c = F.bid; S.A = (const char*)(F.ws + WS_XB8); S.Bt = Wb + W_GU; S.tstep = (size_t)256 * D; S.estride = 0;
              pg8::EpiPairI8 E{(bf16*)(F.ws + WS_H), FF, (const float*)(F.ws + WS_SX), (const float*)(F.ws + WS_SW)};
              RPT(0) PH(11) pg8::gemm_phase<pg8::EpiPairI8, true>(F.lds, D / 2, S, E, F.wave); }
            GRID_BAR();
            { UFRESH(F); pg8::Order S{}; S.nM = T / 256; S.nN = D / 256; S.nwg = S.nM * S.nN; S.G = F.G; S.c = F.bid; S.A = (const char*)(F.ws + WS_H); S.Bt = Wb + W_DN; S.tstep = (size_t)256 * FF * 2; S.estride = 0;
              pg8::EpiPlain E{Yb, D, XB};
              RPT(0) PH(10) pg8::gemm_phase(F.lds, FF, S, E, F.wave); }
            GRID_BAR();
            RPT(5) PH(5) ln_pass_plain(F, args.in[1] + (size_t)(L * 2 + 1) * D, args.in[2] + (size_t)(L * 2 + 1) * D, false);
            RPT(4) PH(1) conv_layer(F, args, L + 1);
            GRID_BAR();
        }
        {
            const int L = 2 * lp + 1, i = lp;
            unsigned* cnt = F.ctl + CW_CNT + 64 * i;
            RPT(3) PH(6) s5_phase(F, args, i);
            GRID_BAR();
            { UFRESH(F); pg8::Order S{}; S.nM = T / 256; S.nN = 2 * D / 256; S.nwg = S.nM * S.nN; S.G = F.G; S.c = F.bid; S.A = (const char*)(F.ws + WS_YG); S.Bt = Wb + W_GLU; S.tstep = (size_t)256 * D * 2; S.estride = 0;
              pg8::EpiPair<1> E{Yb, D, XB};
              RPT(0) PH(12) pg8::gemm_phase(F.lds, D, S, E, F.wave); }
            GRID_BAR();
            if ((RG >> 6) & 1) { PH(7) ln_pass_router(F, args.in[1] + (size_t)(L * 2 + 0) * D, args.in[2] + (size_t)(L * 2 + 0) * D, args.in[23] + (size_t)i * D * 8, cnt + 1024, WS_YS - WS_RECI); }
            PH(7) ln_pass_router(F, args.in[1] + (size_t)(L * 2 + 0) * D, args.in[2] + (size_t)(L * 2 + 0) * D, args.in[23] + (size_t)i * D * 8, cnt, 0);
            GRID_BAR();
            RPT(4) PH(8) moe_gather(F, cnt);
            GRID_BAR();
            {
                int tb[9], cn[8]; moe_tiles(cnt, tb, cn);
                const int ntt = tb[8], TC = 128, nch = (ntt + TC - 1) / TC;
RPT(1)
#pragma unroll 1
                for (int ch = 0; ch < nch; ++ch) {
                    const int t0 = ch * TC, t1 = (t0 + TC < ntt) ? t0 + TC : ntt, nM = (t1 > t0) ? t1 - t0 : 0;
                    { UFRESH(F); pg8::Order S{}; S.nM = nM; S.nN = 2 * FF / 256; S.nwg = S.nM * S.nN; S.G = F.G; S.c = F.bid; S.atile0 = t0; S.otile0 = 0; S.etile0 = t0;
                      S.A = (const char*)(F.ws + WS_XS); S.Bt = Wb + W_MGU; S.tstep = (size_t)256 * D; S.estride = (size_t)2 * FF * D;
#pragma unroll
                      for (int e = 0; e < 8; ++e) S.tb[e] = tb[e];
                      pg8::EpiPairI8 E{(bf16*)(F.ws + WS_HS), FF, (const float*)(F.ws + WS_SXS), (const float*)(F.ws + WS_SW)};
                      PH(13) pg8::gemm_phase<pg8::EpiPairI8, true>(F.lds, D / 2, S, E, F.wave); }
                    GRID_BAR();
                    { UFRESH(F); pg8::Order S{}; S.nM = nM; S.nN = D / 256; S.nwg = S.nM * S.nN; S.G = F.G; S.c = F.bid; S.atile0 = 0; S.otile0 = t0; S.etile0 = t0;
                      S.A = (const char*)(F.ws + WS_HS); S.Bt = Wb + W_MDN; S.tstep = (size_t)256 * FF * 2; S.estride = (size_t)D * FF * 2;
#pragma unroll
                      for (int e = 0; e < 8; ++e) S.tb[e] = tb[e];
                      pg8::EpiPlain E{(bf16*)(F.ws + WS_YS), D, nullptr};
                      PH(14) pg8::gemm_phase(F.lds, FF, S, E, F.wave); }
                    GRID_BAR();
                }
            }
            if ((RG >> 7) & 1) { PH(9) ln_pass_combine(F, args.in[1] + (size_t)(L * 2 + 1) * D, args.in[2] + (size_t)(L * 2 + 1) * D, cnt, L == 3, true); }
            PH(9) ln_pass_combine(F, args.in[1] + (size_t)(L * 2 + 1) * D, args.in[2] + (size_t)(L * 2 + 1) * D, cnt, L == 3, false);
            if (L + 1 < 4) { RPT(4) PH(1) conv_layer(F, args, L + 1); GRID_BAR(); }
        }
    }
}

extern "C" void kernel_launch(void* const* d_in, const int* in_sizes, int n_in, void* d_out, int out_size, void* d_ws, size_t ws_size, hipStream_t stream) {
    static int grid = 0;
    if (grid == 0) {
        if (n_in != 27 || in_sizes[0] != T * D || out_size != T * D || ws_size < WS_END) {
            fprintf(stderr, "kernel_launch: unexpected shapes (n_in %d, in0 %d, out %d, ws %zu; need ws >= %zu); nothing launched\n", n_in, n_in > 0 ? in_sizes[0] : -1, out_size, ws_size, (size_t)WS_END); grid = -1; return; }
        int dev = 0, cus = 0, per_cu = 0;
        if (hipGetDevice(&dev) != hipSuccess || hipDeviceGetAttribute(&cus, hipDeviceAttributeMultiprocessorCount, dev) != hipSuccess) { grid = -1; return; }
        if (hipFuncSetAttribute((const void*)fwd_kernel, hipFuncAttributeMaxDynamicSharedMemorySize, LDS_BYTES) != hipSuccess) { fprintf(stderr, "kernel_launch: hipFuncSetAttribute failed\n"); grid = -1; return; }
        if (hipOccupancyMaxActiveBlocksPerMultiprocessor(&per_cu, (const void*)fwd_kernel, NWAVES * 64, LDS_BYTES) != hipSuccess || per_cu < 1)
            fprintf(stderr, "kernel_launch: note: occupancy query reports %d workgroups per CU\n", per_cu);
        (void)hipGetLastError();
        grid = cus;
    }
    if (grid < 0) return;
    if (hipMemsetAsync((char*)d_ws + WS_CTL, 0, CTL_ZERO_BYTES, stream) != hipSuccess) return;
    Args a{};
    for (int i = 0; i < 27; ++i) a.in[i] = (const float*)d_in[i];
    a.out = (float*)d_out; a.ws = (unsigned char*)d_ws;
    hipLaunchKernelGGL(fwd_kernel, dim3(grid), dim3(NWAVES * 64), LDS_BYTES, stream, a);
}
```

```cpp
#include <hip/hip_runtime.h>
#include <cstdio>
#include <cstdint>

#define LAS __attribute__((address_space(3)))
typedef unsigned short bf16;
typedef short bf16x8 __attribute__((ext_vector_type(8)));
typedef short s16x4 __attribute__((ext_vector_type(4)));
typedef float f32x4 __attribute__((ext_vector_type(4)));
typedef float f32x2 __attribute__((ext_vector_type(2)));
typedef float f32x16 __attribute__((ext_vector_type(16)));
typedef unsigned u32x4 __attribute__((ext_vector_type(4)));
typedef unsigned u32x2 __attribute__((ext_vector_type(2)));
typedef int i32x4 __attribute__((ext_vector_type(4)));
typedef int i32x8 __attribute__((ext_vector_type(8)));
typedef __bf16 bf2_t __attribute__((ext_vector_type(2)));
#define DI __device__ __forceinline__
#define GASP __attribute__((address_space(1)))
template <class T> DI T* as_global(T* p) { return (T*)(GASP T*)p; }
#ifndef PHM
#define PHM 0xFFFFF
#endif
#define PH(b) if (PHM & (1 << (b)))
#ifndef RG
#define RG 0
#endif
#define RPT(g) for (int rep_ = 0, nrep_ = rep_count(((RG) >> (g)) & 1); rep_ < nrep_; ++rep_)
#define UFRESH(F) do { asm volatile("" : "+s"((F).ws), "+s"((F).out), "+s"((F).G), "+s"((F).bid)); (F).ctl = (unsigned*)((F).ws + WS_CTL); } while (0)
#define FRESH(F) do { UFRESH(F); int l_ = lane_id(); asm volatile("" : "+v"(l_)); (F).lane = l_; (F).tid = (F).wave * 64 + l_; } while (0)

constexpr int NWAVES = 8;
constexpr int BATCH = 32, SEQ = 2048, D = 1024, T = BATCH * SEQ;
constexpr int INW = 1792, FF = 2816, NE = 8;
constexpr float ALPHA = 1.6817928305074290f;
constexpr float LN_EPS = 1e-5f;
constexpr float QSCALE = 0.18033688011112042f;
constexpr float LOG2E = 1.4426950408889634f;

constexpr size_t MiB = 1u << 20;
constexpr size_t WS_CTL = 0, CTL_ZERO_BYTES = 1 * MiB;
constexpr size_t WS_ROPE = 1 * MiB;
constexpr size_t WS_RECI = 2 * MiB;
constexpr size_t WS_RECW = 3 * MiB;
constexpr size_t WS_SGUW = 4 * MiB;
constexpr size_t WS_SX = 5 * MiB;
constexpr size_t WS_SW = 6 * MiB;
constexpr size_t WS_SXS = 7 * MiB;
constexpr size_t WS_W = 16 * MiB;
constexpr size_t WS_XB = 156 * MiB;
constexpr size_t WS_Y = 284 * MiB;
constexpr size_t WS_R = 412 * MiB;
constexpr size_t WS_Q = WS_R, WS_K = WS_Q + 64 * MiB, WS_V = WS_K + 16 * MiB, WS_ZU = WS_V + 16 * MiB, WS_ZV = WS_ZU + 64 * MiB, WS_MIX = WS_ZV + 64 * MiB;
constexpr size_t WS_H = WS_R;
constexpr size_t WS_YF = WS_R;
constexpr size_t WS_YG = WS_R + 256 * MiB;
constexpr int XS_ROWS = 2 * T + NE * 256;
constexpr int TC_MAX = 130;
constexpr size_t WS_XB8 = 768 * MiB;
constexpr size_t WS_XS = 284 * MiB;
constexpr size_t WS_HS = 416 * MiB;
constexpr size_t WS_YS = 600 * MiB;
constexpr size_t WS_END = 860 * MiB;
constexpr size_t W_IN = 0, W_OUT = 4 * MiB, W_GU = 6 * MiB, W_DN = 17 * MiB;
constexpr size_t W_GLU = 0, W_MGU = 4 * MiB, W_MDN = 48 * MiB;
constexpr int CW_TMO = 0, CW_DBG = 2, CW_BAR = 4096, CW_CNT = 8192;

constexpr int RING_BYTES = 131072;
constexpr int LDSCTL_OFF = RING_BYTES, MISC_OFF = LDSCTL_OFF + 320;
constexpr int LDS_BYTES = 147456;

DI unsigned pk2(float lo, float hi) { f32x2 v = {lo, hi}; return __builtin_bit_cast(unsigned, __builtin_convertvector(v, bf2_t)); }
DI unsigned q8(float v, float inv) { return __float_as_uint(__builtin_fmaf(v, inv, 12582912.0f)) & 0xffu; }
DI unsigned pk4_i8(float a, float b, float c, float d, float inv) { return q8(a, inv) | (q8(b, inv) << 8) | (q8(c, inv) << 16) | (q8(d, inv) << 24); }
DI float bf_lo(unsigned w) { return __uint_as_float(w << 16); }
DI float bf_hi(unsigned w) { return __uint_as_float(w & 0xffff0000u); }
DI float fast_exp2(float x) { return __builtin_amdgcn_exp2f(x); }
DI float fast_rcp(float x) { return __builtin_amdgcn_rcpf(x); }
DI float sigmoidf_(float x) { return fast_rcp(1.0f + fast_exp2(-LOG2E * x)); }
DI float gelu_tanh(float x) { const float z = x + 0.044715f * x * x * x; return x * fast_rcp(1.0f + fast_exp2(-2.302208198f * z)); }
#define dpp_f(v, ctrl) __int_as_float(__builtin_amdgcn_mov_dpp(__float_as_int(v), (ctrl), 0xf, 0xf, true))
#define DPP_XOR1 0xB1
#define DPP_XOR2 0x4E
#define DPP_HMIRROR 0x141
#define DPP_MIRROR 0x140
DI float swz16_f(float v) { return __int_as_float(__builtin_amdgcn_ds_swizzle(__float_as_int(v), 0x401F)); }
DI float sum_x32(float v) { auto r = __builtin_amdgcn_permlane32_swap(__float_as_uint(v), __float_as_uint(v), false, false); return __uint_as_float(r[0]) + __uint_as_float(r[1]); }
DI float max_x32(float v) { auto r = __builtin_amdgcn_permlane32_swap(__float_as_uint(v), __float_as_uint(v), false, false); return fmaxf(__uint_as_float(r[0]), __uint_as_float(r[1])); }
DI float wave_max(float v) {
    v = fmaxf(v, dpp_f(v, DPP_XOR1)); v = fmaxf(v, dpp_f(v, DPP_XOR2)); v = fmaxf(v, dpp_f(v, DPP_HMIRROR)); v = fmaxf(v, dpp_f(v, DPP_MIRROR)); v = fmaxf(v, swz16_f(v)); return max_x32(v);
}
DI float wave_sum(float v) {
    v += dpp_f(v, DPP_XOR1); v += dpp_f(v, DPP_XOR2); v += dpp_f(v, DPP_HMIRROR); v += dpp_f(v, DPP_MIRROR); v += swz16_f(v); return sum_x32(v);
}
#define LDS_WAIT() asm volatile("s_waitcnt lgkmcnt(0)" ::: "memory")
#define VM_WAIT() asm volatile("s_waitcnt vmcnt(0)" ::: "memory")
DI int lane_id() { unsigned ones = ~0u; asm volatile("" : "+s"(ones)); return (int)__builtin_amdgcn_mbcnt_hi(ones, __builtin_amdgcn_mbcnt_lo(ones, 0u)); }
DI int rep_count(int extra) { int n = 1 + extra; asm volatile("" : "+s"(n)); return n; }
DI int crow(int reg, int h) { return (reg & 3) + 8 * (reg >> 2) + 4 * h; }
#define MFMA32(a, b, c) __builtin_amdgcn_mfma_f32_32x32x16_bf16((a), (b), (c), 0, 0, 0)
#define MFMA16(a, b, c) __builtin_amdgcn_mfma_f32_16x16x32_bf16((a), (b), (c), 0, 0, 0)

DI void sincos_d(double th, double& s, double& c) {
    const double tq = th * 0.63661977236758134308;
    const double q = rint(tq);
    const double f = (tq - q) * 1.57079632679489661923;
    const double f2 = f * f;
    const double sp = f * (1.0 + f2 * (-1.0 / 6 + f2 * (1.0 / 120 + f2 * (-1.0 / 5040 + f2 * (1.0 / 362880 + f2 * (-1.0 / 39916800 + f2 * (1.0 / 6227020800.0)))))));
    const double cp = 1.0 + f2 * (-0.5 + f2 * (1.0 / 24 + f2 * (-1.0 / 720 + f2 * (1.0 / 40320 + f2 * (-1.0 / 3628800 + f2 * (1.0 / 479001600.0 + f2 * (-1.0 / 87178291200.0)))))));
    const int qi = ((int)q) & 3;
    s = (qi == 0) ? sp : (qi == 1) ? cp : (qi == 2) ? -sp : -cp;
    c = (qi == 0) ? cp : (qi == 1) ? -sp : (qi == 2) ? -cp : sp;
}
DI double exp_d(double x) {
    const double n = rint(x * 1.4426950408889634074);
    const double r = x - n * 0.69314718055994530942;
    double p = 1.0 / 87178291200.0;
    p = p * r + 1.0 / 6227020800.0; p = p * r + 1.0 / 479001600.0; p = p * r + 1.0 / 39916800.0; p = p * r + 1.0 / 3628800.0; p = p * r + 1.0 / 362880.0;
    p = p * r + 1.0 / 40320.0; p = p * r + 1.0 / 5040.0; p = p * r + 1.0 / 720.0; p = p * r + 1.0 / 120.0; p = p * r + 1.0 / 24.0; p = p * r + 1.0 / 6.0; p = p * r + 0.5; p = p * r + 1.0; p = p * r + 1.0;
    const long long bits = (long long)((int)n + 1023) << 52;
    return p * __builtin_bit_cast(double, bits);
}

namespace pg8 {
constexpr int BM = 256, BK = 64, HALF = 128, HTB = HALF * BK * 2, STAGE_BYTES = 8 * HTB, NXCD = 8, WGM = 8;
DI int lds_byte(int r, int c) { const int st = (r >> 4) * 2 + (c >> 5), rr = r & 15, cc = c & 31, ob = rr * 64 + cc * 2; return st * 1024 + (ob ^ (((ob >> 9) & 1) << 5)); }
DI void stage_rc(int b, int& R, int& C) { const int st = b / 1024, sb = b % 1024, swz = sb ^ (((sb >> 9) & 1) << 5); R = (st >> 1) * 16 + swz / 64; C = (st & 1) * 32 + (swz % 64) / 2; }
DI int perm32(int rho) { const int n = rho >> 4, i = rho & 15; return 8 * (i >> 2) + 4 * n + (i & 3); }

struct Unit { int pm, pn, row0, arow0, e; const char* a; const char* b; };
struct Order {
    int nM, nN, nwg, G, c, atile0, otile0, etile0;
    const char* A; const char* Bt; size_t tstep, estride;
    int tb[8];
    DI bool next(int i, Unit& u) const {
        const long L = (long)i * G + c; if (L >= nwg) return false;
        int wgid = (int)L; { const int q = nwg / NXCD, r = nwg % NXCD, xcd = wgid % NXCD, off = wgid / NXCD; wgid = (xcd < r ? xcd * (q + 1) : r * (q + 1) + (xcd - r) * q) + off; }
        const int nig = WGM * nN, gid = wgid / nig, fm = gid * WGM, gsz = (nM - fm) < WGM ? (nM - fm) : WGM;
        u.pm = fm + ((wgid % nig) % gsz); u.pn = (wgid % nig) / gsz;
        u.row0 = (otile0 + u.pm) * BM;
        int e = 0;
        if (estride) { const int t = etile0 + u.pm;
#pragma unroll
            for (int j = 1; j < 8; ++j) e += (t >= tb[j]) ? 1 : 0; }
        u.e = e; u.arow0 = (atile0 + u.pm) * BM;
        u.a = A + (size_t)(atile0 + u.pm) * tstep; u.b = Bt + (size_t)e * estride + (size_t)u.pn * tstep;
        return true;
    }
};

template <class Epi, bool I8 = false>
DI void gemm_phase(LAS unsigned char* lds, const int K, const Order& S, const Epi& E, const int wid) {
    int lane = lane_id(); asm volatile("" : "+v"(lane));
    const int tid = wid * 64 + lane, wr = wid >> 2, wc = wid & 3, fr = lane & 15, fq = lane >> 4;
    const int nt = K / BK;
    unsigned voffA[2], voffB[2];
#pragma unroll
    for (int i = 0; i < 2; ++i) { int R, C; stage_rc(tid * 16 + i * 8192, R, C); const int Rb = (R & ~31) + perm32(R & 31);
        voffA[i] = (unsigned)(R * K + C) * 2u; voffB[i] = (unsigned)(Rb * K + C) * 2u; }
    const size_t kstep = (size_t)(BK * 2);
    const size_t hstep = (size_t)HALF * K * 2;
    const unsigned ldsw = (unsigned)wid * 1024u;
    const int aoff = lds_byte(wr * 64 + fr, fq * 8), boff = lds_byte(wc * 32 + fr, fq * 8);
#define PG8_SA(b, h) (((b) * 2 + (h)) * HTB)
#define PG8_SB(b, h) ((4 + (b) * 2 + (h)) * HTB)
#define PG8_STAGE(bufoff, gbase, voff) do { _Pragma("unroll") for (int _i = 0; _i < 2; ++_i) \
        __builtin_amdgcn_global_load_lds((const unsigned*)((const char*)(gbase) + (voff)[_i]), (LAS unsigned*)(lds + (bufoff) + ldsw + _i * 8192), 16, 0, 0); } while (0)
#define PG8_LDA(dst, b, h) do { _Pragma("unroll") for (int m = 0; m < 4; ++m) _Pragma("unroll") for (int k = 0; k < 2; ++k) dst[m][k] = *(const LAS bf16x8*)(lds + PG8_SA(b, h) + aoff + m * 2048 + k * 1024); } while (0)
#define PG8_LDB(dst, b, h) do { _Pragma("unroll") for (int n = 0; n < 2; ++n) _Pragma("unroll") for (int k = 0; k < 2; ++k) dst[n][k] = *(const LAS bf16x8*)(lds + PG8_SB(b, h) + boff + n * 2048 + k * 1024); } while (0)
#define PG8_MMA(ai, bj, At, Bt) do { __builtin_amdgcn_s_setprio(1); _Pragma("unroll") for (int m = 0; m < 4; ++m) _Pragma("unroll") for (int n = 0; n < 2; ++n) _Pragma("unroll") for (int k = 0; k < 2; ++k) \
        { if constexpr (I8) acc[ai][bj][m][n] = __builtin_bit_cast(f32x4, __builtin_amdgcn_mfma_i32_16x16x64_i8(__builtin_bit_cast(i32x4, Bt[n][k]), __builtin_bit_cast(i32x4, At[m][k]), __builtin_bit_cast(i32x4, acc[ai][bj][m][n]), 0, 0, 0)); \
          else acc[ai][bj][m][n] = __builtin_amdgcn_mfma_f32_16x16x32_bf16(Bt[n][k], At[m][k], acc[ai][bj][m][n], 0, 0, 0); } __builtin_amdgcn_s_setprio(0); } while (0)
#define PG8_WAIT_V(n) asm volatile("s_waitcnt vmcnt(" #n ")" ::: "memory")
#define PG8_WAIT_L(n) asm volatile("s_waitcnt lgkmcnt(" #n ")" ::: "memory")
#define PG8_BAR __builtin_amdgcn_s_barrier()
#define PG8_SCHED __builtin_amdgcn_sched_barrier(0)
    Unit cur, nxt; int ui = 0;
    if (!S.next(0, cur)) return;
    f32x4 acc[2][2][4][2];
#pragma unroll
    for (int a = 0; a < 2; ++a)
#pragma unroll
        for (int b = 0; b < 2; ++b)
#pragma unroll
            for (int m = 0; m < 4; ++m)
#pragma unroll
                for (int n = 0; n < 2; ++n) acc[a][b][m][n] = (f32x4){0.f, 0.f, 0.f, 0.f};
    bf16x8 At[4][2], B0[2][2], B1[2][2];
    const char* cA = cur.a; const char* cB = cur.b;
    PG8_STAGE(PG8_SB(0, 0), cB, voffB); PG8_STAGE(PG8_SB(0, 1), cB + hstep, voffB); PG8_STAGE(PG8_SA(0, 0), cA, voffA); PG8_STAGE(PG8_SA(0, 1), cA + hstep, voffA);
    if (wr == 1) PG8_BAR;
    PG8_WAIT_V(2); PG8_BAR;
    PG8_STAGE(PG8_SB(1, 0), cB + kstep, voffB); PG8_STAGE(PG8_SA(1, 0), cA + kstep, voffA); PG8_STAGE(PG8_SB(1, 1), cB + hstep + kstep, voffB);
    PG8_WAIT_V(6); PG8_BAR;
    for (;;) {
        const bool has_next = S.next(ui + 1, nxt);
        const char* nA = has_next ? nxt.a : cA; const char* nB = has_next ? nxt.b : cB;
#pragma unroll 1
        for (int t = 0; t < nt; t += 2) {
            const bool last = (t == nt - 2);
            const char* a1 = cA + (size_t)(t + 1) * kstep;
            const char* a2 = last ? nA : cA + (size_t)(t + 2) * kstep; const char* b2 = last ? nB : cB + (size_t)(t + 2) * kstep;
            const char* a3 = a2 + kstep; const char* b3 = b2 + kstep;
            PG8_LDB(B0, 0, 0); PG8_LDB(B1, 0, 1); PG8_SCHED; PG8_LDA(At, 0, 0); PG8_STAGE(PG8_SA(1, 1), a1 + hstep, voffA);
            PG8_WAIT_V(8); PG8_WAIT_L(0); PG8_BAR; PG8_MMA(0, 0, At, B0); PG8_MMA(0, 1, At, B1); PG8_BAR; PG8_SCHED;
            PG8_LDA(At, 0, 1); PG8_STAGE(PG8_SB(0, 0), b2, voffB); PG8_STAGE(PG8_SB(0, 1), b2 + hstep, voffB); PG8_STAGE(PG8_SA(0, 0), a2, voffA);
            PG8_WAIT_V(8); PG8_WAIT_L(0); PG8_BAR; PG8_MMA(1, 0, At, B0); PG8_MMA(1, 1, At, B1); PG8_BAR; PG8_SCHED;
            PG8_LDB(B0, 1, 0); PG8_LDB(B1, 1, 1); PG8_SCHED; PG8_LDA(At, 1, 0); PG8_STAGE(PG8_SA(0, 1), a2 + hstep, voffA);
            PG8_WAIT_V(8); PG8_WAIT_L(0); PG8_BAR; PG8_MMA(0, 0, At, B0); PG8_MMA(0, 1, At, B1); PG8_BAR; PG8_SCHED;
            PG8_LDA(At, 1, 1); PG8_STAGE(PG8_SB(1, 0), b3, voffB); PG8_STAGE(PG8_SB(1, 1), b3 + hstep, voffB); PG8_STAGE(PG8_SA(1, 0), a3, voffA);
            PG8_WAIT_V(8); PG8_WAIT_L(0); PG8_BAR; PG8_MMA(1, 0, At, B0); PG8_MMA(1, 1, At, B1); PG8_BAR; PG8_SCHED;
        }
        if (wr == 0) PG8_BAR;
        E(acc, cur, wr, wc, fr, fq);
        if (!has_next) break;
#pragma unroll
        for (int a = 0; a < 2; ++a)
#pragma unroll
            for (int b = 0; b < 2; ++b)
#pragma unroll
                for (int m = 0; m < 4; ++m)
#pragma unroll
                    for (int n = 0; n < 2; ++n) acc[a][b][m][n] = (f32x4){0.f, 0.f, 0.f, 0.f};
        cur = nxt; cA = nA; cB = nB; ++ui;
        if (wr == 1) PG8_BAR;
    }
    PG8_WAIT_V(0);
    PG8_BAR;
#undef PG8_SA
#undef PG8_SB
#undef PG8_STAGE
#undef PG8_LDA
#undef PG8_LDB
#undef PG8_MMA
#undef PG8_WAIT_V
#undef PG8_WAIT_L
#undef PG8_BAR
#undef PG8_SCHED
}

DI u32x4 pack8(const f32x4 a, const f32x4 b) { u32x4 w; w.x = pk2(a[0], a[1]); w.y = pk2(a[2], a[3]); w.z = pk2(b[0], b[1]); w.w = pk2(b[2], b[3]); return w; }

DI f32x4 bfx4_lo(const u32x4 w) { return (f32x4){bf_lo(w.x), bf_hi(w.x), bf_lo(w.y), bf_hi(w.y)}; }
DI f32x4 bfx4_hi(const u32x4 w) { return (f32x4){bf_lo(w.z), bf_hi(w.z), bf_lo(w.w), bf_hi(w.w)}; }
struct EpiPlain {
    bf16* O; int ldc; const bf16* R;
    DI void operator()(const f32x4 (&acc)[2][2][4][2], const Unit& u, int wr, int wc, int fr, int fq) const {
        asm volatile("" : "+v"(fr), "+v"(fq));
        const int row0 = u.row0 + wr * 64 + fr, col0 = u.pn * BM + wc * 32 + 8 * fq;
        if (R) {
            u32x4 r0[8], r1[8];
#pragma unroll
            for (int g = 0; g < 8; ++g) { const size_t off = (size_t)(row0 + (g >> 2) * HALF + (g & 3) * 16) * ldc + col0; r0[g] = *(const u32x4*)(R + off); r1[g] = *(const u32x4*)(R + off + HALF); }
            asm volatile("" ::: "memory");
#pragma unroll
            for (int g = 0; g < 8; ++g) { const int ai = g >> 2, m = g & 3; const size_t off = (size_t)(row0 + ai * HALF + m * 16) * ldc + col0;
                *(u32x4*)(O + off) = pack8(acc[ai][0][m][0] + bfx4_lo(r0[g]) * ALPHA, acc[ai][0][m][1] + bfx4_hi(r0[g]) * ALPHA);
                *(u32x4*)(O + off + HALF) = pack8(acc[ai][1][m][0] + bfx4_lo(r1[g]) * ALPHA, acc[ai][1][m][1] + bfx4_hi(r1[g]) * ALPHA); }
        } else {
#pragma unroll
            for (int ai = 0; ai < 2; ++ai)
#pragma unroll
                for (int m = 0; m < 4; ++m) { const size_t off = (size_t)(row0 + ai * HALF + m * 16) * ldc + col0;
#pragma unroll
                    for (int bj = 0; bj < 2; ++bj) *(u32x4*)(O + off + bj * HALF) = pack8(acc[ai][bj][m][0], acc[ai][bj][m][1]); }
        }
    }
};
template <int ACT> struct EpiPair {
    bf16* O; int ldc; const bf16* R;
    DI void operator()(const f32x4 (&acc)[2][2][4][2], const Unit& u, int wr, int wc, int fr, int fq) const {
        asm volatile("" : "+v"(fr), "+v"(fq));
        const int row0 = u.row0 + wr * 64 + fr, col0 = u.pn * HALF + wc * 32 + 8 * fq;
        u32x4 r[8];
#pragma unroll
        for (int g = 0; g < 8; ++g) { r[g] = (u32x4){0u, 0u, 0u, 0u}; if (R) r[g] = *(const u32x4*)(R + (size_t)(row0 + (g >> 2) * HALF + (g & 3) * 16) * ldc + col0); }
        if (R) asm volatile("" ::: "memory");
#pragma unroll
        for (int g = 0; g < 8; ++g) { const int ai = g >> 2, m = g & 3;
            const size_t off = (size_t)(row0 + ai * HALF + m * 16) * ldc + col0;
            f32x4 o[2];
            if (R) { o[0] = bfx4_lo(r[g]) * ALPHA; o[1] = bfx4_hi(r[g]) * ALPHA; } else { o[0] = (f32x4){0.f, 0.f, 0.f, 0.f}; o[1] = o[0]; }
#pragma unroll
            for (int n = 0; n < 2; ++n) { const f32x4 a = acc[ai][0][m][n], b = acc[ai][1][m][n];
#pragma unroll
                for (int j = 0; j < 4; ++j) o[n][j] += (ACT == 0) ? a[j] * sigmoidf_(a[j]) * b[j] : a[j] * sigmoidf_(b[j]); }
            *(u32x4*)(O + off) = pack8(o[0], o[1]); }
    }
};
struct EpiPairI8 {
    bf16* O; int ldc; const float* sx; const float* sw;
    DI void operator()(const f32x4 (&acc)[2][2][4][2], const Unit& u, int wr, int wc, int fr, int fq) const {
        asm volatile("" : "+v"(fr), "+v"(fq));
        const int rloc = wr * 64 + fr, col0 = u.pn * HALF + wc * 32 + 8 * fq;
        const float* swp = sw + (size_t)u.e * (2 * FF) + u.pn * BM + wc * 32 + 8 * fq;
        f32x4 sg[2], su[2];
#pragma unroll
        for (int n = 0; n < 2; ++n) { sg[n] = *(const f32x4*)(swp + 4 * n); su[n] = *(const f32x4*)(swp + HALF + 4 * n); }
        float srv[8];
#pragma unroll
        for (int g = 0; g < 8; ++g) srv[g] = sx[u.arow0 + rloc + (g >> 2) * HALF + (g & 3) * 16];
#pragma unroll
        for (int ai = 0; ai < 2; ++ai)
#pragma unroll
            for (int m = 0; m < 4; ++m) {
                const int rr = rloc + ai * HALF + m * 16;
                const float sr = srv[ai * 4 + m];
                f32x4 o[2];
#pragma unroll
                for (int n = 0; n < 2; ++n) {
                    const f32x4 a = __builtin_convertvector(__builtin_bit_cast(i32x4, acc[ai][0][m][n]), f32x4) * (sg[n] * sr);
                    const f32x4 b = __builtin_convertvector(__builtin_bit_cast(i32x4, acc[ai][1][m][n]), f32x4) * (su[n] * sr);
                    const f32x4 t = a * (-LOG2E);
                    f32x4 e; e[0] = fast_exp2(t[0]); e[1] = fast_exp2(t[1]); e[2] = fast_exp2(t[2]); e[3] = fast_exp2(t[3]);
                    e = e + 1.0f;
                    f32x4 r; r[0] = fast_rcp(e[0]); r[1] = fast_rcp(e[1]); r[2] = fast_rcp(e[2]); r[3] = fast_rcp(e[3]);
                    o[n] = (a * r) * b; }
                *(u32x4*)(O + (size_t)(u.row0 + rr) * ldc + col0) = pack8(o[0], o[1]);
                asm volatile("" ::: "memory"); }
    }
};
struct EpiWin {
    bf16 *Q, *Kb, *Vb, *ZU, *ZV; const float *cosT, *sinT, *lng, *lnb;
    DI void operator()(const f32x4 (&acc)[2][2][4][2], const Unit& u, int wr, int wc, int fr, int fq) const {
        asm volatile("" : "+v"(fr), "+v"(fq));
        const int rbase = u.row0 + wr * 64 + fr, pn = u.pn;
        if (pn < 2 || (pn == 2 && wc < 2)) {
            bf16* dst; int ld, colb; float sc;
            if (pn < 2) { dst = Q; ld = 512; colb = 64 * (4 * pn + wc); sc = QSCALE; } else { dst = Kb; ld = 128; colb = 64 * wc; sc = 1.0f; }
#pragma unroll
            for (int hb = 0; hb < 2; ++hb) {
                f32x4 cc[4][2], ss[4][2];
#pragma unroll
                for (int m = 0; m < 4; ++m) { const int pos = (rbase + hb * HALF + m * 16) & (SEQ - 1);
#pragma unroll
                    for (int n = 0; n < 2; ++n) { cc[m][n] = *(const f32x4*)(cosT + pos * 32 + 8 * fq + 4 * n); ss[m][n] = *(const f32x4*)(sinT + pos * 32 + 8 * fq + 4 * n); } }
                asm volatile("" ::: "memory");
#pragma unroll
                for (int m = 0; m < 4; ++m) { const int ai = hb; const int row = rbase + ai * HALF + m * 16;
                    f32x4 o1[2], o2[2];
#pragma unroll
                    for (int n = 0; n < 2; ++n) { const f32x4 x1 = acc[ai][0][m][n], x2 = acc[ai][1][m][n];
                        o1[n] = (x1 * cc[m][n] - x2 * ss[m][n]) * sc; o2[n] = (x2 * cc[m][n] + x1 * ss[m][n]) * sc; }
                    bf16* rp = dst + (size_t)row * ld + colb + 8 * fq;
                    *(u32x4*)(rp) = pack8(o1[0], o1[1]); *(u32x4*)(rp + 32) = pack8(o2[0], o2[1]); }
                asm volatile("" ::: "memory");
            }
        } else if (pn == 2) {
#pragma unroll
            for (int ai = 0; ai < 2; ++ai)
#pragma unroll
                for (int m = 0; m < 4; ++m) { int row = rbase + ai * HALF + m * 16; asm volatile("" : "+v"(row) :: "memory"); bf16* rp = Vb + (size_t)row * 128 + 64 * (wc - 2) + 8 * fq;
#pragma unroll
                    for (int bj = 0; bj < 2; ++bj) *(u32x4*)(rp + 32 * bj) = pack8(acc[ai][bj][m][0], acc[ai][bj][m][1]); }
        } else if (pn < 5) {
#pragma unroll
            for (int ai = 0; ai < 2; ++ai)
#pragma unroll
                for (int m = 0; m < 4; ++m) { int row = rbase + ai * HALF + m * 16; asm volatile("" : "+v"(row) :: "memory"); bf16* rp = ZU + (size_t)row * 512 + 256 * (pn - 3) + 64 * wc + 8 * fq;
#pragma unroll
                    for (int bj = 0; bj < 2; ++bj) { f32x4 a = acc[ai][bj][m][0], b = acc[ai][bj][m][1];
#pragma unroll
                        for (int j = 0; j < 4; ++j) { a[j] = gelu_tanh(a[j]); b[j] = gelu_tanh(b[j]); }
                        *(u32x4*)(rp + 32 * bj) = pack8(a, b); } }
        } else {
            const int gi = 4 * (pn - 5) + wc;
            f32x4 gg[2][2], bb[2][2];
#pragma unroll
            for (int bj = 0; bj < 2; ++bj)
#pragma unroll
                for (int n = 0; n < 2; ++n) { gg[bj][n] = *(const f32x4*)(lng + gi * 64 + 32 * bj + 8 * fq + 4 * n); bb[bj][n] = *(const f32x4*)(lnb + gi * 64 + 32 * bj + 8 * fq + 4 * n); }
#pragma unroll
            for (int ai = 0; ai < 2; ++ai)
#pragma unroll
                for (int m = 0; m < 4; ++m) { int row = rbase + ai * HALF + m * 16; asm volatile("" : "+v"(row) :: "memory");
                    f32x4 z[2][2]; float s = 0.f;
#pragma unroll
                    for (int bj = 0; bj < 2; ++bj)
#pragma unroll
                        for (int n = 0; n < 2; ++n) {
#pragma unroll
                            for (int j = 0; j < 4; ++j) { z[bj][n][j] = gelu_tanh(acc[ai][bj][m][n][j]); s += z[bj][n][j]; } }
                    s += swz16_f(s); s = sum_x32(s);
                    const float mean = s * (1.0f / 64.0f); float q = 0.f;
#pragma unroll
                    for (int bj = 0; bj < 2; ++bj)
#pragma unroll
                        for (int n = 0; n < 2; ++n) { z[bj][n] = z[bj][n] - mean; q += (z[bj][n][0] * z[bj][n][0] + z[bj][n][1] * z[bj][n][1]) + (z[bj][n][2] * z[bj][n][2] + z[bj][n][3] * z[bj][n][3]); }
                    q += swz16_f(q); q = sum_x32(q);
                    const float rstd = 1.0f / sqrtf(q * (1.0f / 64.0f) + LN_EPS);
                    bf16* rp = ZV + (size_t)row * 512 + 64 * gi + 8 * fq;
#pragma unroll
                    for (int bj = 0; bj < 2; ++bj) *(u32x4*)(rp + 32 * bj) = pack8(z[bj][0] * rstd * gg[bj][0] + bb[bj][0], z[bj][1] * rstd * gg[bj][1] + bb[bj][1]); asm volatile("" ::: "memory"); }
        }
    }
};
}

#define XB_TMO      128
#define XB_XCNT(j)  (256  + 64 * (j))
#define XB_XSUB(j)  (1280 + 64 * (j))
#define XB_XGEN(j)  (2304 + 64 * (j))
#define XB_TOP      3328
#define XB_TOPGEN   3392
#define XCD_BAR_WORDS 3456
#define XB_SPIN_CAP (1u << 22)
DI unsigned xb_ld(unsigned* p)              { return __hip_atomic_load(p, __ATOMIC_RELAXED, __HIP_MEMORY_SCOPE_AGENT); }
DI unsigned xb_add(unsigned* p, unsigned v) { return __hip_atomic_fetch_add(p, v, __ATOMIC_RELAXED, __HIP_MEMORY_SCOPE_AGENT); }
DI unsigned xb_xcc_id() { return (unsigned)__builtin_amdgcn_s_getreg((3 << 11) | 20) & 0xFu; }
#define XB_SPIN(cond, bar) do { unsigned _sp = 0; while (cond) { __builtin_amdgcn_s_sleep(1); \
    if ((++_sp & 255u) == 0u) { if (xb_ld(&(bar)[XB_TMO])) break; if (_sp > XB_SPIN_CAP) { atomicAdd(&(bar)[XB_TMO], 1u); break; } } } } while (0)
struct XcdBarrier { GASP unsigned* bar; unsigned x; volatile LAS unsigned* st; };
DI XcdBarrier xcd_barrier_post(GASP unsigned* bar, volatile LAS unsigned* st, bool leader) {
    XcdBarrier b; b.bar = bar; b.x = xb_xcc_id(); b.st = st;
    if (leader) (void)xb_add((unsigned*)&bar[XB_XCNT(b.x)], 1u);
    return b;
}
DI void xcd_barrier_complete(unsigned* bar, unsigned x, unsigned& nloc, unsigned& nx) {
    const unsigned G = gridDim.x * gridDim.y * gridDim.z;
    unsigned sum, cnt, mine, sp = 0u;
    for (;;) {
        sum = 0u; cnt = 0u; mine = 0u;
#pragma unroll
        for (unsigned j = 0; j < 16; ++j) { const unsigned c = xb_ld(&bar[XB_XCNT(j)]); sum += c; cnt += (c > 0u) ? 1u : 0u; mine = (j == x) ? c : mine; }
        if (sum == G) break;
        __builtin_amdgcn_s_sleep(1);
        if ((++sp & 255u) == 0u) { if (xb_ld(&bar[XB_TMO])) break; if (sp > XB_SPIN_CAP) { atomicAdd(&bar[XB_TMO], 1u); break; } }
    }
    nloc = mine > 0u ? mine : 1u; nx = cnt > 0u ? cnt : 1u;
}
DI void xcd_barrier(const XcdBarrier& b, int wave) {
    asm volatile("s_waitcnt vmcnt(0)" ::: "memory");
    __syncthreads();
    if (wave == 0 && lane_id() == 0) {
        GASP unsigned* barg = b.bar; unsigned bx = b.x; asm volatile("" : "+s"(barg), "+s"(bx)); unsigned* bar = (unsigned*)barg;
        __builtin_amdgcn_s_waitcnt(0);
        unsigned nloc = b.st[0], nx = b.st[1];
        if (nloc == 0u) { xcd_barrier_complete(bar, bx, nloc, nx); b.st[0] = nloc; b.st[1] = nx; }
        const unsigned old = xb_add(&bar[XB_XSUB(bx)], 1u);
        const unsigned gen = old / nloc;
        if (old + 1u == (gen + 1u) * nloc) {
            __builtin_amdgcn_fence(__ATOMIC_RELEASE, "agent");
            asm volatile("s_waitcnt vmcnt(0)" ::: "memory");
            const unsigned og = xb_add(&bar[XB_TOP], 1u);
            const unsigned tg = og / nx;
            if (og + 1u == (tg + 1u) * nx) xb_add(&bar[XB_TOPGEN], 1u);
            else XB_SPIN(xb_ld(&bar[XB_TOPGEN]) == tg, bar);
            __builtin_amdgcn_fence(__ATOMIC_ACQUIRE, "agent");
            xb_add(&bar[XB_XGEN(bx)], 1u);
            asm volatile("s_waitcnt vmcnt(0)" ::: "memory");
        } else {
            XB_SPIN(xb_ld(&bar[XB_XGEN(bx)]) == gen, bar);
            __builtin_amdgcn_fence(__ATOMIC_ACQUIRE, "agent");
            asm volatile("s_waitcnt vmcnt(0)" ::: "memory");
        }
    }
    __syncthreads();
}

struct Frame {
    LAS unsigned char* lds;
    volatile LAS unsigned* MISC;
    unsigned* ctl;
    int tid, lane, wave, G, bid;
    GASP unsigned char* ws;
    GASP float* out;
};
struct Args { const float* in[27]; float* out; unsigned char* ws; };
typedef const unsigned char __attribute__((address_space(4)))* kptr_t;
DI const float* in_ptr(int k) { kptr_t p = (kptr_t)__builtin_amdgcn_kernarg_segment_ptr(); asm volatile("" : "+s"(p)); return (const float*)(*(GASP const float* const __attribute__((address_space(4)))*)(p + 8 * k)); }
struct ArgsRef { struct Acc { DI const float* operator[](int k) const { return in_ptr(k); } } in; };

template <int MAP>
DI int conv_col(int nb2, int lane, bool& second) {
    second = false;
    if (MAP == 0) return 64 * nb2 + lane;
    const int pn = nb2 >> 2, bj = (nb2 >> 1) & 1, wcp = nb2 & 1;
    if (MAP == 2) { second = bj != 0; return 128 * pn + 64 * wcp + lane; }
    return 256 * pn + 128 * wcp + 32 * bj + 64 * (lane >> 5) + (lane & 31);
}
template <int MAP>
DI void conv_job(Frame& F, const float* s1, const float* s2, bf16* dst, int K, int ldw, int nblk64, int nexp) {
    const int gw = F.bid * NWAVES + F.wave, NGW = F.G * NWAVES, lane = F.lane;
    const int per = (K / 64) * nblk64, total = per * nexp;
    for (int it = gw; it < total; it += NGW) {
        const int e = it / per, r = it - e * per, kb = r / nblk64, nb2 = r - kb * nblk64;
        bool second; const int col = conv_col<MAP>(nb2, lane, second);
        const float* W = (second ? s2 : s1) + (size_t)e * K * ldw + (size_t)(64 * kb) * ldw + col;
        float v[64];
#pragma unroll
        for (int k = 0; k < 64; ++k) v[k] = W[(size_t)k * ldw];
        bf16* drow = dst + ((size_t)e * nblk64 * 64 + (size_t)nb2 * 64 + lane) * K + 64 * kb;
#pragma unroll
        for (int q = 0; q < 8; ++q) { u32x4 o; o.x = pk2(v[8 * q], v[8 * q + 1]); o.y = pk2(v[8 * q + 2], v[8 * q + 3]); o.z = pk2(v[8 * q + 4], v[8 * q + 5]); o.w = pk2(v[8 * q + 6], v[8 * q + 7]); *(u32x4*)(drow + 8 * q) = o; }
    }
}
template <int MAP>
DI void conv_job_i8(Frame& F, const float* s1, const float* s2, unsigned char* dst, float* swout, int ldw, int nblk64, int nexp) {
    constexpr int K = D, KW = K / NWAVES;
    LAS float* wmax = (LAS float*)(F.lds + 124 * 1024);
    LAS float* sinv = wmax + 512;
    const int lane = F.lane, w = F.wave;
    for (int it = F.bid; it < nblk64 * nexp; it += F.G) {
        const int e = it / nblk64, nb2 = it - e * nblk64;
        bool second; const int col = conv_col<MAP>(nb2, lane, second);
        const float* W = (second ? s2 : s1) + (size_t)e * K * ldw + (size_t)(KW * w) * ldw + col;
        float v[KW]; float mx = 0.f;
#pragma unroll
        for (int k = 0; k < KW; ++k) v[k] = W[(size_t)k * ldw];
#pragma unroll
        for (int k = 0; k < KW; ++k) mx = fmaxf(mx, fabsf(v[k]));
        wmax[w * 64 + lane] = mx;
        __syncthreads();
        if (w == 0) { float m = wmax[lane];
#pragma unroll
            for (int j = 1; j < 8; ++j) m = fmaxf(m, wmax[j * 64 + lane]);
            swout[(size_t)e * nblk64 * 64 + nb2 * 64 + lane] = m * (1.0f / 127.0f); sinv[lane] = m > 0.f ? 127.0f / m : 0.f; }
        __syncthreads();
        const float iv = sinv[lane];
        unsigned char* drow = dst + ((size_t)e * nblk64 * 64 + (size_t)nb2 * 64 + lane) * K + KW * w;
#pragma unroll
        for (int q = 0; q < KW / 16; ++q) { u32x4 o;
            o.x = pk4_i8(v[16 * q], v[16 * q + 1], v[16 * q + 2], v[16 * q + 3], iv); o.y = pk4_i8(v[16 * q + 4], v[16 * q + 5], v[16 * q + 6], v[16 * q + 7], iv);
            o.z = pk4_i8(v[16 * q + 8], v[16 * q + 9], v[16 * q + 10], v[16 * q + 11], iv); o.w = pk4_i8(v[16 * q + 12], v[16 * q + 13], v[16 * q + 14], v[16 * q + 15], iv);
            *(u32x4*)(drow + 16 * q) = o; }
        __syncthreads();
    }
}
DI void conv_layer(Frame& F, const ArgsRef& a, int L) {
    FRESH(F);
    bf16* Wb = (bf16*)(F.ws + WS_W);
    const int i = L >> 1;
    if ((L & 1) == 0) {
        conv_job<1>(F, a.in[3] + (size_t)i * D * INW, nullptr, (bf16*)((char*)Wb + W_IN), D, INW, INW / 64, 1);
        conv_job<0>(F, a.in[9] + (size_t)i * D * D, nullptr, (bf16*)((char*)Wb + W_OUT), D, D, D / 64, 1);
        conv_job_i8<2>(F, a.in[10] + (size_t)i * D * FF, a.in[11] + (size_t)i * D * FF, (unsigned char*)Wb + W_GU, (float*)(F.ws + WS_SW), FF, 2 * FF / 64, 1);
        conv_job<0>(F, a.in[12] + (size_t)i * FF * D, nullptr, (bf16*)((char*)Wb + W_DN), FF, D, D / 64, 1);
        const float* sw = a.in[5] + (size_t)i * 8 * 128 * 128; bf16* dw = (bf16*)(F.ws + WS_SGUW);
        for (int idx = F.bid * 512 + F.tid; idx < 8 * 128 * 128 / 4; idx += F.G * 512) { const f32x4 v = *(const f32x4*)(sw + 4 * idx); u32x2 o; o.x = pk2(v[0], v[1]); o.y = pk2(v[2], v[3]); *(u32x2*)(dw + 4 * idx) = o; }
    } else {
        conv_job<2>(F, a.in[21] + (size_t)i * D * D, a.in[22] + (size_t)i * D * D, (bf16*)((char*)Wb + W_GLU), D, D, 2 * D / 64, 1);
        conv_job_i8<2>(F, a.in[24] + (size_t)i * NE * D * FF, a.in[25] + (size_t)i * NE * D * FF, (unsigned char*)Wb + W_MGU, (float*)(F.ws + WS_SW), FF, 2 * FF / 64, NE);
        conv_job<0>(F, a.in[26] + (size_t)i * NE * FF * D, nullptr, (bf16*)((char*)Wb + W_MDN), FF, D, D / 64, NE);
    }
}

DI void prologue(Frame& F, const ArgsRef& a) {
    FRESH(F);
    const float* x = a.in[0]; bf16* XB = (bf16*)(F.ws + WS_XB);
    const size_t nthr = (size_t)F.G * 512, t0 = (size_t)F.bid * 512 + F.tid;
    for (size_t i = t0; i < (size_t)T * D / 8; i += nthr) { const f32x4 v0 = *(const f32x4*)(x + 8 * i), v1 = *(const f32x4*)(x + 8 * i + 4); *(u32x4*)(XB + 8 * i) = pg8::pack8(v0, v1); }
    float* cosT = (float*)(F.ws + WS_ROPE); float* sinT = cosT + SEQ * 32;
    for (size_t i = t0; i < (size_t)SEQ * 32; i += nthr) { const int pos = (int)(i >> 5), d = (int)(i & 31);
        const float invf = (float)exp_d(-(double)(2 * d) * (9.2103403719761836 / 64.0));
        const float ang = (float)pos * invf; double s, c; sincos_d((double)ang, s, c); cosT[i] = (float)c; sinT[i] = (float)s; }
}

DI void ln_core(f32x4 (&v)[4], const f32x4 (&g)[4], const f32x4 (&b)[4]) {
    float s = 0.f;
#pragma unroll
    for (int j = 0; j < 4; ++j) s += (v[j][0] + v[j][1]) + (v[j][2] + v[j][3]);
    const float mean = wave_sum(s) * (1.0f / D); float q = 0.f;
#pragma unroll
    for (int j = 0; j < 4; ++j) { v[j] = v[j] - mean; q += (v[j][0] * v[j][0] + v[j][1] * v[j][1]) + (v[j][2] * v[j][2] + v[j][3] * v[j][3]); }
    const float rstd = 1.0f / sqrtf(wave_sum(q) * (1.0f / D) + LN_EPS);
#pragma unroll
    for (int j = 0; j < 4; ++j) v[j] = v[j] * rstd * g[j] + b[j];
}
DI void ln_store(const f32x4 (&v)[4], bf16* XB, size_t row, int lane) {
#pragma unroll
    for (int j = 0; j < 4; ++j) { u32x2 o; o.x = pk2(v[j][0], v[j][1]); o.y = pk2(v[j][2], v[j][3]); *(u32x2*)(XB + row * D + 4 * lane + 256 * j) = o; }
}
DI void ln_load(f32x4 (&v)[4], const bf16* Y, size_t row, int lane) {
#pragma unroll
    for (int j = 0; j < 4; ++j) { const u32x2 yv = *(const u32x2*)(Y + row * D + 4 * lane + 256 * j); v[j] = (f32x4){bf_lo(yv.x), bf_hi(yv.x), bf_lo(yv.y), bf_hi(yv.y)}; }
}
DI void ln_pass_plain(Frame& F, const float* g_, const float* b_, const bool q8copy) {
    FRESH(F);
    const bf16* Y = (const bf16*)(F.ws + WS_Y); bf16* XB = (bf16*)(F.ws + WS_XB);
    f32x4 g[4], b[4];
#pragma unroll
    for (int j = 0; j < 4; ++j) { g[j] = *(const f32x4*)(g_ + 4 * F.lane + 256 * j); b[j] = *(const f32x4*)(b_ + 4 * F.lane + 256 * j); }
    const int gw = F.bid * NWAVES + F.wave, NGW = F.G * NWAVES;
    for (int row = gw; row < T; row += NGW) {
        f32x4 v[4]; ln_load(v, Y, (size_t)row, F.lane);
        ln_core(v, g, b);
        ln_store(v, XB, (size_t)row, F.lane);
        if (q8copy) {
            float mx = 0.f;
#pragma unroll
            for (int j = 0; j < 4; ++j) mx = fmaxf(mx, fmaxf(fmaxf(fabsf(v[j][0]), fabsf(v[j][1])), fmaxf(fabsf(v[j][2]), fabsf(v[j][3]))));
            mx = wave_max(mx);
            const float inv = mx > 0.f ? 127.0f / mx : 0.f;
            unsigned char* X8 = (unsigned char*)(F.ws + WS_XB8);
#pragma unroll
            for (int j = 0; j < 4; ++j) *(unsigned*)(X8 + (size_t)row * D + 4 * F.lane + 256 * j) = pk4_i8(v[j][0], v[j][1], v[j][2], v[j][3], inv);
            if (F.lane == 0) ((float*)(F.ws + WS_SX))[row] = mx * (1.0f / 127.0f);
        }
    }
}
DI void ln_pass_router(Frame& F, const float* g_, const float* b_, const float* rw_, unsigned* cnt, const size_t rec_off) {
    FRESH(F);
    const bf16* Y = (const bf16*)(F.ws + WS_Y); bf16* XB = (bf16*)(F.ws + WS_XB);
    i32x4* RECI = (i32x4*)(F.ws + WS_RECI + rec_off); f32x2* RECW = (f32x2*)(F.ws + WS_RECW + rec_off);
    LAS int* lcnt = (LAS int*)(F.lds); LAS int* lbase = lcnt + 8;
    LAS int* re0 = lcnt + 64; LAS int* re1 = re0 + 256; LAS int* rp0 = re1 + 256; LAS int* rp1 = rp0 + 256; LAS float* rw0 = (LAS float*)(rp1 + 256); LAS float* rw1 = rw0 + 256;
    f32x4 g[4], b[4];
#pragma unroll
    for (int j = 0; j < 4; ++j) { g[j] = *(const f32x4*)(g_ + 4 * F.lane + 256 * j); b[j] = *(const f32x4*)(b_ + 4 * F.lane + 256 * j); }
    f32x4 rwa[4][4], rwb[4][4];
#pragma unroll
    for (int j = 0; j < 4; ++j)
#pragma unroll
        for (int c = 0; c < 4; ++c) { const float* p = rw_ + (size_t)(4 * F.lane + 256 * j + c) * 8; rwa[j][c] = *(const f32x4*)p; rwb[j][c] = *(const f32x4*)(p + 4); }
    for (int pnl = F.bid; pnl < T / 256; pnl += F.G) {
        if (F.tid < 8) lcnt[F.tid] = 0;
        __syncthreads();
        for (int rr = 0; rr < 32; ++rr) {
            const int lr = F.wave + 8 * rr; const size_t row = (size_t)pnl * 256 + lr;
            f32x4 v[4]; ln_load(v, Y, row, F.lane);
            ln_core(v, g, b);
            ln_store(v, XB, row, F.lane);
            f32x4 la = {0.f, 0.f, 0.f, 0.f}, lb = {0.f, 0.f, 0.f, 0.f};
#pragma unroll
            for (int j = 0; j < 4; ++j)
#pragma unroll
                for (int c = 0; c < 4; ++c) { la += rwa[j][c] * v[j][c]; lb += rwb[j][c] * v[j][c]; }
            float lg[8];
#pragma unroll
            for (int e = 0; e < 4; ++e) { lg[e] = wave_sum(la[e]); lg[4 + e] = wave_sum(lb[e]); }
            int i0 = 0; float l0 = lg[0];
#pragma unroll
            for (int e = 1; e < 8; ++e) if (lg[e] > l0) { l0 = lg[e]; i0 = e; }
            int i1 = -1; float l1 = -3.0e38f;
#pragma unroll
            for (int e = 0; e < 8; ++e) if (e != i0 && lg[e] > l1) { l1 = lg[e]; i1 = e; }
            const float w0 = 1.0f / (1.0f + __expf(l1 - l0)), w1 = 1.0f - w0;
            if (F.lane == 0) { const int p0 = atomicAdd((int*)(lcnt + i0), 1), p1 = atomicAdd((int*)(lcnt + i1), 1);
                re0[lr] = i0; re1[lr] = i1; rp0[lr] = p0; rp1[lr] = p1; rw0[lr] = w0; rw1[lr] = w1; }
        }
        __syncthreads();
        if (F.tid < 8) lbase[F.tid] = (int)xb_add(cnt + F.tid, (unsigned)lcnt[F.tid]);
        __syncthreads();
        if (F.tid < 256) { const int e0 = re0[F.tid], e1 = re1[F.tid]; const size_t row = (size_t)pnl * 256 + F.tid;
            RECI[row] = (i32x4){e0, lbase[e0] + rp0[F.tid], e1, lbase[e1] + rp1[F.tid]}; RECW[row] = (f32x2){rw0[F.tid], rw1[F.tid]}; }
        __syncthreads();
    }
}
DI void moe_tiles(const unsigned* cnt, int (&tb)[9], int (&cn)[8]) {
    int acc = 0;
#pragma unroll
    for (int e = 0; e < 8; ++e) { cn[e] = __builtin_amdgcn_readfirstlane((int)__hip_atomic_load(cnt + e, __ATOMIC_RELAXED, __HIP_MEMORY_SCOPE_AGENT)); tb[e] = acc; acc += (cn[e] + 255) >> 8; }
    tb[8] = acc;
}
DI void moe_gather(Frame& F, const unsigned* cnt) {
    FRESH(F);
    int tb[9], cn[8]; moe_tiles(cnt, tb, cn);
    const bf16* XB = (const bf16*)(F.ws + WS_XB); unsigned char* XS = (unsigned char*)(F.ws + WS_XS); float* SXS = (float*)(F.ws + WS_SXS); const i32x4* RECI = (const i32x4*)(F.ws + WS_RECI);
    const int gw = F.bid * NWAVES + F.wave, NGW = F.G * NWAVES;
    for (int t = gw; t < T; t += NGW) {
        const i32x4 r = RECI[t];
        int b0 = 0, b1 = 0;
#pragma unroll
        for (int e = 0; e < 8; ++e) { b0 = (r[0] == e) ? tb[e] : b0; b1 = (r[2] == e) ? tb[e] : b1; }
        const size_t r0 = (size_t)b0 * 256 + r[1], r1 = (size_t)b1 * 256 + r[3];
        const u32x4 v0 = *(const u32x4*)(XB + (size_t)t * D + 8 * F.lane), v1 = *(const u32x4*)(XB + (size_t)t * D + 512 + 8 * F.lane);
        float f[16] = {bf_lo(v0.x), bf_hi(v0.x), bf_lo(v0.y), bf_hi(v0.y), bf_lo(v0.z), bf_hi(v0.z), bf_lo(v0.w), bf_hi(v0.w),
                       bf_lo(v1.x), bf_hi(v1.x), bf_lo(v1.y), bf_hi(v1.y), bf_lo(v1.z), bf_hi(v1.z), bf_lo(v1.w), bf_hi(v1.w)};
        float mx = 0.f;
#pragma unroll
        for (int k = 0; k < 16; ++k) mx = fmaxf(mx, fabsf(f[k]));
        mx = wave_max(mx);
        const float inv = mx > 0.f ? 127.0f / mx : 0.f, sc = mx * (1.0f / 127.0f);
        u32x2 q0, q1;
        q0.x = pk4_i8(f[0], f[1], f[2], f[3], inv); q0.y = pk4_i8(f[4], f[5], f[6], f[7], inv); q1.x = pk4_i8(f[8], f[9], f[10], f[11], inv); q1.y = pk4_i8(f[12], f[13], f[14], f[15], inv);
        *(u32x2*)(XS + r0 * D + 8 * F.lane) = q0; *(u32x2*)(XS + r0 * D + 512 + 8 * F.lane) = q1;
        *(u32x2*)(XS + r1 * D + 8 * F.lane) = q0; *(u32x2*)(XS + r1 * D + 512 + 8 * F.lane) = q1;
        if (F.lane == 0) { SXS[r0] = sc; SXS[r1] = sc; }
    }
#pragma unroll
    for (int e = 0; e < 8; ++e) { const int first = tb[e] * 256 + cn[e], last = tb[e + 1] * 256;
        for (int r = first + gw; r < last; r += NGW) { const u32x2 z = {0u, 0u}; *(u32x2*)(XS + (size_t)r * D + 8 * F.lane) = z; *(u32x2*)(XS + (size_t)r * D + 512 + 8 * F.lane) = z; if (F.lane == 0) SXS[r] = 0.f; } }
}
DI void ln_pass_combine(Frame& F, const float* g_, const float* b_, const unsigned* cnt, const bool final_, const bool dummy_) {
    FRESH(F);
    int tb[9], cn[8]; moe_tiles(cnt, tb, cn);
    const bf16* YS = (const bf16*)(F.ws + WS_YS); bf16* XB = (bf16*)(F.ws + WS_XB); float* X = (float*)F.out;
    const i32x4* RECI = (const i32x4*)(F.ws + WS_RECI); const f32x2* RECW = (const f32x2*)(F.ws + WS_RECW);
    f32x4 g[4], b[4];
#pragma unroll
    for (int j = 0; j < 4; ++j) { g[j] = *(const f32x4*)(g_ + 4 * F.lane + 256 * j); b[j] = *(const f32x4*)(b_ + 4 * F.lane + 256 * j); }
    const int gw = F.bid * NWAVES + F.wave, NGW = F.G * NWAVES;
    for (int row = gw; row < T; row += NGW) {
        const i32x4 r = RECI[row]; const f32x2 w = RECW[row];
        int b0 = 0, b1 = 0;
#pragma unroll
        for (int e = 0; e < 8; ++e) { b0 = (r[0] == e) ? tb[e] : b0; b1 = (r[2] == e) ? tb[e] : b1; }
        const size_t r0 = (size_t)b0 * 256 + r[1], r1 = (size_t)b1 * 256 + r[3];
        f32x4 v[4];
#pragma unroll
        for (int j = 0; j < 4; ++j) { const u32x2 xv = *(const u32x2*)(XB + (size_t)row * D + 4 * F.lane + 256 * j);
            const u32x2 ya = *(const u32x2*)(YS + r0 * D + 4 * F.lane + 256 * j), yb = *(const u32x2*)(YS + r1 * D + 4 * F.lane + 256 * j);
            v[j][0] = ALPHA * bf_lo(xv.x) + (w[0] * bf_lo(ya.x) + w[1] * bf_lo(yb.x)); v[j][1] = ALPHA * bf_hi(xv.x) + (w[0] * bf_hi(ya.x) + w[1] * bf_hi(yb.x));
            v[j][2] = ALPHA * bf_lo(xv.y) + (w[0] * bf_lo(ya.y) + w[1] * bf_lo(yb.y)); v[j][3] = ALPHA * bf_hi(xv.y) + (w[0] * bf_hi(ya.y) + w[1] * bf_hi(yb.y)); }
        ln_core(v, g, b);
        if (dummy_) ln_store(v, (bf16*)(F.ws + WS_XS), (size_t)row, F.lane);
        else if (final_) {
#pragma unroll
            for (int j = 0; j < 4; ++j) *(f32x4*)(X + (size_t)row * D + 4 * F.lane + 256 * j) = v[j];
        } else ln_store(v, XB, (size_t)row, F.lane);
    }
}

constexpr int KL_STRIDE = 144, VT_STRIDE = 776, VT_OFF = 384 * KL_STRIDE;
DI void attn_phase(Frame& F, const float* sink) {
    FRESH(F);
    const bf16* Q = (const bf16*)(F.ws + WS_Q); const bf16* Kb = (const bf16*)(F.ws + WS_K); const bf16* Vb = (const bf16*)(F.ws + WS_V); bf16* MIX = (bf16*)(F.ws + WS_MIX);
    LAS unsigned char* Kl = F.lds; LAS unsigned char* Vt = F.lds + VT_OFF;
    const int lane = F.lane, l31 = lane & 31, h = lane >> 5, w = F.wave;
    for (int unit = F.bid; unit < BATCH * 2 * 16; unit += F.G) {
        const int b = unit >> 5, kvh = (unit >> 4) & 1, n = unit & 15;
        __syncthreads();
        for (int idx = F.tid; idx < 384 * 8; idx += 512) {
            const int key = idx >> 3, ch = idx & 7, kp = (n - 1) * 128 + key;
            u32x4 kv = {0u, 0u, 0u, 0u}, vv = {0u, 0u, 0u, 0u};
            if (kp >= 0 && kp < SEQ) { const size_t off = (size_t)(b * SEQ + kp) * 128 + kvh * 64 + ch * 8; kv = *(const u32x4*)(Kb + off); vv = *(const u32x4*)(Vb + off); }
            *(LAS u32x4*)(Kl + key * KL_STRIDE + ch * 16) = kv;
            LAS unsigned short* vd = (LAS unsigned short*)(Vt + (ch * 8) * VT_STRIDE + key * 2);
            constexpr int RS = VT_STRIDE / 2;
            vd[0 * RS] = (unsigned short)(vv.x & 0xffffu); vd[1 * RS] = (unsigned short)(vv.x >> 16); vd[2 * RS] = (unsigned short)(vv.y & 0xffffu); vd[3 * RS] = (unsigned short)(vv.y >> 16);
            vd[4 * RS] = (unsigned short)(vv.z & 0xffffu); vd[5 * RS] = (unsigned short)(vv.z >> 16); vd[6 * RS] = (unsigned short)(vv.w & 0xffffu); vd[7 * RS] = (unsigned short)(vv.w >> 16);
        }
        __syncthreads();
        const int hq = kvh * 4 + (w >> 1);
        const float m0 = sink[hq] * LOG2E;
        for (int qb = 0; qb < 2; ++qb) {
            const int q0 = 64 * (w & 1) + 32 * qb;
            const size_t qrow = (size_t)(b * SEQ + n * 128 + q0 + l31);
            bf16x8 bq[4];
#pragma unroll
            for (int ks = 0; ks < 4; ++ks) bq[ks] = *(const bf16x8*)(Q + qrow * 512 + hq * 64 + 16 * ks + 8 * h);
            float m2 = m0, l = 1.0f;
            f32x16 O0, O1;
#pragma unroll
            for (int i = 0; i < 16; ++i) { O0[i] = 0.f; O1[i] = 0.f; }
            const int kt0 = q0 >> 5, qk = q0 + l31; const bool edge = (n == 0) || (n == 15);
            for (int kt = kt0; kt <= kt0 + 8; ++kt) {
                f32x16 X;
#pragma unroll
                for (int i = 0; i < 16; ++i) X[i] = 0.f;
#pragma unroll
                for (int ks = 0; ks < 4; ++ks) { const bf16x8 a = *(const LAS bf16x8*)(Kl + (32 * kt + l31) * KL_STRIDE + (16 * ks + 8 * h) * 2); X = MFMA32(a, bq[ks], X); }
                float mx = -1.0e30f;
                if (kt == kt0 || kt == kt0 + 8 || edge) {
#pragma unroll
                    for (int i = 0; i < 16; ++i) { const int kk = 32 * kt + crow(i, h); const int kp = (n - 1) * 128 + kk;
                        const bool valid = (kk >= qk) && (kk <= qk + 256) && (kp >= 0) && (kp < SEQ);
                        X[i] = valid ? X[i] : -1.0e30f; mx = fmaxf(mx, X[i]); }
                } else {
#pragma unroll
                    for (int i = 0; i < 16; ++i) mx = fmaxf(mx, X[i]);
                }
                mx = max_x32(mx);
                const float mn = fmaxf(m2, mx), alpha = fast_exp2(m2 - mn); m2 = mn;
                float ps = 0.f;
#pragma unroll
                for (int i = 0; i < 16; ++i) { X[i] = fast_exp2(X[i] - mn); ps += X[i]; }
                ps = sum_x32(ps);
                l = l * alpha + ps;
#pragma unroll
                for (int i = 0; i < 16; ++i) { O0[i] *= alpha; O1[i] *= alpha; }
#pragma unroll
                for (int s = 0; s < 2; ++s) {
                    u32x4 pw; pw.x = pk2(X[8 * s + 0], X[8 * s + 1]); pw.y = pk2(X[8 * s + 2], X[8 * s + 3]); pw.z = pk2(X[8 * s + 4], X[8 * s + 5]); pw.w = pk2(X[8 * s + 6], X[8 * s + 7]);
                    const bf16x8 pf = __builtin_bit_cast(bf16x8, pw);
                    const int kb = (32 * kt + 16 * s + 4 * h) * 2;
                    { const s16x4 lo = *(const LAS s16x4*)(Vt + l31 * VT_STRIDE + kb), hi = *(const LAS s16x4*)(Vt + l31 * VT_STRIDE + kb + 16);
                      O0 = MFMA32(__builtin_shufflevector(lo, hi, 0, 1, 2, 3, 4, 5, 6, 7), pf, O0); }
                    { const s16x4 lo = *(const LAS s16x4*)(Vt + (32 + l31) * VT_STRIDE + kb), hi = *(const LAS s16x4*)(Vt + (32 + l31) * VT_STRIDE + kb + 16);
                      O1 = MFMA32(__builtin_shufflevector(lo, hi, 0, 1, 2, 3, 4, 5, 6, 7), pf, O1); }
                }
            }
            const float inv = 1.0f / l;
            bf16* orow = MIX + qrow * D + hq * 64;
#pragma unroll
            for (int g4 = 0; g4 < 4; ++g4) {
                u32x2 o; o.x = pk2(O0[4 * g4] * inv, O0[4 * g4 + 1] * inv); o.y = pk2(O0[4 * g4 + 2] * inv, O0[4 * g4 + 3] * inv); *(u32x2*)(orow + 8 * g4 + 4 * h) = o;
                u32x2 p; p.x = pk2(O1[4 * g4] * inv, O1[4 * g4 + 1] * inv); p.y = pk2(O1[4 * g4 + 2] * inv, O1[4 * g4 + 3] * inv); *(u32x2*)(orow + 32 + 8 * g4 + 4 * h) = p;
            }
        }
    }
    __syncthreads();
}

constexpr int SG_STRIDE = 272;
DI void sgu_phase(Frame& F, const float* sgu_b) {
    FRESH(F);
    const bf16* ZU = (const bf16*)(F.ws + WS_ZU); const bf16* ZV = (const bf16*)(F.ws + WS_ZV); const bf16* Wsb = (const bf16*)(F.ws + WS_SGUW); bf16* MIX = (bf16*)(F.ws + WS_MIX);
    LAS unsigned char* VT = F.lds + F.wave * (32 * SG_STRIDE);
    const int lane = F.lane, l31 = lane & 31, h = lane >> 5;
    const int gw = F.bid * NWAVES + F.wave, NGW = F.G * NWAVES;
    for (int su = gw; su < BATCH * 16 * 8 * 2; su += NGW) {
        const int dh = su & 1, g = (su >> 1) & 7, n = (su >> 4) & 15, b = su >> 8;
        const size_t rowb = (size_t)(b * SEQ + n * 128);
#pragma unroll
        for (int i = 0; i < 8; ++i) { const int c = lane + 64 * i, q = c >> 2, ch = c & 3;
            const u32x4 vv = *(const u32x4*)(ZV + (rowb + q) * 512 + 64 * g + 32 * dh + 8 * ch);
            LAS unsigned short* vd = (LAS unsigned short*)(VT + (ch * 8) * SG_STRIDE + q * 2);
            constexpr int RS = SG_STRIDE / 2;
            vd[0 * RS] = (unsigned short)(vv.x & 0xffffu); vd[1 * RS] = (unsigned short)(vv.x >> 16); vd[2 * RS] = (unsigned short)(vv.y & 0xffffu); vd[3 * RS] = (unsigned short)(vv.y >> 16);
            vd[4 * RS] = (unsigned short)(vv.z & 0xffffu); vd[5 * RS] = (unsigned short)(vv.z >> 16); vd[6 * RS] = (unsigned short)(vv.w & 0xffffu); vd[7 * RS] = (unsigned short)(vv.w >> 16); }
        bf16x8 af[8];
#pragma unroll
        for (int ks = 0; ks < 8; ++ks) af[ks] = *(const LAS bf16x8*)(VT + l31 * SG_STRIDE + (16 * ks + 8 * h) * 2);
#pragma unroll
        for (int pt = 0; pt < 4; ++pt) {
            const int p = 32 * pt + l31;
            f32x16 acc;
#pragma unroll
            for (int i = 0; i < 16; ++i) acc[i] = 0.f;
#pragma unroll
            for (int ks = 0; ks < 8; ++ks) { const bf16x8 bw = *(const bf16x8*)(Wsb + ((size_t)g * 128 + p) * 128 + 16 * ks + 8 * h); acc = MFMA32(af[ks], bw, acc); }
            const float bias = sgu_b[g * 128 + p];
            const size_t row = rowb + p;
#pragma unroll
            for (int g4 = 0; g4 < 4; ++g4) { const int d = 32 * dh + 8 * g4 + 4 * h;
                const u32x2 uu = *(const u32x2*)(ZU + row * 512 + 64 * g + d);
                u32x2 o; o.x = pk2(bf_lo(uu.x) * (acc[4 * g4] + bias), bf_hi(uu.x) * (acc[4 * g4 + 1] + bias)); o.y = pk2(bf_lo(uu.y) * (acc[4 * g4 + 2] + bias), bf_hi(uu.y) * (acc[4 * g4 + 3] + bias));
                *(u32x2*)(MIX + row * D + 512 + 64 * g + d) = o; }
        }
        LDS_WAIT();
    }
}

constexpr int S5_STRIDE = 272;
DI void sincos_f(float th, float& s, float& c) {
    const float tq = th * 0.636619772367581f, q = rintf(tq), f = (tq - q) * 1.5707963267948966f, f2 = f * f;
    const float sp = f * (1.0f + f2 * (-1.6666667e-1f + f2 * (8.3333333e-3f + f2 * (-1.9841270e-4f + f2 * 2.7557319e-6f))));
    const float cp = 1.0f + f2 * (-0.5f + f2 * (4.1666667e-2f + f2 * (-1.3888889e-3f + f2 * (2.4801587e-5f + f2 * (-2.7557319e-7f)))));
    const int qi = ((int)q) & 3;
    s = (qi == 0) ? sp : (qi == 1) ? cp : (qi == 2) ? -sp : -cp;
    c = (qi == 0) ? cp : (qi == 1) ? -sp : (qi == 2) ? -cp : sp;
}
DI void zoh_params(float lr, float li, float logdt, float& br, float& bi, float& cr, float& ci) {
    const float dt = expf(logdt);
    const float ea = expf(lr * dt);
    float sn, cs; sincos_f(li * dt, sn, cs);
    br = ea * cs; bi = ea * sn;
    const float nr = br - 1.0f, rden = 1.0f / (lr * lr + li * li);
    cr = (nr * lr + bi * li) * rden; ci = (bi * lr - nr * li) * rden;
}
DI void s5_phase(Frame& F, const ArgsRef& a, int i) {
    FRESH(F);
    const bf16* XB = (const bf16*)(F.ws + WS_XB); bf16* YF = (bf16*)(F.ws + WS_YF);     bf16* YG = (bf16*)(F.ws + WS_YG);
    LAS unsigned char* xs = F.lds + F.wave * (32 * S5_STRIDE);
    const int lane = F.lane, l31 = lane & 31, h = lane >> 5, l15 = lane & 15, q4 = lane >> 4;
    const int gw = F.bid * NWAVES + F.wave, NGW = F.G * NWAVES;
    const bool fwdrow = (l31 & 4) == 0; const int slot = (l31 & 3) + 4 * (l31 >> 3);
    for (int unit = gw; unit < BATCH * 64; unit += NGW) {
        const int b = unit >> 6, g = unit & 63;
        const f32x4 dsk = *(const f32x4*)(a.in[20] + ((size_t)i * 64 + g) * 16 + 4 * q4);
        bf16x8 bfr[2][2][2]; float lbr[2], lbi[2];
#pragma unroll
        for (int dir = 0; dir < 2; ++dir) { const size_t pg = ((size_t)(i * 2 + dir) * 64 + g); const float logdt = a.in[15][pg];
#pragma unroll
            for (int ph = 0; ph < 2; ++ph) { const int pp = 32 * ph + l31; float tbr, tbi, tcr, tci;
                zoh_params(a.in[13][pg * 64 + pp], a.in[14][pg * 64 + pp], logdt, tbr, tbi, tcr, tci);
                if (dir == 0) { lbr[ph] = tbr; lbi[ph] = tbi; } else { lbr[ph] = h ? tbr : lbr[ph]; lbi[ph] = h ? tbi : lbi[ph]; }
                const float* brp = a.in[16] + (pg * 64 + pp) * 16 + 8 * h; const float* bip = a.in[17] + (pg * 64 + pp) * 16 + 8 * h;
                const f32x4 r0 = *(const f32x4*)brp, r1 = *(const f32x4*)(brp + 4), m0 = *(const f32x4*)bip, m1 = *(const f32x4*)(bip + 4);
                bfr[dir][ph][0] = __builtin_bit_cast(bf16x8, pg8::pack8(r0 * tcr - m0 * tci, r1 * tcr - m1 * tci));
                bfr[dir][ph][1] = __builtin_bit_cast(bf16x8, pg8::pack8(m0 * tcr + r0 * tci, m1 * tcr + r1 * tci)); } }
        bf16x8 cf[2][4];
#pragma unroll
        for (int dir = 0; dir < 2; ++dir) { const size_t pg = ((size_t)(i * 2 + dir) * 64 + g);
#pragma unroll
            for (int ks = 0; ks < 4; ++ks) { const size_t co = (pg * 16 + l15) * 64 + 16 * ks + 4 * q4;
                const f32x4 cre = *(const f32x4*)(a.in[18] + co), cim = *(const f32x4*)(a.in[19] + co);
                u32x4 wv; wv.x = pk2(cre[0], -cim[0]); wv.y = pk2(cre[1], -cim[1]); wv.z = pk2(cre[2], -cim[2]); wv.w = pk2(cre[3], -cim[3]);
                cf[dir][ks] = __builtin_bit_cast(bf16x8, wv); } }
        float xr[2] = {0.f, 0.f}, xi[2] = {0.f, 0.f};
        const size_t seq0 = (size_t)b * SEQ;
        bf16x8 au_n = *(const bf16x8*)(XB + (seq0 + (fwdrow ? slot : 16 * 127 + 15 - slot)) * D + 16 * g + 8 * h);
#pragma unroll 1
        for (int j = 0; j < 128; ++j) {
            const bf16x8 au = au_n;
            const size_t orow_f = seq0 + 16 * j + l15, orow_b = seq0 + 16 * (127 - j) + l15;
            const size_t oo_f = orow_f * D + 16 * g + 4 * q4, oo_b = orow_b * D + 16 * g + 4 * q4;
            u32x2 yfp[2], uup[2];
            if (j >= 64) { yfp[0] = *(const u32x2*)(YF + oo_f); yfp[1] = *(const u32x2*)(YF + oo_b); uup[0] = *(const u32x2*)(XB + oo_f); uup[1] = *(const u32x2*)(XB + oo_b); }
            else { yfp[0] = yfp[1] = (u32x2){0u, 0u}; uup[0] = uup[1] = (u32x2){0u, 0u}; }
            const bf16x8 zero8 = {0, 0, 0, 0, 0, 0, 0, 0};
            const bf16x8 a0 = fwdrow ? au : zero8, a1 = fwdrow ? zero8 : au;
            f32x16 z16;
#pragma unroll
            for (int k = 0; k < 16; ++k) z16[k] = 0.f;
            f32x16 P[2][2];
#pragma unroll
            for (int ph = 0; ph < 2; ++ph)
#pragma unroll
                for (int ri = 0; ri < 2; ++ri) { P[ph][ri] = MFMA32(a0, bfr[0][ph][ri], z16); P[ph][ri] = MFMA32(a1, bfr[1][ph][ri], P[ph][ri]); }
            __builtin_amdgcn_sched_barrier(0);
            { const int jn = (j < 127) ? j + 1 : j;
              au_n = *(const bf16x8*)(XB + (seq0 + (fwdrow ? 16 * jn + slot : 16 * (127 - jn) + 15 - slot)) * D + 16 * g + 8 * h); }
#pragma unroll
            for (int t = 0; t < 16; ++t) {
#pragma unroll
                for (int ph = 0; ph < 2; ++ph) {
                    const float t1 = __builtin_fmaf(-lbi[ph], xi[ph], P[ph][0][t]), t2 = __builtin_fmaf(lbi[ph], xr[ph], P[ph][1][t]);
                    xr[ph] = __builtin_fmaf(lbr[ph], xr[ph], t1); xi[ph] = __builtin_fmaf(lbr[ph], xi[ph], t2);
                    asm volatile("" : "+v"(xr[ph]), "+v"(xi[ph]));
                    *(LAS unsigned*)(xs + (16 * h + t) * S5_STRIDE + 4 * (32 * ph + l31)) = pk2(xr[ph], xi[ph]);
                }
            }
            f32x4 y4[2];
#pragma unroll
            for (int dd = 0; dd < 2; ++dd) {
                y4[dd] = (f32x4){0.f, 0.f, 0.f, 0.f};
                const int srow = dd ? 16 + (15 - l15) : l15;
#pragma unroll
                for (int ks = 0; ks < 4; ++ks) { const bf16x8 bx = *(const LAS bf16x8*)(xs + srow * S5_STRIDE + (32 * ks + 8 * q4) * 2); y4[dd] = MFMA16(cf[dd][ks], bx, y4[dd]); }
            }
            if (j < 64) { u32x2 p0, p1; p0.x = pk2(y4[0][0], y4[0][1]); p0.y = pk2(y4[0][2], y4[0][3]); p1.x = pk2(y4[1][0], y4[1][1]); p1.y = pk2(y4[1][2], y4[1][3]); *(u32x2*)(YF + oo_f) = p0; *(u32x2*)(YF + oo_b) = p1; }
            else {
#pragma unroll
                for (int dd = 0; dd < 2; ++dd) { const u32x2 uu = uup[dd];
                    const f32x4 uv = {bf_lo(uu.x), bf_hi(uu.x), bf_lo(uu.y), bf_hi(uu.y)};
                    const f32x4 yp = {bf_lo(yfp[dd].x), bf_hi(yfp[dd].x), bf_lo(yfp[dd].y), bf_hi(yfp[dd].y)};
                    const f32x4 y = yp + y4[dd] + dsk * uv;
                    u32x2 ov; ov.x = pk2(gelu_tanh(y[0]), gelu_tanh(y[1])); ov.y = pk2(gelu_tanh(y[2]), gelu_tanh(y[3])); *(u32x2*)(YG + (dd ? oo_b : oo_f)) = ov; }
            }
            { u32x4 t_ = __builtin_bit_cast(u32x4, au_n); asm volatile("" : "+v"(t_.x), "+v"(t_.y), "+v"(t_.z), "+v"(t_.w)); au_n = __builtin_bit_cast(bf16x8, t_); }
            LDS_WAIT();
        }
    }
}

__global__ void __launch_bounds__(NWAVES * 64, 2) fwd_kernel(Args args_by_value) {
    extern __shared__ __attribute__((aligned(16))) unsigned char lds[];
    Frame F;
    F.lds = (LAS unsigned char*)lds;
    F.MISC = (volatile LAS unsigned*)(F.lds + MISC_OFF);
    F.tid = threadIdx.x; F.lane = F.tid & 63; F.wave = __builtin_amdgcn_readfirstlane(F.tid >> 6);
    F.G = gridDim.x; F.bid = blockIdx.x;
    { kptr_t kp = (kptr_t)__builtin_amdgcn_kernarg_segment_ptr(); F.out = *(GASP float* const __attribute__((address_space(4)))*)(kp + 8 * 27); F.ws = *(GASP unsigned char* const __attribute__((address_space(4)))*)(kp + 8 * 28); }
    F.ctl = (unsigned*)(F.ws + WS_CTL);
    const ArgsRef args{};
    for (int u = F.tid; u < (LDS_BYTES - LDSCTL_OFF) / 4; u += NWAVES * 64) ((LAS unsigned*)(F.lds + LDSCTL_OFF))[u] = 0u;
    __syncthreads();
    XcdBarrier bar = xcd_barrier_post((GASP unsigned*)(F.ws + WS_CTL) + CW_BAR, F.MISC + 8, F.tid == 0);
#define GRID_BAR() xcd_barrier(bar, F.wave)
#define XB ((bf16*)(F.ws + WS_XB))
#define Yb ((bf16*)(F.ws + WS_Y))
#define Wb ((const char*)(F.ws + WS_W))
#define cosT ((const float*)(F.ws + WS_ROPE))
#define sinT ((const float*)(F.ws + WS_ROPE) + SEQ * 32)

    RPT(10) PH(0) prologue(F, args);
    RPT(4) PH(1) conv_layer(F, args, 0);
    GRID_BAR();

#pragma unroll 1
    for (int lp = 0; lp < 2; ++lp) {
        {
            const int L = 2 * lp, i = lp;
            { UFRESH(F); pg8::Order S{}; S.nM = T / 256; S.nN = INW / 256; S.nwg = S.nM * S.nN; S.G = F.G; S.c = F.bid; S.A = (const char*)XB; S.Bt = Wb + W_IN; S.tstep = (size_t)256 * D * 2; S.estride = 0;
              RPT(0) PH(2) { pg8::EpiWin E{(bf16*)(F.ws + WS_Q), (bf16*)(F.ws + WS_K), (bf16*)(F.ws + WS_V), (bf16*)(F.ws + WS_ZU), (bf16*)(F.ws + WS_ZV), cosT, sinT, args.in[7] + (size_t)i * 512, args.in[8] + (size_t)i * 512};
              pg8::gemm_phase(F.lds, D, S, E, F.wave); } }
            GRID_BAR();
            RPT(2) PH(3) attn_phase(F, args.in[4] + (size_t)i * 8);
            RPT(9) PH(4) sgu_phase(F, args.in[6] + (size_t)i * 8 * 128);
            GRID_BAR();
            { UFRESH(F); pg8::Order S{}; S.nM = T / 256; S.nN = D / 256; S.nwg = S.nM * S.nN; S.G = F.G; S.c = F.bid; S.A = (const char*)(F.ws + WS_MIX); S.Bt = Wb + W_OUT; S.tstep = (size_t)256 * D * 2; S.estride = 0;
              pg8::EpiPlain E{Yb, D, XB};
              RPT(0) PH(10) pg8::gemm_phase(F.lds, D, S, E, F.wave); }
            GRID_BAR();
            RPT(5) PH(5) ln_pass_plain(F, args.in[1] + (size_t)(L * 2 + 0) * D, args.in[2] + (size_t)(L * 2 + 0) * D, true);
            GRID_BAR();
            { UFRESH(F); pg8::Order S{}; S.nM = T / 256; S.nN = 2 * FF / 256; S.nwg = S.nM * S.nN; S.G = F.G; S.c = F.bid; S.A = (const char*)(F.ws + WS_XB8); S.Bt = Wb + W_GU; S.tstep = (size_t)256 * D; S.estride = 0;
              pg8::EpiPairI8 E{(bf16*)(F.ws + WS_H), FF, (const float*)(F.ws + WS_SX), (const float*)(F.ws + WS_SW)};
              RPT(0) PH(11) pg8::gemm_phase<pg8::EpiPairI8, true>(F.lds, D / 2, S, E, F.wave); }
            GRID_BAR();
            { UFRESH(F); pg8::Order S{}; S.nM = T / 256; S.nN = D / 256; S.nwg = S.nM * S.nN; S.G = F.G; S.c = F.bid; S.A = (const char*)(F.ws + WS_H); S.Bt = Wb + W_DN; S.tstep = (size_t)256 * FF * 2; S.estride = 0;
              pg8::EpiPlain E{Yb, D, XB};
              RPT(0) PH(10) pg8::gemm_phase(F.lds, FF, S, E, F.wave); }
            GRID_BAR();
            RPT(5) PH(5) ln_pass_plain(F, args.in[1] + (size_t)(L * 2 + 1) * D, args.in[2] + (size_t)(L * 2 + 1) * D, false);
            RPT(4) PH(1) conv_layer(F, args, L + 1);
            GRID_BAR();
        }
        {
            const int L = 2 * lp + 1, i = lp;
            unsigned* cnt = F.ctl + CW_CNT + 64 * i;
            RPT(3) PH(6) s5_phase(F, args, i);
            GRID_BAR();
            { UFRESH(F); pg8::Order S{}; S.nM = T / 256; S.nN = 2 * D / 256; S.nwg = S.nM * S.nN; S.G = F.G; S.c = F.bid; S.A = (const char*)(F.ws + WS_YG); S.Bt = Wb + W_GLU; S.tstep = (size_t)256 * D * 2; S.estride = 0;
              pg8::EpiPair<1> E{Yb, D, XB};
              RPT(0) PH(12) pg8::gemm_phase(F.lds, D, S, E, F.wave); }
            GRID_BAR();
            if ((RG >> 6) & 1) { PH(7) ln_pass_router(F, args.in[1] + (size_t)(L * 2 + 0) * D, args.in[2] + (size_t)(L * 2 + 0) * D, args.in[23] + (size_t)i * D * 8, cnt + 1024, WS_YS - WS_RECI); }
            PH(7) ln_pass_router(F, args.in[1] + (size_t)(L * 2 + 0) * D, args.in[2] + (size_t)(L * 2 + 0) * D, args.in[23] + (size_t)i * D * 8, cnt, 0);
            GRID_BAR();
            RPT(11) PH(8) moe_gather(F, cnt);
            GRID_BAR();
            {
                int tb[9], cn[8]; moe_tiles(cnt, tb, cn);
                const int ntt = tb[8], TC = 128, nch = (ntt + TC - 1) / TC;
RPT(1)
#pragma unroll 1
                for (int ch = 0; ch < nch; ++ch) {
                    const int t0 = ch * TC, t1 = (t0 + TC < ntt) ? t0 + TC : ntt, nM = (t1 > t0) ? t1 - t0 : 0;
                    { UFRESH(F); pg8::Order S{}; S.nM = nM; S.nN = 2 * FF / 256; S.nwg = S.nM * S.nN; S.G = F.G; S.c = F.bid; S.atile0 = t0; S.otile0 = 0; S.etile0 = t0;
                      S.A = (const char*)(F.ws + WS_XS); S.Bt = Wb + W_MGU; S.tstep = (size_t)256 * D; S.estride = (size_t)2 * FF * D;
#pragma unroll
                      for (int e = 0; e < 8; ++e) S.tb[e] = tb[e];
                      pg8::EpiPairI8 E{(bf16*)(F.ws + WS_HS), FF, (const float*)(F.ws + WS_SXS), (const float*)(F.ws + WS_SW)};
                      PH(13) pg8::gemm_phase<pg8::EpiPairI8, true>(F.lds, D / 2, S, E, F.wave); }
                    GRID_BAR();
                    { UFRESH(F); pg8::Order S{}; S.nM = nM; S.nN = D / 256; S.nwg = S.nM * S.nN; S.G = F.G; S.c = F.bid; S.atile0 = 0; S.otile0 = t0; S.etile0 = t0;
                      S.A = (const char*)(F.ws + WS_HS); S.Bt = Wb + W_MDN; S.tstep = (size_t)256 * FF * 2; S.estride = (size_t)D * FF * 2;
#pragma unroll
                      for (int e = 0; e < 8; ++e) S.tb[e] = tb[e];
                      pg8::EpiPlain E{(bf16*)(F.ws + WS_YS), D, nullptr};
                      PH(14) pg8::gemm_phase(F.lds, FF, S, E, F.wave); }
                    GRID_BAR();
                }
            }
            if ((RG >> 7) & 1) { PH(9) ln_pass_combine(F, args.in[1] + (size_t)(L * 2 + 1) * D, args.in[2] + (size_t)(L * 2 + 1) * D, cnt, L == 3, true); }
            PH(9) ln_pass_combine(F, args.in[1] + (size_t)(L * 2 + 1) * D, args.in[2] + (size_t)(L * 2 + 1) * D, cnt, L == 3, false);
            if (L + 1 < 4) { RPT(4) PH(1) conv_layer(F, args, L + 1); GRID_BAR(); }
        }
    }
}

extern "C" void kernel_launch(void* const* d_in, const int* in_sizes, int n_in, void* d_out, int out_size, void* d_ws, size_t ws_size, hipStream_t stream) {
    static int grid = 0;
    if (grid == 0) {
        if (n_in != 27 || in_sizes[0] != T * D || out_size != T * D || ws_size < WS_END) {
            fprintf(stderr, "kernel_launch: unexpected shapes (n_in %d, in0 %d, out %d, ws %zu; need ws >= %zu); nothing launched\n", n_in, n_in > 0 ? in_sizes[0] : -1, out_size, ws_size, (size_t)WS_END); grid = -1; return; }
        int dev = 0, cus = 0, per_cu = 0;
        if (hipGetDevice(&dev) != hipSuccess || hipDeviceGetAttribute(&cus, hipDeviceAttributeMultiprocessorCount, dev) != hipSuccess) { grid = -1; return; }
        if (hipFuncSetAttribute((const void*)fwd_kernel, hipFuncAttributeMaxDynamicSharedMemorySize, LDS_BYTES) != hipSuccess) { fprintf(stderr, "kernel_launch: hipFuncSetAttribute failed\n"); grid = -1; return; }
        if (hipOccupancyMaxActiveBlocksPerMultiprocessor(&per_cu, (const void*)fwd_kernel, NWAVES * 64, LDS_BYTES) != hipSuccess || per_cu < 1)
            fprintf(stderr, "kernel_launch: note: occupancy query reports %d workgroups per CU\n", per_cu);
        (void)hipGetLastError();
        grid = cus;
    }
    if (grid < 0) return;
    if (hipMemsetAsync((char*)d_ws + WS_CTL, 0, CTL_ZERO_BYTES, stream) != hipSuccess) return;
    Args a{};
    for (int i = 0; i < 27; ++i) a.in[i] = (const float*)d_in[i];
    a.out = (float*)d_out; a.ws = (unsigned char*)d_ws;
    hipLaunchKernelGGL(fwd_kernel, dim3(grid), dim3(NWAVES * 64), LDS_BYTES, stream, a);
}
```

```cpp
#include <hip/hip_runtime.h>
#include <cstdio>
#include <cstdint>

#define LAS __attribute__((address_space(3)))
typedef unsigned short bf16;
typedef short bf16x8 __attribute__((ext_vector_type(8)));
typedef short s16x4 __attribute__((ext_vector_type(4)));
typedef float f32x4 __attribute__((ext_vector_type(4)));
typedef float f32x2 __attribute__((ext_vector_type(2)));
typedef float f32x16 __attribute__((ext_vector_type(16)));
typedef unsigned u32x4 __attribute__((ext_vector_type(4)));
typedef unsigned u32x2 __attribute__((ext_vector_type(2)));
typedef int i32x4 __attribute__((ext_vector_type(4)));
typedef int i32x8 __attribute__((ext_vector_type(8)));
typedef __bf16 bf2_t __attribute__((ext_vector_type(2)));
#define DI __device__ __forceinline__
#define GASP __attribute__((address_space(1)))
template <class T> DI T* as_global(T* p) { return (T*)(GASP T*)p; }
#ifndef PHM
#define PHM 0xFFFFF
#endif
#define PH(b) if (PHM & (1 << (b)))
#ifndef RG
#define RG 0
#endif
#define RPT(g) for (int rep_ = 0, nrep_ = rep_count(((RG) >> (g)) & 1); rep_ < nrep_; ++rep_)
#define UFRESH(F) do { asm volatile("" : "+s"((F).ws), "+s"((F).out), "+s"((F).G), "+s"((F).bid)); (F).ctl = (unsigned*)((F).ws + WS_CTL); } while (0)
#define FRESH(F) do { UFRESH(F); int l_ = lane_id(); asm volatile("" : "+v"(l_)); (F).lane = l_; (F).tid = (F).wave * 64 + l_; } while (0)

constexpr int NWAVES = 8;
constexpr int BATCH = 32, SEQ = 2048, D = 1024, T = BATCH * SEQ;
constexpr int INW = 1792, FF = 2816, NE = 8;
constexpr float ALPHA = 1.6817928305074290f;
constexpr float LN_EPS = 1e-5f;
constexpr float QSCALE = 0.18033688011112042f;
constexpr float LOG2E = 1.4426950408889634f;

constexpr size_t MiB = 1u << 20;
constexpr size_t WS_CTL = 0, CTL_ZERO_BYTES = 1 * MiB;
constexpr size_t WS_ROPE = 1 * MiB;
constexpr size_t WS_RECI = 2 * MiB;
constexpr size_t WS_RECW = 3 * MiB;
constexpr size_t WS_SGUW = 4 * MiB;
constexpr size_t WS_SX = 5 * MiB;
constexpr size_t WS_SW = 6 * MiB;
constexpr size_t WS_SWD = 9 * MiB;
constexpr size_t WS_SXS = 7 * MiB;
constexpr size_t WS_W = 16 * MiB;
constexpr size_t WS_XB = 156 * MiB;
constexpr size_t WS_Y = 284 * MiB;
constexpr size_t WS_R = 412 * MiB;
constexpr size_t WS_Q = WS_R, WS_K = WS_Q + 64 * MiB, WS_V = WS_K + 16 * MiB, WS_ZU = WS_V + 16 * MiB, WS_ZV = WS_ZU + 64 * MiB, WS_MIX = WS_ZV + 64 * MiB;
constexpr size_t WS_H = WS_R;
constexpr size_t WS_YF = WS_R;
constexpr size_t WS_YG = WS_R + 256 * MiB;
constexpr int XS_ROWS = 2 * T + NE * 256;
constexpr int TC_MAX = 264;
constexpr size_t WS_XB8 = 768 * MiB;
constexpr size_t WS_XS = 284 * MiB;
constexpr size_t WS_HS = 416 * MiB;
constexpr size_t WS_YS = 600 * MiB;
constexpr size_t WS_END = 860 * MiB;
constexpr size_t W_IN = 0, W_OUT = 4 * MiB, W_GU = 6 * MiB, W_DN = 17 * MiB;
constexpr size_t W_GLU = 0, W_MGU = 4 * MiB, W_MDN = 48 * MiB;
constexpr int CW_TMO = 0, CW_DBG = 2, CW_BAR = 4096, CW_CNT = 8192;

constexpr int RING_BYTES = 131072;
constexpr int LDSCTL_OFF = RING_BYTES, MISC_OFF = LDSCTL_OFF + 320;
constexpr int LDS_BYTES = 147456;

DI unsigned pk2(float lo, float hi) { f32x2 v = {lo, hi}; return __builtin_bit_cast(unsigned, __builtin_convertvector(v, bf2_t)); }
DI unsigned q8(float v, float inv) { return __float_as_uint(__builtin_fmaf(v, inv, 12582912.0f)) & 0xffu; }
DI unsigned pk4_i8(float a, float b, float c, float d, float inv) { return q8(a, inv) | (q8(b, inv) << 8) | (q8(c, inv) << 16) | (q8(d, inv) << 24); }
DI unsigned pk4_fp8(float a, float b, float c, float d) { int w = 0; w = __builtin_amdgcn_cvt_pk_fp8_f32(a, b, w, false); w = __builtin_amdgcn_cvt_pk_fp8_f32(c, d, w, true); return (unsigned)w; }
DI float bf_lo(unsigned w) { return __uint_as_float(w << 16); }
DI float bf_hi(unsigned w) { return __uint_as_float(w & 0xffff0000u); }
DI float fast_exp2(float x) { return __builtin_amdgcn_exp2f(x); }
DI float fast_rcp(float x) { return __builtin_amdgcn_rcpf(x); }
DI float sigmoidf_(float x) { return fast_rcp(1.0f + fast_exp2(-LOG2E * x)); }
DI float gelu_tanh(float x) { const float z = x + 0.044715f * x * x * x; return x * fast_rcp(1.0f + fast_exp2(-2.302208198f * z)); }
#define dpp_f(v, ctrl) __int_as_float(__builtin_amdgcn_mov_dpp(__float_as_int(v), (ctrl), 0xf, 0xf, true))
#define DPP_XOR1 0xB1
#define DPP_XOR2 0x4E
#define DPP_HMIRROR 0x141
#define DPP_MIRROR 0x140
DI float swz16_f(float v) { return __int_as_float(__builtin_amdgcn_ds_swizzle(__float_as_int(v), 0x401F)); }
DI float sum_x32(float v) { auto r = __builtin_amdgcn_permlane32_swap(__float_as_uint(v), __float_as_uint(v), false, false); return __uint_as_float(r[0]) + __uint_as_float(r[1]); }
DI float max_x32(float v) { auto r = __builtin_amdgcn_permlane32_swap(__float_as_uint(v), __float_as_uint(v), false, false); return fmaxf(__uint_as_float(r[0]), __uint_as_float(r[1])); }
DI float wave_max(float v) {
    v = fmaxf(v, dpp_f(v, DPP_XOR1)); v = fmaxf(v, dpp_f(v, DPP_XOR2)); v = fmaxf(v, dpp_f(v, DPP_HMIRROR)); v = fmaxf(v, dpp_f(v, DPP_MIRROR)); v = fmaxf(v, swz16_f(v)); return max_x32(v);
}
DI float wave_sum(float v) {
    v += dpp_f(v, DPP_XOR1); v += dpp_f(v, DPP_XOR2); v += dpp_f(v, DPP_HMIRROR); v += dpp_f(v, DPP_MIRROR); v += swz16_f(v); return sum_x32(v);
}
#define LDS_WAIT() asm volatile("s_waitcnt lgkmcnt(0)" ::: "memory")
#define VM_WAIT() asm volatile("s_waitcnt vmcnt(0)" ::: "memory")
DI int lane_id() { unsigned ones = ~0u; asm volatile("" : "+s"(ones)); return (int)__builtin_amdgcn_mbcnt_hi(ones, __builtin_amdgcn_mbcnt_lo(ones, 0u)); }
DI int rep_count(int extra) { int n = 1 + extra; asm volatile("" : "+s"(n)); return n; }
DI int crow(int reg, int h) { return (reg & 3) + 8 * (reg >> 2) + 4 * h; }
#define MFMA32(a, b, c) __builtin_amdgcn_mfma_f32_32x32x16_bf16((a), (b), (c), 0, 0, 0)
#define MFMA16(a, b, c) __builtin_amdgcn_mfma_f32_16x16x32_bf16((a), (b), (c), 0, 0, 0)

DI void sincos_d(double th, double& s, double& c) {
    const double tq = th * 0.63661977236758134308;
    const double q = rint(tq);
    const double f = (tq - q) * 1.57079632679489661923;
    const double f2 = f * f;
    const double sp = f * (1.0 + f2 * (-1.0 / 6 + f2 * (1.0 / 120 + f2 * (-1.0 / 5040 + f2 * (1.0 / 362880 + f2 * (-1.0 / 39916800 + f2 * (1.0 / 6227020800.0)))))));
    const double cp = 1.0 + f2 * (-0.5 + f2 * (1.0 / 24 + f2 * (-1.0 / 720 + f2 * (1.0 / 40320 + f2 * (-1.0 / 3628800 + f2 * (1.0 / 479001600.0 + f2 * (-1.0 / 87178291200.0)))))));
    const int qi = ((int)q) & 3;
    s = (qi == 0) ? sp : (qi == 1) ? cp : (qi == 2) ? -sp : -cp;
    c = (qi == 0) ? cp : (qi == 1) ? -sp : (qi == 2) ? -cp : sp;
}
DI double exp_d(double x) {
    const double n = rint(x * 1.4426950408889634074);
    const double r = x - n * 0.69314718055994530942;
    double p = 1.0 / 87178291200.0;
    p = p * r + 1.0 / 6227020800.0; p = p * r + 1.0 / 479001600.0; p = p * r + 1.0 / 39916800.0; p = p * r + 1.0 / 3628800.0; p = p * r + 1.0 / 362880.0;
    p = p * r + 1.0 / 40320.0; p = p * r + 1.0 / 5040.0; p = p * r + 1.0 / 720.0; p = p * r + 1.0 / 120.0; p = p * r + 1.0 / 24.0; p = p * r + 1.0 / 6.0; p = p * r + 0.5; p = p * r + 1.0; p = p * r + 1.0;
    const long long bits = (long long)((int)n + 1023) << 52;
    return p * __builtin_bit_cast(double, bits);
}

namespace pg8 {
constexpr int BM = 256, BK = 64, HALF = 128, HTB = HALF * BK * 2, STAGE_BYTES = 8 * HTB, NXCD = 8, WGM = 8;
DI int lds_byte(int r, int c) { const int st = (r >> 4) * 2 + (c >> 5), rr = r & 15, cc = c & 31, ob = rr * 64 + cc * 2; return st * 1024 + (ob ^ (((ob >> 9) & 1) << 5)); }
DI void stage_rc(int b, int& R, int& C) { const int st = b / 1024, sb = b % 1024, swz = sb ^ (((sb >> 9) & 1) << 5); R = (st >> 1) * 16 + swz / 64; C = (st & 1) * 32 + (swz % 64) / 2; }
DI int perm32(int rho) { const int n = rho >> 4, i = rho & 15; return 8 * (i >> 2) + 4 * n + (i & 3); }

struct Unit { int pm, pn, row0, arow0, e; const char* a; const char* b; };
struct Order {
    int nM, nN, nwg, G, c, atile0, otile0, etile0;
    const char* A; const char* Bt; size_t tstep, estride;
    int tb[8];
    DI bool next(int i, Unit& u) const {
        const long L = (long)i * G + c; if (L >= nwg) return false;
        int wgid = (int)L; { const int q = nwg / NXCD, r = nwg % NXCD, xcd = wgid % NXCD, off = wgid / NXCD; wgid = (xcd < r ? xcd * (q + 1) : r * (q + 1) + (xcd - r) * q) + off; }
        const int nig = WGM * nN, gid = wgid / nig, fm = gid * WGM, gsz = (nM - fm) < WGM ? (nM - fm) : WGM;
        u.pm = fm + ((wgid % nig) % gsz); u.pn = (wgid % nig) / gsz;
        u.row0 = (otile0 + u.pm) * BM;
        int e = 0;
        if (estride) { const int t = etile0 + u.pm;
#pragma unroll
            for (int j = 1; j < 8; ++j) e += (t >= tb[j]) ? 1 : 0; }
        u.e = e; u.arow0 = (atile0 + u.pm) * BM;
        u.a = A + (size_t)(atile0 + u.pm) * tstep; u.b = Bt + (size_t)e * estride + (size_t)u.pn * tstep;
        return true;
    }
};

template <class Epi, int MODE = 0>
DI void gemm_phase(LAS unsigned char* lds, const int K, const Order& S, const Epi& E, const int wid) {
    int lane = lane_id(); asm volatile("" : "+v"(lane));
    const int tid = wid * 64 + lane, wr = wid >> 2, wc = wid & 3, fr = lane & 15, fq = lane >> 4;
    const int nt = K / BK;
    unsigned voffA[2], voffB[2];
#pragma unroll
    for (int i = 0; i < 2; ++i) { int R, C; stage_rc(tid * 16 + i * 8192, R, C); const int Rb = (R & ~31) + perm32(R & 31);
        voffA[i] = (unsigned)(R * K + C) * 2u; voffB[i] = (unsigned)(Rb * K + C) * 2u; }
    const size_t kstep = (size_t)(BK * 2);
    const size_t hstep = (size_t)HALF * K * 2;
    const unsigned ldsw = (unsigned)wid * 1024u;
    constexpr bool I8 = (MODE == 1), F8 = (MODE == 2);
    const int aoff = F8 ? lds_byte(wr * 64 + fr, 32 * (fq >> 1) + 16 * (fq & 1)) : lds_byte(wr * 64 + fr, fq * 8), boff = F8 ? lds_byte(wc * 32 + fr, 32 * (fq >> 1) + 16 * (fq & 1)) : lds_byte(wc * 32 + fr, fq * 8);
#define PG8_SA(b, h) (((b) * 2 + (h)) * HTB)
#define PG8_SB(b, h) ((4 + (b) * 2 + (h)) * HTB)
#define PG8_STAGE(bufoff, gbase, voff) do { _Pragma("unroll") for (int _i = 0; _i < 2; ++_i) \
        __builtin_amdgcn_global_load_lds((const unsigned*)((const char*)(gbase) + (voff)[_i]), (LAS unsigned*)(lds + (bufoff) + ldsw + _i * 8192), 16, 0, 0); } while (0)
#define PG8_LDA(dst, b, h) do { _Pragma("unroll") for (int m = 0; m < 4; ++m) { if constexpr (F8) dst##8[m] = *(const LAS i32x8*)(lds + PG8_SA(b, h) + aoff + m * 2048); \
        else { _Pragma("unroll") for (int k = 0; k < 2; ++k) dst[m][k] = *(const LAS bf16x8*)(lds + PG8_SA(b, h) + aoff + m * 2048 + k * 1024); } } } while (0)
#define PG8_LDB(dst, b, h) do { _Pragma("unroll") for (int n = 0; n < 2; ++n) { if constexpr (F8) dst##8[n] = *(const LAS i32x8*)(lds + PG8_SB(b, h) + boff + n * 2048); \
        else { _Pragma("unroll") for (int k = 0; k < 2; ++k) dst[n][k] = *(const LAS bf16x8*)(lds + PG8_SB(b, h) + boff + n * 2048 + k * 1024); } } } while (0)
#define PG8_MMA(ai, bj, At, Bt) do { __builtin_amdgcn_s_setprio(1); _Pragma("unroll") for (int m = 0; m < 4; ++m) _Pragma("unroll") for (int n = 0; n < 2; ++n) { \
        if constexpr (F8) asm volatile("v_mfma_scale_f32_16x16x128_f8f6f4 %0, %1, %2, %0, %3, %3 op_sel_hi:[0,0,0]" : "+v"(acc[ai][bj][m][n]) : "v"(Bt##8[n]), "v"(At##8[m]), "v"(scale1)); \
        else { _Pragma("unroll") for (int k = 0; k < 2; ++k) \
        { if constexpr (I8) acc[ai][bj][m][n] = __builtin_bit_cast(f32x4, __builtin_amdgcn_mfma_i32_16x16x64_i8(__builtin_bit_cast(i32x4, Bt[n][k]), __builtin_bit_cast(i32x4, At[m][k]), __builtin_bit_cast(i32x4, acc[ai][bj][m][n]), 0, 0, 0)); \
          else acc[ai][bj][m][n] = __builtin_amdgcn_mfma_f32_16x16x32_bf16(Bt[n][k], At[m][k], acc[ai][bj][m][n], 0, 0, 0); } } } __builtin_amdgcn_s_setprio(0); } while (0)
#define PG8_WAIT_V(n) asm volatile("s_waitcnt vmcnt(" #n ")" ::: "memory")
#define PG8_WAIT_L(n) asm volatile("s_waitcnt lgkmcnt(" #n ")" ::: "memory")
#define PG8_BAR __builtin_amdgcn_s_barrier()
#define PG8_SCHED __builtin_amdgcn_sched_barrier(0)
    Unit cur, nxt; int ui = 0;
    if (!S.next(0, cur)) return;
    f32x4 acc[2][2][4][2];
#pragma unroll
    for (int a = 0; a < 2; ++a)
#pragma unroll
        for (int b = 0; b < 2; ++b)
#pragma unroll
            for (int m = 0; m < 4; ++m)
#pragma unroll
                for (int n = 0; n < 2; ++n) acc[a][b][m][n] = (f32x4){0.f, 0.f, 0.f, 0.f};
    const int scale1 = 0x7F7F7F7F;
    bf16x8 At[4][2], B0[2][2], B1[2][2]; i32x8 At8[4], B08[2], B18[2];
    const char* cA = cur.a; const char* cB = cur.b;
    PG8_STAGE(PG8_SB(0, 0), cB, voffB); PG8_STAGE(PG8_SB(0, 1), cB + hstep, voffB); PG8_STAGE(PG8_SA(0, 0), cA, voffA); PG8_STAGE(PG8_SA(0, 1), cA + hstep, voffA);
    if (wr == 1) PG8_BAR;
    PG8_WAIT_V(2); PG8_BAR;
    PG8_STAGE(PG8_SB(1, 0), cB + kstep, voffB); PG8_STAGE(PG8_SA(1, 0), cA + kstep, voffA); PG8_STAGE(PG8_SB(1, 1), cB + hstep + kstep, voffB);
    PG8_WAIT_V(6); PG8_BAR;
    for (;;) {
        const bool has_next = S.next(ui + 1, nxt);
        const char* nA = has_next ? nxt.a : cA; const char* nB = has_next ? nxt.b : cB;
#pragma unroll 1
        for (int t = 0; t < nt; t += 2) {
            const bool last = (t == nt - 2);
            const char* a1 = cA + (size_t)(t + 1) * kstep;
            const char* a2 = last ? nA : cA + (size_t)(t + 2) * kstep; const char* b2 = last ? nB : cB + (size_t)(t + 2) * kstep;
            const char* a3 = a2 + kstep; const char* b3 = b2 + kstep;
            PG8_LDB(B0, 0, 0); PG8_LDB(B1, 0, 1); PG8_SCHED; PG8_LDA(At, 0, 0); PG8_STAGE(PG8_SA(1, 1), a1 + hstep, voffA);
            PG8_WAIT_V(8); PG8_WAIT_L(0); PG8_BAR; PG8_MMA(0, 0, At, B0); PG8_MMA(0, 1, At, B1); PG8_BAR; PG8_SCHED;
            PG8_LDA(At, 0, 1); PG8_STAGE(PG8_SB(0, 0), b2, voffB); PG8_STAGE(PG8_SB(0, 1), b2 + hstep, voffB); PG8_STAGE(PG8_SA(0, 0), a2, voffA);
            PG8_WAIT_V(8); PG8_WAIT_L(0); PG8_BAR; PG8_MMA(1, 0, At, B0); PG8_MMA(1, 1, At, B1); PG8_BAR; PG8_SCHED;
            PG8_LDB(B0, 1, 0); PG8_LDB(B1, 1, 1); PG8_SCHED; PG8_LDA(At, 1, 0); PG8_STAGE(PG8_SA(0, 1), a2 + hstep, voffA);
            PG8_WAIT_V(8); PG8_WAIT_L(0); PG8_BAR; PG8_MMA(0, 0, At, B0); PG8_MMA(0, 1, At, B1); PG8_BAR; PG8_SCHED;
            PG8_LDA(At, 1, 1); PG8_STAGE(PG8_SB(1, 0), b3, voffB); PG8_STAGE(PG8_SB(1, 1), b3 + hstep, voffB); PG8_STAGE(PG8_SA(1, 0), a3, voffA);
            PG8_WAIT_V(8); PG8_WAIT_L(0); PG8_BAR; PG8_MMA(1, 0, At, B0); PG8_MMA(1, 1, At, B1); PG8_BAR; PG8_SCHED;
        }
        if (wr == 0) PG8_BAR;
        if constexpr (F8) asm volatile("s_nop 15\n\ts_nop 7" ::: "memory");
        E(acc, cur, wr, wc, fr, fq);
        if (!has_next) break;
#pragma unroll
        for (int a = 0; a < 2; ++a)
#pragma unroll
            for (int b = 0; b < 2; ++b)
#pragma unroll
                for (int m = 0; m < 4; ++m)
#pragma unroll
                    for (int n = 0; n < 2; ++n) acc[a][b][m][n] = (f32x4){0.f, 0.f, 0.f, 0.f};
        cur = nxt; cA = nA; cB = nB; ++ui;
        if (wr == 1) PG8_BAR;
    }
    PG8_WAIT_V(0);
    PG8_BAR;
#undef PG8_SA
#undef PG8_SB
#undef PG8_STAGE
#undef PG8_LDA
#undef PG8_LDB
#undef PG8_MMA
#undef PG8_WAIT_V
#undef PG8_WAIT_L
#undef PG8_BAR
#undef PG8_SCHED
}

DI u32x4 pack8(const f32x4 a, const f32x4 b) { u32x4 w; w.x = pk2(a[0], a[1]); w.y = pk2(a[2], a[3]); w.z = pk2(b[0], b[1]); w.w = pk2(b[2], b[3]); return w; }

DI f32x4 bfx4_lo(const u32x4 w) { return (f32x4){bf_lo(w.x), bf_hi(w.x), bf_lo(w.y), bf_hi(w.y)}; }
DI f32x4 bfx4_hi(const u32x4 w) { return (f32x4){bf_lo(w.z), bf_hi(w.z), bf_lo(w.w), bf_hi(w.w)}; }
struct EpiPlain {
    bf16* O; int ldc; const bf16* R; const float* swd;
    DI void operator()(const f32x4 (&acc)[2][2][4][2], const Unit& u, int wr, int wc, int fr, int fq) const {
        asm volatile("" : "+v"(fr), "+v"(fq));
        const int row0 = u.row0 + wr * 64 + fr, col0 = u.pn * BM + wc * 32 + 8 * fq;
        f32x4 cs[2][2];
#pragma unroll
        for (int bj = 0; bj < 2; ++bj)
#pragma unroll
            for (int n = 0; n < 2; ++n) cs[bj][n] = swd ? *(const f32x4*)(swd + (size_t)u.e * D + col0 + bj * HALF + 4 * n) : (f32x4){1.f, 1.f, 1.f, 1.f};
#define ACS(ai, bj, m, n) (acc[ai][bj][m][n] * cs[bj][n])
        if (R) {
#pragma unroll
            for (int hb = 0; hb < 2; ++hb) {
                u32x4 r0[4], r1[4];
#pragma unroll
                for (int m = 0; m < 4; ++m) { const size_t off = (size_t)(row0 + hb * HALF + m * 16) * ldc + col0; r0[m] = *(const u32x4*)(R + off); r1[m] = *(const u32x4*)(R + off + HALF); }
                asm volatile("" ::: "memory");
#pragma unroll
                for (int m = 0; m < 4; ++m) { const int ai = hb; const size_t off = (size_t)(row0 + ai * HALF + m * 16) * ldc + col0;
                    *(u32x4*)(O + off) = pack8(ACS(ai, 0, m, 0) + bfx4_lo(r0[m]) * ALPHA, ACS(ai, 0, m, 1) + bfx4_hi(r0[m]) * ALPHA);
                    *(u32x4*)(O + off + HALF) = pack8(ACS(ai, 1, m, 0) + bfx4_lo(r1[m]) * ALPHA, ACS(ai, 1, m, 1) + bfx4_hi(r1[m]) * ALPHA); }
                asm volatile("" ::: "memory");
            }
        } else {
#pragma unroll
            for (int ai = 0; ai < 2; ++ai)
#pragma unroll
                for (int m = 0; m < 4; ++m) { const size_t off = (size_t)(row0 + ai * HALF + m * 16) * ldc + col0;
#pragma unroll
                    for (int bj = 0; bj < 2; ++bj) *(u32x4*)(O + off + bj * HALF) = pack8(ACS(ai, bj, m, 0), ACS(ai, bj, m, 1)); }
        }
    }
#undef ACS
};
template <int ACT> struct EpiPair {
    bf16* O; int ldc; const bf16* R;
    DI void operator()(const f32x4 (&acc)[2][2][4][2], const Unit& u, int wr, int wc, int fr, int fq) const {
        asm volatile("" : "+v"(fr), "+v"(fq));
        const int row0 = u.row0 + wr * 64 + fr, col0 = u.pn * HALF + wc * 32 + 8 * fq;
        u32x4 r[8];
#pragma unroll
        for (int g = 0; g < 8; ++g) { r[g] = (u32x4){0u, 0u, 0u, 0u}; if (R) r[g] = *(const u32x4*)(R + (size_t)(row0 + (g >> 2) * HALF + (g & 3) * 16) * ldc + col0); }
        if (R) asm volatile("" ::: "memory");
#pragma unroll
        for (int g = 0; g < 8; ++g) { const int ai = g >> 2, m = g & 3;
            const size_t off = (size_t)(row0 + ai * HALF + m * 16) * ldc + col0;
            f32x4 o[2];
            if (R) { o[0] = bfx4_lo(r[g]) * ALPHA; o[1] = bfx4_hi(r[g]) * ALPHA; } else { o[0] = (f32x4){0.f, 0.f, 0.f, 0.f}; o[1] = o[0]; }
#pragma unroll
            for (int n = 0; n < 2; ++n) { const f32x4 a = acc[ai][0][m][n], b = acc[ai][1][m][n];
#pragma unroll
                for (int j = 0; j < 4; ++j) o[n][j] += (ACT == 0) ? a[j] * sigmoidf_(a[j]) * b[j] : a[j] * sigmoidf_(b[j]); }
            *(u32x4*)(O + off) = pack8(o[0], o[1]); }
    }
};
struct EpiPairI8 {
    unsigned char* O;     int ldc; const float* sx; const float* sw;
    DI void operator()(const f32x4 (&acc)[2][2][4][2], const Unit& u, int wr, int wc, int fr, int fq) const {
        asm volatile("" : "+v"(fr), "+v"(fq));
        const int rloc = wr * 64 + fr, col0 = u.pn * HALF + wc * 32 + 8 * fq;
        const float* swp = sw + (size_t)u.e * (2 * FF) + u.pn * BM + wc * 32 + 8 * fq;
        f32x4 sg[2], su[2];
#pragma unroll
        for (int n = 0; n < 2; ++n) { sg[n] = *(const f32x4*)(swp + 4 * n); su[n] = *(const f32x4*)(swp + HALF + 4 * n); }
        float srv[8];
#pragma unroll
        for (int g = 0; g < 8; ++g) srv[g] = sx[u.arow0 + rloc + (g >> 2) * HALF + (g & 3) * 16];
#pragma unroll
        for (int ai = 0; ai < 2; ++ai)
#pragma unroll
            for (int m = 0; m < 4; ++m) {
                const int rr = rloc + ai * HALF + m * 16;
                const float sr = srv[ai * 4 + m];
                f32x4 o[2];
#pragma unroll
                for (int n = 0; n < 2; ++n) {
                    const f32x4 a = __builtin_convertvector(__builtin_bit_cast(i32x4, acc[ai][0][m][n]), f32x4) * (sg[n] * sr);
                    const f32x4 b = __builtin_convertvector(__builtin_bit_cast(i32x4, acc[ai][1][m][n]), f32x4) * (su[n] * sr);
                    const f32x4 t = a * (-LOG2E);
                    f32x4 e; e[0] = fast_exp2(t[0]); e[1] = fast_exp2(t[1]); e[2] = fast_exp2(t[2]); e[3] = fast_exp2(t[3]);
                    e = e + 1.0f;
                    f32x4 r; r[0] = fast_rcp(e[0]); r[1] = fast_rcp(e[1]); r[2] = fast_rcp(e[2]); r[3] = fast_rcp(e[3]);
                    o[n] = (a * r) * b; }
                u32x2 w8; w8.x = pk4_fp8(o[0][0], o[0][1], o[0][2], o[0][3]); w8.y = pk4_fp8(o[1][0], o[1][1], o[1][2], o[1][3]);
                *(u32x2*)(O + (size_t)(u.row0 + rr) * ldc + col0) = w8;
                asm volatile("" ::: "memory"); }
    }
};
struct EpiWin {
    bf16 *Q, *Kb, *Vb, *ZU, *ZV; const float *cosT, *sinT, *lng, *lnb;
    DI void operator()(const f32x4 (&acc)[2][2][4][2], const Unit& u, int wr, int wc, int fr, int fq) const {
        asm volatile("" : "+v"(fr), "+v"(fq));
        const int rbase = u.row0 + wr * 64 + fr, pn = u.pn;
        if (pn < 2 || (pn == 2 && wc < 2)) {
            bf16* dst; int ld, colb; float sc;
            if (pn < 2) { dst = Q; ld = 512; colb = 64 * (4 * pn + wc); sc = QSCALE; } else { dst = Kb; ld = 128; colb = 64 * wc; sc = 1.0f; }
#pragma unroll
            for (int hb = 0; hb < 2; ++hb) {
                f32x4 cc[4][2], ss[4][2];
#pragma unroll
                for (int m = 0; m < 4; ++m) { const int pos = (rbase + hb * HALF + m * 16) & (SEQ - 1);
#pragma unroll
                    for (int n = 0; n < 2; ++n) { cc[m][n] = *(const f32x4*)(cosT + pos * 32 + 8 * fq + 4 * n); ss[m][n] = *(const f32x4*)(sinT + pos * 32 + 8 * fq + 4 * n); } }
                asm volatile("" ::: "memory");
#pragma unroll
                for (int m = 0; m < 4; ++m) { const int ai = hb; const int row = rbase + ai * HALF + m * 16;
                    f32x4 o1[2], o2[2];
#pragma unroll
                    for (int n = 0; n < 2; ++n) { const f32x4 x1 = acc[ai][0][m][n], x2 = acc[ai][1][m][n];
                        o1[n] = (x1 * cc[m][n] - x2 * ss[m][n]) * sc; o2[n] = (x2 * cc[m][n] + x1 * ss[m][n]) * sc; }
                    bf16* rp = dst + (size_t)row * ld + colb + 8 * fq;
                    *(u32x4*)(rp) = pack8(o1[0], o1[1]); *(u32x4*)(rp + 32) = pack8(o2[0], o2[1]); }
                asm volatile("" ::: "memory");
            }
        } else if (pn == 2) {
#pragma unroll
            for (int ai = 0; ai < 2; ++ai)
#pragma unroll
                for (int m = 0; m < 4; ++m) { int row = rbase + ai * HALF + m * 16; asm volatile("" : "+v"(row) :: "memory"); bf16* rp = Vb + (size_t)row * 128 + 64 * (wc - 2) + 8 * fq;
#pragma unroll
                    for (int bj = 0; bj < 2; ++bj) *(u32x4*)(rp + 32 * bj) = pack8(acc[ai][bj][m][0], acc[ai][bj][m][1]); }
        } else if (pn < 5) {
#pragma unroll
            for (int ai = 0; ai < 2; ++ai)
#pragma unroll
                for (int m = 0; m < 4; ++m) { int row = rbase + ai * HALF + m * 16; asm volatile("" : "+v"(row) :: "memory"); bf16* rp = ZU + (size_t)row * 512 + 256 * (pn - 3) + 64 * wc + 8 * fq;
#pragma unroll
                    for (int bj = 0; bj < 2; ++bj) { f32x4 a = acc[ai][bj][m][0], b = acc[ai][bj][m][1];
#pragma unroll
                        for (int j = 0; j < 4; ++j) { a[j] = gelu_tanh(a[j]); b[j] = gelu_tanh(b[j]); }
                        *(u32x4*)(rp + 32 * bj) = pack8(a, b); } }
        } else {
            const int gi = 4 * (pn - 5) + wc;
            f32x4 gg[2][2], bb[2][2];
#pragma unroll
            for (int bj = 0; bj < 2; ++bj)
#pragma unroll
                for (int n = 0; n < 2; ++n) { gg[bj][n] = *(const f32x4*)(lng + gi * 64 + 32 * bj + 8 * fq + 4 * n); bb[bj][n] = *(const f32x4*)(lnb + gi * 64 + 32 * bj + 8 * fq + 4 * n); }
#pragma unroll
            for (int ai = 0; ai < 2; ++ai)
#pragma unroll
                for (int m = 0; m < 4; ++m) { int row = rbase + ai * HALF + m * 16; asm volatile("" : "+v"(row) :: "memory");
                    f32x4 z[2][2]; float s = 0.f;
#pragma unroll
                    for (int bj = 0; bj < 2; ++bj)
#pragma unroll
                        for (int n = 0; n < 2; ++n) {
#pragma unroll
                            for (int j = 0; j < 4; ++j) { z[bj][n][j] = gelu_tanh(acc[ai][bj][m][n][j]); s += z[bj][n][j]; } }
                    s += swz16_f(s); s = sum_x32(s);
                    const float mean = s * (1.0f / 64.0f); float q = 0.f;
#pragma unroll
                    for (int bj = 0; bj < 2; ++bj)
#pragma unroll
                        for (int n = 0; n < 2; ++n) { z[bj][n] = z[bj][n] - mean; q += (z[bj][n][0] * z[bj][n][0] + z[bj][n][1] * z[bj][n][1]) + (z[bj][n][2] * z[bj][n][2] + z[bj][n][3] * z[bj][n][3]); }
                    q += swz16_f(q); q = sum_x32(q);
                    const float rstd = 1.0f / sqrtf(q * (1.0f / 64.0f) + LN_EPS);
                    bf16* rp = ZV + (size_t)row * 512 + 64 * gi + 8 * fq;
#pragma unroll
                    for (int bj = 0; bj < 2; ++bj) *(u32x4*)(rp + 32 * bj) = pack8(z[bj][0] * rstd * gg[bj][0] + bb[bj][0], z[bj][1] * rstd * gg[bj][1] + bb[bj][1]); asm volatile("" ::: "memory"); }
        }
    }
};
}

#define XB_TMO      128
#define XB_XCNT(j)  (256  + 64 * (j))
#define XB_XSUB(j)  (1280 + 64 * (j))
#define XB_XGEN(j)  (2304 + 64 * (j))
#define XB_TOP      3328
#define XB_TOPGEN   3392
#define XCD_BAR_WORDS 3456
#define XB_SPIN_CAP (1u << 22)
DI unsigned xb_ld(unsigned* p)              { return __hip_atomic_load(p, __ATOMIC_RELAXED, __HIP_MEMORY_SCOPE_AGENT); }
DI unsigned xb_add(unsigned* p, unsigned v) { return __hip_atomic_fetch_add(p, v, __ATOMIC_RELAXED, __HIP_MEMORY_SCOPE_AGENT); }
DI unsigned xb_xcc_id() { return (unsigned)__builtin_amdgcn_s_getreg((3 << 11) | 20) & 0xFu; }
#define XB_SPIN(cond, bar) do { unsigned _sp = 0; while (cond) { __builtin_amdgcn_s_sleep(1); \
    if ((++_sp & 255u) == 0u) { if (xb_ld(&(bar)[XB_TMO])) break; if (_sp > XB_SPIN_CAP) { atomicAdd(&(bar)[XB_TMO], 1u); break; } } } } while (0)
struct XcdBarrier { GASP unsigned* bar; unsigned x; volatile LAS unsigned* st; };
DI XcdBarrier xcd_barrier_post(GASP unsigned* bar, volatile LAS unsigned* st, bool leader) {
    XcdBarrier b; b.bar = bar; b.x = xb_xcc_id(); b.st = st;
    if (leader) (void)xb_add((unsigned*)&bar[XB_XCNT(b.x)], 1u);
    return b;
}
DI void xcd_barrier_complete(unsigned* bar, unsigned x, unsigned& nloc, unsigned& nx) {
    const unsigned G = gridDim.x * gridDim.y * gridDim.z;
    unsigned sum, cnt, mine, sp = 0u;
    for (;;) {
        sum = 0u; cnt = 0u; mine = 0u;
#pragma unroll
        for (unsigned j = 0; j < 16; ++j) { const unsigned c = xb_ld(&bar[XB_XCNT(j)]); sum += c; cnt += (c > 0u) ? 1u : 0u; mine = (j == x) ? c : mine; }
        if (sum == G) break;
        __builtin_amdgcn_s_sleep(1);
        if ((++sp & 255u) == 0u) { if (xb_ld(&bar[XB_TMO])) break; if (sp > XB_SPIN_CAP) { atomicAdd(&bar[XB_TMO], 1u); break; } }
    }
    nloc = mine > 0u ? mine : 1u; nx = cnt > 0u ? cnt : 1u;
}
DI void xcd_barrier(const XcdBarrier& b, int wave) {
    asm volatile("s_waitcnt vmcnt(0)" ::: "memory");
    __syncthreads();
    if (wave == 0 && lane_id() == 0) {
        GASP unsigned* barg = b.bar; unsigned bx = b.x; asm volatile("" : "+s"(barg), "+s"(bx)); unsigned* bar = (unsigned*)barg;
        __builtin_amdgcn_s_waitcnt(0);
        unsigned nloc = b.st[0], nx = b.st[1];
        if (nloc == 0u) { xcd_barrier_complete(bar, bx, nloc, nx); b.st[0] = nloc; b.st[1] = nx; }
        const unsigned old = xb_add(&bar[XB_XSUB(bx)], 1u);
        const unsigned gen = old / nloc;
        if (old + 1u == (gen + 1u) * nloc) {
            __builtin_amdgcn_fence(__ATOMIC_RELEASE, "agent");
            asm volatile("s_waitcnt vmcnt(0)" ::: "memory");
            const unsigned og = xb_add(&bar[XB_TOP], 1u);
            const unsigned tg = og / nx;
            if (og + 1u == (tg + 1u) * nx) xb_add(&bar[XB_TOPGEN], 1u);
            else XB_SPIN(xb_ld(&bar[XB_TOPGEN]) == tg, bar);
            __builtin_amdgcn_fence(__ATOMIC_ACQUIRE, "agent");
            xb_add(&bar[XB_XGEN(bx)], 1u);
            asm volatile("s_waitcnt vmcnt(0)" ::: "memory");
        } else {
            XB_SPIN(xb_ld(&bar[XB_XGEN(bx)]) == gen, bar);
            __builtin_amdgcn_fence(__ATOMIC_ACQUIRE, "agent");
            asm volatile("s_waitcnt vmcnt(0)" ::: "memory");
        }
    }
    __syncthreads();
}

struct Frame {
    LAS unsigned char* lds;
    volatile LAS unsigned* MISC;
    unsigned* ctl;
    int tid, lane, wave, G, bid;
    GASP unsigned char* ws;
    GASP float* out;
};
struct Args { const float* in[27]; float* out; unsigned char* ws; };
typedef const unsigned char __attribute__((address_space(4)))* kptr_t;
DI const float* in_ptr(int k) { kptr_t p = (kptr_t)__builtin_amdgcn_kernarg_segment_ptr(); asm volatile("" : "+s"(p)); return (const float*)(*(GASP const float* const __attribute__((address_space(4)))*)(p + 8 * k)); }
struct ArgsRef { struct Acc { DI const float* operator[](int k) const { return in_ptr(k); } } in; };

template <int MAP>
DI int conv_col(int nb2, int lane, bool& second) {
    second = false;
    if (MAP == 0) return 64 * nb2 + lane;
    const int pn = nb2 >> 2, bj = (nb2 >> 1) & 1, wcp = nb2 & 1;
    if (MAP == 2) { second = bj != 0; return 128 * pn + 64 * wcp + lane; }
    return 256 * pn + 128 * wcp + 32 * bj + 64 * (lane >> 5) + (lane & 31);
}
template <int MAP>
DI void conv_job(Frame& F, const float* s1, const float* s2, bf16* dst, int K, int ldw, int nblk64, int nexp) {
    const int gw = F.bid * NWAVES + F.wave, NGW = F.G * NWAVES, lane = F.lane;
    const int per = (K / 64) * nblk64, total = per * nexp;
    for (int it = gw; it < total; it += NGW) {
        const int e = it / per, r = it - e * per, kb = r / nblk64, nb2 = r - kb * nblk64;
        bool second; const int col = conv_col<MAP>(nb2, lane, second);
        const float* W = (second ? s2 : s1) + (size_t)e * K * ldw + (size_t)(64 * kb) * ldw + col;
        float v[64];
#pragma unroll
        for (int k = 0; k < 64; ++k) v[k] = W[(size_t)k * ldw];
        bf16* drow = dst + ((size_t)e * nblk64 * 64 + (size_t)nb2 * 64 + lane) * K + 64 * kb;
#pragma unroll
        for (int q = 0; q < 8; ++q) { u32x4 o; o.x = pk2(v[8 * q], v[8 * q + 1]); o.y = pk2(v[8 * q + 2], v[8 * q + 3]); o.z = pk2(v[8 * q + 4], v[8 * q + 5]); o.w = pk2(v[8 * q + 6], v[8 * q + 7]); *(u32x4*)(drow + 8 * q) = o; }
    }
}
template <int MAP>
DI void conv_job_i8(Frame& F, const float* s1, const float* s2, unsigned char* dst, float* swout, int ldw, int nblk64, int nexp) {
    constexpr int K = D, KW = K / NWAVES;
    LAS float* wmax = (LAS float*)(F.lds + 124 * 1024);
    LAS float* sinv = wmax + 512;
    const int lane = F.lane, w = F.wave;
    for (int it = F.bid; it < nblk64 * nexp; it += F.G) {
        const int e = it / nblk64, nb2 = it - e * nblk64;
        bool second; const int col = conv_col<MAP>(nb2, lane, second);
        const float* W = (second ? s2 : s1) + (size_t)e * K * ldw + (size_t)(KW * w) * ldw + col;
        float v[KW]; float mx = 0.f;
#pragma unroll
        for (int k = 0; k < KW; ++k) v[k] = W[(size_t)k * ldw];
#pragma unroll
        for (int k = 0; k < KW; ++k) mx = fmaxf(mx, fabsf(v[k]));
        wmax[w * 64 + lane] = mx;
        __syncthreads();
        if (w == 0) { float m = wmax[lane];
#pragma unroll
            for (int j = 1; j < 8; ++j) m = fmaxf(m, wmax[j * 64 + lane]);
            swout[(size_t)e * nblk64 * 64 + nb2 * 64 + lane] = m * (1.0f / 127.0f); sinv[lane] = m > 0.f ? 127.0f / m : 0.f; }
        __syncthreads();
        const float iv = sinv[lane];
        unsigned char* drow = dst + ((size_t)e * nblk64 * 64 + (size_t)nb2 * 64 + lane) * K + KW * w;
#pragma unroll
        for (int q = 0; q < KW / 16; ++q) { u32x4 o;
            o.x = pk4_i8(v[16 * q], v[16 * q + 1], v[16 * q + 2], v[16 * q + 3], iv); o.y = pk4_i8(v[16 * q + 4], v[16 * q + 5], v[16 * q + 6], v[16 * q + 7], iv);
            o.z = pk4_i8(v[16 * q + 8], v[16 * q + 9], v[16 * q + 10], v[16 * q + 11], iv); o.w = pk4_i8(v[16 * q + 12], v[16 * q + 13], v[16 * q + 14], v[16 * q + 15], iv);
            *(u32x4*)(drow + 16 * q) = o; }
        __syncthreads();
    }
}
DI void conv_job_f8(Frame& F, const float* s1, unsigned char* dst, float* swout, int K, int ldw, int nblk64, int nexp) {
    LAS float* wmax = (LAS float*)(F.lds + 124 * 1024);
    LAS float* sinv = wmax + 512;
    const int lane = F.lane, w = F.wave, kw = K / NWAVES;
    for (int it = F.bid; it < nblk64 * nexp; it += F.G) {
        const int e = it / nblk64, nb2 = it - e * nblk64;
        const float* W = s1 + (size_t)e * K * ldw + (size_t)(kw * w) * ldw + 64 * nb2 + lane;
        float mx = 0.f;
#pragma unroll 16
        for (int k = 0; k < kw; ++k) mx = fmaxf(mx, fabsf(W[(size_t)k * ldw]));
        wmax[w * 64 + lane] = mx;
        __syncthreads();
        if (w == 0) { float m = wmax[lane];
#pragma unroll
            for (int j = 1; j < 8; ++j) m = fmaxf(m, wmax[j * 64 + lane]);
            swout[(size_t)e * nblk64 * 64 + nb2 * 64 + lane] = m * (1.0f / 256.0f); sinv[lane] = m > 0.f ? 256.0f / m : 0.f; }
        __syncthreads();
        const float iv = sinv[lane];
        unsigned char* drow = dst + ((size_t)e * nblk64 * 64 + (size_t)nb2 * 64 + lane) * K + kw * w;
        for (int k0 = 0; k0 < kw; k0 += 32) {
            float v[32];
#pragma unroll
            for (int k = 0; k < 32; ++k) v[k] = W[(size_t)(k0 + k) * ldw] * iv;
#pragma unroll
            for (int q = 0; q < 2; ++q) { u32x4 o; o.x = pk4_fp8(v[16 * q], v[16 * q + 1], v[16 * q + 2], v[16 * q + 3]); o.y = pk4_fp8(v[16 * q + 4], v[16 * q + 5], v[16 * q + 6], v[16 * q + 7]);
                o.z = pk4_fp8(v[16 * q + 8], v[16 * q + 9], v[16 * q + 10], v[16 * q + 11]); o.w = pk4_fp8(v[16 * q + 12], v[16 * q + 13], v[16 * q + 14], v[16 * q + 15]);
                *(u32x4*)(drow + k0 + 16 * q) = o; }
        }
        __syncthreads();
    }
}
DI void conv_layer(Frame& F, const ArgsRef& a, int L) {
    FRESH(F);
    bf16* Wb = (bf16*)(F.ws + WS_W);
    const int i = L >> 1;
    if ((L & 1) == 0) {
        conv_job<1>(F, a.in[3] + (size_t)i * D * INW, nullptr, (bf16*)((char*)Wb + W_IN), D, INW, INW / 64, 1);
        conv_job<0>(F, a.in[9] + (size_t)i * D * D, nullptr, (bf16*)((char*)Wb + W_OUT), D, D, D / 64, 1);
        conv_job_i8<2>(F, a.in[10] + (size_t)i * D * FF, a.in[11] + (size_t)i * D * FF, (unsigned char*)Wb + W_GU, (float*)(F.ws + WS_SW), FF, 2 * FF / 64, 1);
        conv_job_f8(F, a.in[12] + (size_t)i * FF * D, (unsigned char*)Wb + W_DN, (float*)(F.ws + WS_SWD), FF, D, D / 64, 1);
        const float* sw = a.in[5] + (size_t)i * 8 * 128 * 128; bf16* dw = (bf16*)(F.ws + WS_SGUW);
        for (int idx = F.bid * 512 + F.tid; idx < 8 * 128 * 128 / 4; idx += F.G * 512) { const f32x4 v = *(const f32x4*)(sw + 4 * idx); u32x2 o; o.x = pk2(v[0], v[1]); o.y = pk2(v[2], v[3]); *(u32x2*)(dw + 4 * idx) = o; }
    } else {
        conv_job<2>(F, a.in[21] + (size_t)i * D * D, a.in[22] + (size_t)i * D * D, (bf16*)((char*)Wb + W_GLU), D, D, 2 * D / 64, 1);
        conv_job_i8<2>(F, a.in[24] + (size_t)i * NE * D * FF, a.in[25] + (size_t)i * NE * D * FF, (unsigned char*)Wb + W_MGU, (float*)(F.ws + WS_SW), FF, 2 * FF / 64, NE);
        conv_job_f8(F, a.in[26] + (size_t)i * NE * FF * D, (unsigned char*)Wb + W_MDN, (float*)(F.ws + WS_SWD), FF, D, D / 64, NE);
    }
}

DI void prologue(Frame& F, const ArgsRef& a) {
    FRESH(F);
    const float* x = a.in[0]; bf16* XB = (bf16*)(F.ws + WS_XB);
    const size_t nthr = (size_t)F.G * 512, t0 = (size_t)F.bid * 512 + F.tid;
    for (size_t i = t0; i < (size_t)T * D / 8; i += nthr) { const f32x4 v0 = *(const f32x4*)(x + 8 * i), v1 = *(const f32x4*)(x + 8 * i + 4); *(u32x4*)(XB + 8 * i) = pg8::pack8(v0, v1); }
    float* cosT = (float*)(F.ws + WS_ROPE); float* sinT = cosT + SEQ * 32;
    for (size_t i = t0; i < (size_t)SEQ * 32; i += nthr) { const int pos = (int)(i >> 5), d = (int)(i & 31);
        const float invf = (float)exp_d(-(double)(2 * d) * (9.2103403719761836 / 64.0));
        const float ang = (float)pos * invf; double s, c; sincos_d((double)ang, s, c); cosT[i] = (float)c; sinT[i] = (float)s; }
}

DI void ln_core(f32x4 (&v)[4], const f32x4 (&g)[4], const f32x4 (&b)[4]) {
    float s = 0.f;
#pragma unroll
    for (int j = 0; j < 4; ++j) s += (v[j][0] + v[j][1]) + (v[j][2] + v[j][3]);
    const float mean = wave_sum(s) * (1.0f / D); float q = 0.f;
#pragma unroll
    for (int j = 0; j < 4; ++j) { v[j] = v[j] - mean; q += (v[j][0] * v[j][0] + v[j][1] * v[j][1]) + (v[j][2] * v[j][2] + v[j][3] * v[j][3]); }
    const float rstd = 1.0f / sqrtf(wave_sum(q) * (1.0f / D) + LN_EPS);
#pragma unroll
    for (int j = 0; j < 4; ++j) v[j] = v[j] * rstd * g[j] + b[j];
}
DI void ln_store(const f32x4 (&v)[4], bf16* XB, size_t row, int lane) {
#pragma unroll
    for (int j = 0; j < 4; ++j) { u32x2 o; o.x = pk2(v[j][0], v[j][1]); o.y = pk2(v[j][2], v[j][3]); *(u32x2*)(XB + row * D + 4 * lane + 256 * j) = o; }
}
DI void ln_load(f32x4 (&v)[4], const bf16* Y, size_t row, int lane) {
#pragma unroll
    for (int j = 0; j < 4; ++j) { const u32x2 yv = *(const u32x2*)(Y + row * D + 4 * lane + 256 * j); v[j] = (f32x4){bf_lo(yv.x), bf_hi(yv.x), bf_lo(yv.y), bf_hi(yv.y)}; }
}
DI void ln_pass_plain(Frame& F, const float* g_, const float* b_, const bool q8copy) {
    FRESH(F);
    const bf16* Y = (const bf16*)(F.ws + WS_Y); bf16* XB = (bf16*)(F.ws + WS_XB);
    f32x4 g[4], b[4];
#pragma unroll
    for (int j = 0; j < 4; ++j) { g[j] = *(const f32x4*)(g_ + 4 * F.lane + 256 * j); b[j] = *(const f32x4*)(b_ + 4 * F.lane + 256 * j); }
    const int gw = F.bid * NWAVES + F.wave, NGW = F.G * NWAVES;
    for (int row = gw; row < T; row += NGW) {
        f32x4 v[4]; ln_load(v, Y, (size_t)row, F.lane);
        ln_core(v, g, b);
        ln_store(v, XB, (size_t)row, F.lane);
        if (q8copy) {
            float mx = 0.f;
#pragma unroll
            for (int j = 0; j < 4; ++j) mx = fmaxf(mx, fmaxf(fmaxf(fabsf(v[j][0]), fabsf(v[j][1])), fmaxf(fabsf(v[j][2]), fabsf(v[j][3]))));
            mx = wave_max(mx);
            const float inv = mx > 0.f ? 127.0f / mx : 0.f;
            unsigned char* X8 = (unsigned char*)(F.ws + WS_XB8);
#pragma unroll
            for (int j = 0; j < 4; ++j) *(unsigned*)(X8 + (size_t)row * D + 4 * F.lane + 256 * j) = pk4_i8(v[j][0], v[j][1], v[j][2], v[j][3], inv);
            if (F.lane == 0) ((float*)(F.ws + WS_SX))[row] = mx * (1.0f / 127.0f);
        }
    }
}
DI void ln_pass_router(Frame& F, const float* g_, const float* b_, const float* rw_, unsigned* cnt, const size_t rec_off) {
    FRESH(F);
    const bf16* Y = (const bf16*)(F.ws + WS_Y); bf16* XB = (bf16*)(F.ws + WS_XB);
    i32x4* RECI = (i32x4*)(F.ws + WS_RECI + rec_off); f32x2* RECW = (f32x2*)(F.ws + WS_RECW + rec_off);
    LAS int* lcnt = (LAS int*)(F.lds); LAS int* lbase = lcnt + 8;
    LAS int* re0 = lcnt + 64; LAS int* re1 = re0 + 256; LAS int* rp0 = re1 + 256; LAS int* rp1 = rp0 + 256; LAS float* rw0 = (LAS float*)(rp1 + 256); LAS float* rw1 = rw0 + 256;
    f32x4 g[4], b[4];
#pragma unroll
    for (int j = 0; j < 4; ++j) { g[j] = *(const f32x4*)(g_ + 4 * F.lane + 256 * j); b[j] = *(const f32x4*)(b_ + 4 * F.lane + 256 * j); }
    f32x4 rwa[4][4], rwb[4][4];
#pragma unroll
    for (int j = 0; j < 4; ++j)
#pragma unroll
        for (int c = 0; c < 4; ++c) { const float* p = rw_ + (size_t)(4 * F.lane + 256 * j + c) * 8; rwa[j][c] = *(const f32x4*)p; rwb[j][c] = *(const f32x4*)(p + 4); }
    for (int pnl = F.bid; pnl < T / 256; pnl += F.G) {
        if (F.tid < 8) lcnt[F.tid] = 0;
        __syncthreads();
        for (int rr = 0; rr < 32; ++rr) {
            const int lr = F.wave + 8 * rr; const size_t row = (size_t)pnl * 256 + lr;
            f32x4 v[4]; ln_load(v, Y, row, F.lane);
            ln_core(v, g, b);
            ln_store(v, XB, row, F.lane);
            f32x4 la = {0.f, 0.f, 0.f, 0.f}, lb = {0.f, 0.f, 0.f, 0.f};
#pragma unroll
            for (int j = 0; j < 4; ++j)
#pragma unroll
                for (int c = 0; c < 4; ++c) { la += rwa[j][c] * v[j][c]; lb += rwb[j][c] * v[j][c]; }
            float lg[8];
#pragma unroll
            for (int e = 0; e < 4; ++e) { lg[e] = wave_sum(la[e]); lg[4 + e] = wave_sum(lb[e]); }
            int i0 = 0; float l0 = lg[0];
#pragma unroll
            for (int e = 1; e < 8; ++e) if (lg[e] > l0) { l0 = lg[e]; i0 = e; }
            int i1 = -1; float l1 = -3.0e38f;
#pragma unroll
            for (int e = 0; e < 8; ++e) if (e != i0 && lg[e] > l1) { l1 = lg[e]; i1 = e; }
            const float w0 = 1.0f / (1.0f + __expf(l1 - l0)), w1 = 1.0f - w0;
            if (F.lane == 0) { const int p0 = atomicAdd((int*)(lcnt + i0), 1), p1 = atomicAdd((int*)(lcnt + i1), 1);
                re0[lr] = i0; re1[lr] = i1; rp0[lr] = p0; rp1[lr] = p1; rw0[lr] = w0; rw1[lr] = w1; }
        }
        __syncthreads();
        if (F.tid < 8) lbase[F.tid] = (int)xb_add(cnt + F.tid, (unsigned)lcnt[F.tid]);
        __syncthreads();
        if (F.tid < 256) { const int e0 = re0[F.tid], e1 = re1[F.tid]; const size_t row = (size_t)pnl * 256 + F.tid;
            RECI[row] = (i32x4){e0, lbase[e0] + rp0[F.tid], e1, lbase[e1] + rp1[F.tid]}; RECW[row] = (f32x2){rw0[F.tid], rw1[F.tid]}; }
        __syncthreads();
    }
}
DI void moe_tiles(const unsigned* cnt, int (&tb)[9], int (&cn)[8]) {
    int acc = 0;
#pragma unroll
    for (int e = 0; e < 8; ++e) { cn[e] = __builtin_amdgcn_readfirstlane((int)__hip_atomic_load(cnt + e, __ATOMIC_RELAXED, __HIP_MEMORY_SCOPE_AGENT)); tb[e] = acc; acc += (cn[e] + 255) >> 8; }
    tb[8] = acc;
}
DI void moe_gather(Frame& F, const unsigned* cnt) {
    FRESH(F);
    int tb[9], cn[8]; moe_tiles(cnt, tb, cn);
    const bf16* XB = (const bf16*)(F.ws + WS_XB); unsigned char* XS = (unsigned char*)(F.ws + WS_XS); float* SXS = (float*)(F.ws + WS_SXS); const i32x4* RECI = (const i32x4*)(F.ws + WS_RECI);
    const int gw = F.bid * NWAVES + F.wave, NGW = F.G * NWAVES;
    for (int t = gw; t < T; t += NGW) {
        const i32x4 r = RECI[t];
        int b0 = 0, b1 = 0;
#pragma unroll
        for (int e = 0; e < 8; ++e) { b0 = (r[0] == e) ? tb[e] : b0; b1 = (r[2] == e) ? tb[e] : b1; }
        const size_t r0 = (size_t)b0 * 256 + r[1], r1 = (size_t)b1 * 256 + r[3];
        const u32x4 v0 = *(const u32x4*)(XB + (size_t)t * D + 8 * F.lane), v1 = *(const u32x4*)(XB + (size_t)t * D + 512 + 8 * F.lane);
        float f[16] = {bf_lo(v0.x), bf_hi(v0.x), bf_lo(v0.y), bf_hi(v0.y), bf_lo(v0.z), bf_hi(v0.z), bf_lo(v0.w), bf_hi(v0.w),
                       bf_lo(v1.x), bf_hi(v1.x), bf_lo(v1.y), bf_hi(v1.y), bf_lo(v1.z), bf_hi(v1.z), bf_lo(v1.w), bf_hi(v1.w)};
        float mx = 0.f;
#pragma unroll
        for (int k = 0; k < 16; ++k) mx = fmaxf(mx, fabsf(f[k]));
        mx = wave_max(mx);
        const float inv = mx > 0.f ? 127.0f / mx : 0.f, sc = mx * (1.0f / 127.0f);
        u32x2 q0, q1;
        q0.x = pk4_i8(f[0], f[1], f[2], f[3], inv); q0.y = pk4_i8(f[4], f[5], f[6], f[7], inv); q1.x = pk4_i8(f[8], f[9], f[10], f[11], inv); q1.y = pk4_i8(f[12], f[13], f[14], f[15], inv);
        *(u32x2*)(XS + r0 * D + 8 * F.lane) = q0; *(u32x2*)(XS + r0 * D + 512 + 8 * F.lane) = q1;
        *(u32x2*)(XS + r1 * D + 8 * F.lane) = q0; *(u32x2*)(XS + r1 * D + 512 + 8 * F.lane) = q1;
        if (F.lane == 0) { SXS[r0] = sc; SXS[r1] = sc; }
    }
#pragma unroll
    for (int e = 0; e < 8; ++e) { const int first = tb[e] * 256 + cn[e], last = tb[e + 1] * 256;
        for (int r = first + gw; r < last; r += NGW) { const u32x2 z = {0u, 0u}; *(u32x2*)(XS + (size_t)r * D + 8 * F.lane) = z; *(u32x2*)(XS + (size_t)r * D + 512 + 8 * F.lane) = z; if (F.lane == 0) SXS[r] = 0.f; } }
}
DI void ln_pass_combine(Frame& F, const float* g_, const float* b_, const unsigned* cnt, const bool final_, const bool dummy_) {
    FRESH(F);
    int tb[9], cn[8]; moe_tiles(cnt, tb, cn);
    const bf16* YS = (const bf16*)(F.ws + WS_YS); bf16* XB = (bf16*)(F.ws + WS_XB); float* X = (float*)F.out;
    const i32x4* RECI = (const i32x4*)(F.ws + WS_RECI); const f32x2* RECW = (const f32x2*)(F.ws + WS_RECW);
    f32x4 g[4], b[4];
#pragma unroll
    for (int j = 0; j < 4; ++j) { g[j] = *(const f32x4*)(g_ + 4 * F.lane + 256 * j); b[j] = *(const f32x4*)(b_ + 4 * F.lane + 256 * j); }
    const int gw = F.bid * NWAVES + F.wave, NGW = F.G * NWAVES;
    for (int row = gw; row < T; row += NGW) {
        const i32x4 r = RECI[row]; const f32x2 w = RECW[row];
        int b0 = 0, b1 = 0;
#pragma unroll
        for (int e = 0; e < 8; ++e) { b0 = (r[0] == e) ? tb[e] : b0; b1 = (r[2] == e) ? tb[e] : b1; }
        const size_t r0 = (size_t)b0 * 256 + r[1], r1 = (size_t)b1 * 256 + r[3];
        f32x4 v[4];
#pragma unroll
        for (int j = 0; j < 4; ++j) { const u32x2 xv = *(const u32x2*)(XB + (size_t)row * D + 4 * F.lane + 256 * j);
            const u32x2 ya = *(const u32x2*)(YS + r0 * D + 4 * F.lane + 256 * j), yb = *(const u32x2*)(YS + r1 * D + 4 * F.lane + 256 * j);
            v[j][0] = ALPHA * bf_lo(xv.x) + (w[0] * bf_lo(ya.x) + w[1] * bf_lo(yb.x)); v[j][1] = ALPHA * bf_hi(xv.x) + (w[0] * bf_hi(ya.x) + w[1] * bf_hi(yb.x));
            v[j][2] = ALPHA * bf_lo(xv.y) + (w[0] * bf_lo(ya.y) + w[1] * bf_lo(yb.y)); v[j][3] = ALPHA * bf_hi(xv.y) + (w[0] * bf_hi(ya.y) + w[1] * bf_hi(yb.y)); }
        ln_core(v, g, b);
        if (dummy_) ln_store(v, (bf16*)(F.ws + WS_XS), (size_t)row, F.lane);
        else if (final_) {
#pragma unroll
            for (int j = 0; j < 4; ++j) *(f32x4*)(X + (size_t)row * D + 4 * F.lane + 256 * j) = v[j];
        } else ln_store(v, XB, (size_t)row, F.lane);
    }
}

constexpr int KL_STRIDE = 144, VT_STRIDE = 776, VT_OFF = 384 * KL_STRIDE;
DI void attn_phase(Frame& F, const float* sink) {
    FRESH(F);
    const bf16* Q = (const bf16*)(F.ws + WS_Q); const bf16* Kb = (const bf16*)(F.ws + WS_K); const bf16* Vb = (const bf16*)(F.ws + WS_V); bf16* MIX = (bf16*)(F.ws + WS_MIX);
    LAS unsigned char* Kl = F.lds; LAS unsigned char* Vt = F.lds + VT_OFF;
    const int lane = F.lane, l31 = lane & 31, h = lane >> 5, w = F.wave;
    for (int unit = F.bid; unit < BATCH * 2 * 16; unit += F.G) {
        const int b = unit >> 5, kvh = (unit >> 4) & 1, n = unit & 15;
        __syncthreads();
        for (int idx = F.tid; idx < 384 * 8; idx += 512) {
            const int key = idx >> 3, ch = idx & 7, kp = (n - 1) * 128 + key;
            u32x4 kv = {0u, 0u, 0u, 0u}, vv = {0u, 0u, 0u, 0u};
            if (kp >= 0 && kp < SEQ) { const size_t off = (size_t)(b * SEQ + kp) * 128 + kvh * 64 + ch * 8; kv = *(const u32x4*)(Kb + off); vv = *(const u32x4*)(Vb + off); }
            *(LAS u32x4*)(Kl + key * KL_STRIDE + ch * 16) = kv;
            LAS unsigned short* vd = (LAS unsigned short*)(Vt + (ch * 8) * VT_STRIDE + key * 2);
            constexpr int RS = VT_STRIDE / 2;
            vd[0 * RS] = (unsigned short)(vv.x & 0xffffu); vd[1 * RS] = (unsigned short)(vv.x >> 16); vd[2 * RS] = (unsigned short)(vv.y & 0xffffu); vd[3 * RS] = (unsigned short)(vv.y >> 16);
            vd[4 * RS] = (unsigned short)(vv.z & 0xffffu); vd[5 * RS] = (unsigned short)(vv.z >> 16); vd[6 * RS] = (unsigned short)(vv.w & 0xffffu); vd[7 * RS] = (unsigned short)(vv.w >> 16);
        }
        __syncthreads();
        const int hq = kvh * 4 + (w >> 1);
        const float m0 = sink[hq] * LOG2E;
        for (int qb = 0; qb < 2; ++qb) {
            const int q0 = 64 * (w & 1) + 32 * qb;
            const size_t qrow = (size_t)(b * SEQ + n * 128 + q0 + l31);
            bf16x8 bq[4];
#pragma unroll
            for (int ks = 0; ks < 4; ++ks) bq[ks] = *(const bf16x8*)(Q + qrow * 512 + hq * 64 + 16 * ks + 8 * h);
            float m2 = m0, l = 1.0f;
            f32x16 O0, O1;
#pragma unroll
            for (int i = 0; i < 16; ++i) { O0[i] = 0.f; O1[i] = 0.f; }
            const int kt0 = q0 >> 5, qk = q0 + l31; const bool edge = (n == 0) || (n == 15);
            for (int kt = kt0; kt <= kt0 + 8; ++kt) {
                f32x16 X;
#pragma unroll
                for (int i = 0; i < 16; ++i) X[i] = 0.f;
#pragma unroll
                for (int ks = 0; ks < 4; ++ks) { const bf16x8 a = *(const LAS bf16x8*)(Kl + (32 * kt + l31) * KL_STRIDE + (16 * ks + 8 * h) * 2); X = MFMA32(a, bq[ks], X); }
                float mx = -1.0e30f;
                if (kt == kt0 || kt == kt0 + 8 || edge) {
#pragma unroll
                    for (int i = 0; i < 16; ++i) { const int kk = 32 * kt + crow(i, h); const int kp = (n - 1) * 128 + kk;
                        const bool valid = (kk >= qk) && (kk <= qk + 256) && (kp >= 0) && (kp < SEQ);
                        X[i] = valid ? X[i] : -1.0e30f; mx = fmaxf(mx, X[i]); }
                } else {
#pragma unroll
                    for (int i = 0; i < 16; ++i) mx = fmaxf(mx, X[i]);
                }
                mx = max_x32(mx);
                const float mn = fmaxf(m2, mx), alpha = fast_exp2(m2 - mn); m2 = mn;
                float ps = 0.f;
#pragma unroll
                for (int i = 0; i < 16; ++i) { X[i] = fast_exp2(X[i] - mn); ps += X[i]; }
                ps = sum_x32(ps);
                l = l * alpha + ps;
#pragma unroll
                for (int i = 0; i < 16; ++i) { O0[i] *= alpha; O1[i] *= alpha; }
#pragma unroll
                for (int s = 0; s < 2; ++s) {
                    u32x4 pw; pw.x = pk2(X[8 * s + 0], X[8 * s + 1]); pw.y = pk2(X[8 * s + 2], X[8 * s + 3]); pw.z = pk2(X[8 * s + 4], X[8 * s + 5]); pw.w = pk2(X[8 * s + 6], X[8 * s + 7]);
                    const bf16x8 pf = __builtin_bit_cast(bf16x8, pw);
                    const int kb = (32 * kt + 16 * s + 4 * h) * 2;
                    { const s16x4 lo = *(const LAS s16x4*)(Vt + l31 * VT_STRIDE + kb), hi = *(const LAS s16x4*)(Vt + l31 * VT_STRIDE + kb + 16);
                      O0 = MFMA32(__builtin_shufflevector(lo, hi, 0, 1, 2, 3, 4, 5, 6, 7), pf, O0); }
                    { const s16x4 lo = *(const LAS s16x4*)(Vt + (32 + l31) * VT_STRIDE + kb), hi = *(const LAS s16x4*)(Vt + (32 + l31) * VT_STRIDE + kb + 16);
                      O1 = MFMA32(__builtin_shufflevector(lo, hi, 0, 1, 2, 3, 4, 5, 6, 7), pf, O1); }
                }
            }
            const float inv = 1.0f / l;
            bf16* orow = MIX + qrow * D + hq * 64;
#pragma unroll
            for (int g4 = 0; g4 < 4; ++g4) {
                u32x2 o; o.x = pk2(O0[4 * g4] * inv, O0[4 * g4 + 1] * inv); o.y = pk2(O0[4 * g4 + 2] * inv, O0[4 * g4 + 3] * inv); *(u32x2*)(orow + 8 * g4 + 4 * h) = o;
                u32x2 p; p.x = pk2(O1[4 * g4] * inv, O1[4 * g4 + 1] * inv); p.y = pk2(O1[4 * g4 + 2] * inv, O1[4 * g4 + 3] * inv); *(u32x2*)(orow + 32 + 8 * g4 + 4 * h) = p;
            }
        }
    }
    __syncthreads();
}

constexpr int SG_STRIDE = 272;
DI void sgu_phase(Frame& F, const float* sgu_b) {
    FRESH(F);
    const bf16* ZU = (const bf16*)(F.ws + WS_ZU); const bf16* ZV = (const bf16*)(F.ws + WS_ZV); const bf16* Wsb = (const bf16*)(F.ws + WS_SGUW); bf16* MIX = (bf16*)(F.ws + WS_MIX);
    LAS unsigned char* VT = F.lds + F.wave * (32 * SG_STRIDE);
    const int lane = F.lane, l31 = lane & 31, h = lane >> 5;
    const int gw = F.bid * NWAVES + F.wave, NGW = F.G * NWAVES;
    for (int su = gw; su < BATCH * 16 * 8 * 2; su += NGW) {
        const int dh = su & 1, g = (su >> 1) & 7, n = (su >> 4) & 15, b = su >> 8;
        const size_t rowb = (size_t)(b * SEQ + n * 128);
#pragma unroll
        for (int i = 0; i < 8; ++i) { const int c = lane + 64 * i, q = c >> 2, ch = c & 3;
            const u32x4 vv = *(const u32x4*)(ZV + (rowb + q) * 512 + 64 * g + 32 * dh + 8 * ch);
            LAS unsigned short* vd = (LAS unsigned short*)(VT + (ch * 8) * SG_STRIDE + q * 2);
            constexpr int RS = SG_STRIDE / 2;
            vd[0 * RS] = (unsigned short)(vv.x & 0xffffu); vd[1 * RS] = (unsigned short)(vv.x >> 16); vd[2 * RS] = (unsigned short)(vv.y & 0xffffu); vd[3 * RS] = (unsigned short)(vv.y >> 16);
            vd[4 * RS] = (unsigned short)(vv.z & 0xffffu); vd[5 * RS] = (unsigned short)(vv.z >> 16); vd[6 * RS] = (unsigned short)(vv.w & 0xffffu); vd[7 * RS] = (unsigned short)(vv.w >> 16); }
        bf16x8 af[8];
#pragma unroll
        for (int ks = 0; ks < 8; ++ks) af[ks] = *(const LAS bf16x8*)(VT + l31 * SG_STRIDE + (16 * ks + 8 * h) * 2);
#pragma unroll
        for (int pt = 0; pt < 4; ++pt) {
            const int p = 32 * pt + l31;
            f32x16 acc;
#pragma unroll
            for (int i = 0; i < 16; ++i) acc[i] = 0.f;
#pragma unroll
            for (int ks = 0; ks < 8; ++ks) { const bf16x8 bw = *(const bf16x8*)(Wsb + ((size_t)g * 128 + p) * 128 + 16 * ks + 8 * h); acc = MFMA32(af[ks], bw, acc); }
            const float bias = sgu_b[g * 128 + p];
            const size_t row = rowb + p;
#pragma unroll
            for (int g4 = 0; g4 < 4; ++g4) { const int d = 32 * dh + 8 * g4 + 4 * h;
                const u32x2 uu = *(const u32x2*)(ZU + row * 512 + 64 * g + d);
                u32x2 o; o.x = pk2(bf_lo(uu.x) * (acc[4 * g4] + bias), bf_hi(uu.x) * (acc[4 * g4 + 1] + bias)); o.y = pk2(bf_lo(uu.y) * (acc[4 * g4 + 2] + bias), bf_hi(uu.y) * (acc[4 * g4 + 3] + bias));
                *(u32x2*)(MIX + row * D + 512 + 64 * g + d) = o; }
        }
        LDS_WAIT();
    }
}

constexpr int S5_STRIDE = 272;
DI void sincos_f(float th, float& s, float& c) {
    const float tq = th * 0.636619772367581f, q = rintf(tq), f = (tq - q) * 1.5707963267948966f, f2 = f * f;
    const float sp = f * (1.0f + f2 * (-1.6666667e-1f + f2 * (8.3333333e-3f + f2 * (-1.9841270e-4f + f2 * 2.7557319e-6f))));
    const float cp = 1.0f + f2 * (-0.5f + f2 * (4.1666667e-2f + f2 * (-1.3888889e-3f + f2 * (2.4801587e-5f + f2 * (-2.7557319e-7f)))));
    const int qi = ((int)q) & 3;
    s = (qi == 0) ? sp : (qi == 1) ? cp : (qi == 2) ? -sp : -cp;
    c = (qi == 0) ? cp : (qi == 1) ? -sp : (qi == 2) ? -cp : sp;
}
DI void zoh_params(float lr, float li, float logdt, float& br, float& bi, float& cr, float& ci) {
    const float dt = expf(logdt);
    const float ea = expf(lr * dt);
    float sn, cs; sincos_f(li * dt, sn, cs);
    br = ea * cs; bi = ea * sn;
    const float nr = br - 1.0f, rden = 1.0f / (lr * lr + li * li);
    cr = (nr * lr + bi * li) * rden; ci = (bi * lr - nr * li) * rden;
}
DI void s5_phase(Frame& F, const ArgsRef& a, int i) {
    FRESH(F);
    const bf16* XB = (const bf16*)(F.ws + WS_XB); bf16* YF = (bf16*)(F.ws + WS_YF);     bf16* YG = (bf16*)(F.ws + WS_YG);
    LAS unsigned char* xs = F.lds + F.wave * (32 * S5_STRIDE);
    const int lane = F.lane, l31 = lane & 31, h = lane >> 5, l15 = lane & 15, q4 = lane >> 4;
    const int gw = F.bid * NWAVES + F.wave, NGW = F.G * NWAVES;
    const bool fwdrow = (l31 & 4) == 0; const int slot = (l31 & 3) + 4 * (l31 >> 3);
    for (int unit = gw; unit < BATCH * 64; unit += NGW) {
        const int b = unit >> 6, g = unit & 63;
        const f32x4 dsk = *(const f32x4*)(a.in[20] + ((size_t)i * 64 + g) * 16 + 4 * q4);
        bf16x8 bfr[2][2][2]; float lbr[2], lbi[2];
#pragma unroll
        for (int dir = 0; dir < 2; ++dir) { const size_t pg = ((size_t)(i * 2 + dir) * 64 + g); const float logdt = a.in[15][pg];
#pragma unroll
            for (int ph = 0; ph < 2; ++ph) { const int pp = 32 * ph + l31; float tbr, tbi, tcr, tci;
                zoh_params(a.in[13][pg * 64 + pp], a.in[14][pg * 64 + pp], logdt, tbr, tbi, tcr, tci);
                if (dir == 0) { lbr[ph] = tbr; lbi[ph] = tbi; } else { lbr[ph] = h ? tbr : lbr[ph]; lbi[ph] = h ? tbi : lbi[ph]; }
                const float* brp = a.in[16] + (pg * 64 + pp) * 16 + 8 * h; const float* bip = a.in[17] + (pg * 64 + pp) * 16 + 8 * h;
                const f32x4 r0 = *(const f32x4*)brp, r1 = *(const f32x4*)(brp + 4), m0 = *(const f32x4*)bip, m1 = *(const f32x4*)(bip + 4);
                bfr[dir][ph][0] = __builtin_bit_cast(bf16x8, pg8::pack8(r0 * tcr - m0 * tci, r1 * tcr - m1 * tci));
                bfr[dir][ph][1] = __builtin_bit_cast(bf16x8, pg8::pack8(m0 * tcr + r0 * tci, m1 * tcr + r1 * tci)); } }
        bf16x8 cf[2][4];
#pragma unroll
        for (int dir = 0; dir < 2; ++dir) { const size_t pg = ((size_t)(i * 2 + dir) * 64 + g);
#pragma unroll
            for (int ks = 0; ks < 4; ++ks) { const size_t co = (pg * 16 + l15) * 64 + 16 * ks + 4 * q4;
                const f32x4 cre = *(const f32x4*)(a.in[18] + co), cim = *(const f32x4*)(a.in[19] + co);
                u32x4 wv; wv.x = pk2(cre[0], -cim[0]); wv.y = pk2(cre[1], -cim[1]); wv.z = pk2(cre[2], -cim[2]); wv.w = pk2(cre[3], -cim[3]);
                cf[dir][ks] = __builtin_bit_cast(bf16x8, wv); } }
        float xr[2] = {0.f, 0.f}, xi[2] = {0.f, 0.f};
        const size_t seq0 = (size_t)b * SEQ;
        bf16x8 au_n = *(const bf16x8*)(XB + (seq0 + (fwdrow ? slot : 16 * 127 + 15 - slot)) * D + 16 * g + 8 * h);
#pragma unroll 1
        for (int j = 0; j < 128; ++j) {
            const bf16x8 au = au_n;
            const size_t orow_f = seq0 + 16 * j + l15, orow_b = seq0 + 16 * (127 - j) + l15;
            const size_t oo_f = orow_f * D + 16 * g + 4 * q4, oo_b = orow_b * D + 16 * g + 4 * q4;
            u32x2 yfp[2], uup[2];
            if (j >= 64) { yfp[0] = *(const u32x2*)(YF + oo_f); yfp[1] = *(const u32x2*)(YF + oo_b); uup[0] = *(const u32x2*)(XB + oo_f); uup[1] = *(const u32x2*)(XB + oo_b); }
            else { yfp[0] = yfp[1] = (u32x2){0u, 0u}; uup[0] = uup[1] = (u32x2){0u, 0u}; }
            const bf16x8 zero8 = {0, 0, 0, 0, 0, 0, 0, 0};
            const bf16x8 a0 = fwdrow ? au : zero8, a1 = fwdrow ? zero8 : au;
            f32x16 z16;
#pragma unroll
            for (int k = 0; k < 16; ++k) z16[k] = 0.f;
            f32x16 P[2][2];
#pragma unroll
            for (int ph = 0; ph < 2; ++ph)
#pragma unroll
                for (int ri = 0; ri < 2; ++ri) { P[ph][ri] = MFMA32(a0, bfr[0][ph][ri], z16); P[ph][ri] = MFMA32(a1, bfr[1][ph][ri], P[ph][ri]); }
            __builtin_amdgcn_sched_barrier(0);
            { const int jn = (j < 127) ? j + 1 : j;
              au_n = *(const bf16x8*)(XB + (seq0 + (fwdrow ? 16 * jn + slot : 16 * (127 - jn) + 15 - slot)) * D + 16 * g + 8 * h); }
#pragma unroll
            for (int t = 0; t < 16; ++t) {
#pragma unroll
                for (int ph = 0; ph < 2; ++ph) {
                    const float t1 = __builtin_fmaf(-lbi[ph], xi[ph], P[ph][0][t]), t2 = __builtin_fmaf(lbi[ph], xr[ph], P[ph][1][t]);
                    xr[ph] = __builtin_fmaf(lbr[ph], xr[ph], t1); xi[ph] = __builtin_fmaf(lbr[ph], xi[ph], t2);
                    asm volatile("" : "+v"(xr[ph]), "+v"(xi[ph]));
                    *(LAS unsigned*)(xs + (16 * h + t) * S5_STRIDE + 4 * (32 * ph + l31)) = pk2(xr[ph], xi[ph]);
                }
            }
            f32x4 y4[2];
#pragma unroll
            for (int dd = 0; dd < 2; ++dd) {
                y4[dd] = (f32x4){0.f, 0.f, 0.f, 0.f};
                const int srow = dd ? 16 + (15 - l15) : l15;
#pragma unroll
                for (int ks = 0; ks < 4; ++ks) { const bf16x8 bx = *(const LAS bf16x8*)(xs + srow * S5_STRIDE + (32 * ks + 8 * q4) * 2); y4[dd] = MFMA16(cf[dd][ks], bx, y4[dd]); }
            }
            if (j < 64) { u32x2 p0, p1; p0.x = pk2(y4[0][0], y4[0][1]); p0.y = pk2(y4[0][2], y4[0][3]); p1.x = pk2(y4[1][0], y4[1][1]); p1.y = pk2(y4[1][2], y4[1][3]); *(u32x2*)(YF + oo_f) = p0; *(u32x2*)(YF + oo_b) = p1; }
            else {
#pragma unroll
                for (int dd = 0; dd < 2; ++dd) { const u32x2 uu = uup[dd];
                    const f32x4 uv = {bf_lo(uu.x), bf_hi(uu.x), bf_lo(uu.y), bf_hi(uu.y)};
                    const f32x4 yp = {bf_lo(yfp[dd].x), bf_hi(yfp[dd].x), bf_lo(yfp[dd].y), bf_hi(yfp[dd].y)};
                    const f32x4 y = yp + y4[dd] + dsk * uv;
                    u32x2 ov; ov.x = pk2(gelu_tanh(y[0]), gelu_tanh(y[1])); ov.y = pk2(gelu_tanh(y[2]), gelu_tanh(y[3])); *(u32x2*)(YG + (dd ? oo_b : oo_f)) = ov; }
            }
            { u32x4 t_ = __builtin_bit_cast(u32x4, au_n); asm volatile("" : "+v"(t_.x), "+v"(t_.y), "+v"(t_.z), "+v"(t_.w)); au_n = __builtin_bit_cast(bf16x8, t_); }
            LDS_WAIT();
        }
    }
}

__global__ void __launch_bounds__(NWAVES * 64, 2) fwd_kernel(Args args_by_value) {
    extern __shared__ __attribute__((aligned(16))) unsigned char lds[];
    Frame F;
    F.lds = (LAS unsigned char*)lds;
    F.MISC = (volatile LAS unsigned*)(F.lds + MISC_OFF);
    F.tid = threadIdx.x; F.lane = F.tid & 63; F.wave = __builtin_amdgcn_readfirstlane(F.tid >> 6);
    F.G = gridDim.x; F.bid = blockIdx.x;
    { kptr_t kp = (kptr_t)__builtin_amdgcn_kernarg_segment_ptr(); F.out = *(GASP float* const __attribute__((address_space(4)))*)(kp + 8 * 27); F.ws = *(GASP unsigned char* const __attribute__((address_space(4)))*)(kp + 8 * 28); }
    F.ctl = (unsigned*)(F.ws + WS_CTL);
    const ArgsRef args{};
    for (int u = F.tid; u < (LDS_BYTES - LDSCTL_OFF) / 4; u += NWAVES * 64) ((LAS unsigned*)(F.lds + LDSCTL_OFF))[u] = 0u;
    __syncthreads();
    XcdBarrier bar = xcd_barrier_post((GASP unsigned*)(F.ws + WS_CTL) + CW_BAR, F.MISC + 8, F.tid == 0);
#define GRID_BAR() xcd_barrier(bar, F.wave)
#define XB ((bf16*)(F.ws + WS_XB))
#define Yb ((bf16*)(F.ws + WS_Y))
#define Wb ((const char*)(F.ws + WS_W))
#define cosT ((const float*)(F.ws + WS_ROPE))
#define sinT ((const float*)(F.ws + WS_ROPE) + SEQ * 32)

    RPT(10) PH(0) prologue(F, args);
    RPT(4) PH(1) conv_layer(F, args, 0);
    GRID_BAR();

#pragma unroll 1
    for (int lp = 0; lp < 2; ++lp) {
        {
            const int L = 2 * lp, i = lp;
            { UFRESH(F); pg8::Order S{}; S.nM = T / 256; S.nN = INW / 256; S.nwg = S.nM * S.nN; S.G = F.G; S.c = F.bid; S.A = (const char*)XB; S.Bt = Wb + W_IN; S.tstep = (size_t)256 * D * 2; S.estride = 0;
              RPT(0) PH(2) { pg8::EpiWin E{(bf16*)(F.ws + WS_Q), (bf16*)(F.ws + WS_K), (bf16*)(F.ws + WS_V), (bf16*)(F.ws + WS_ZU), (bf16*)(F.ws + WS_ZV), cosT, sinT, args.in[7] + (size_t)i * 512, args.in[8] + (size_t)i * 512};
              pg8::gemm_phase(F.lds, D, S, E, F.wave); } }
            GRID_BAR();
            RPT(2) PH(3) attn_phase(F, args.in[4] + (size_t)i * 8);
            RPT(9) PH(4) sgu_phase(F, args.in[6] + (size_t)i * 8 * 128);
            GRID_BAR();
            { UFRESH(F); pg8::Order S{}; S.nM = T / 256; S.nN = D / 256; S.nwg = S.nM * S.nN; S.G = F.G; S.c = F.bid; S.A = (const char*)(F.ws + WS_MIX); S.Bt = Wb + W_OUT; S.tstep = (size_t)256 * D * 2; S.estride = 0;
              pg8::EpiPlain E{Yb, D, XB, nullptr};
              RPT(0) PH(10) pg8::gemm_phase(F.lds, D, S, E, F.wave); }
            GRID_BAR();
            RPT(5) PH(5) ln_pass_plain(F, args.in[1] + (size_t)(L * 2 + 0) * D, args.in[2] + (size_t)(L * 2 + 0) * D, true);
            GRID_BAR();
            { UFRESH(F); pg8::Order S{}; S.nM = T / 256; S.nN = 2 * FF / 256; S.nwg = S.nM * S.nN; S.G = F.G; S.c = F.bid; S.A = (const char*)(F.ws + WS_XB8); S.Bt = Wb + W_GU; S.tstep = (size_t)256 * D; S.estride = 0;
              pg8::EpiPairI8 E{(unsigned char*)(F.ws + WS_H), FF, (const float*)(F.ws + WS_SX), (const float*)(F.ws + WS_SW)};
              RPT(0) PH(11) pg8::gemm_phase<pg8::EpiPairI8, 1>(F.lds, D / 2, S, E, F.wave); }
            GRID_BAR();
            { UFRESH(F); pg8::Order S{}; S.nM = T / 256; S.nN = D / 256; S.nwg = S.nM * S.nN; S.G = F.G; S.c = F.bid; S.A = (const char*)(F.ws + WS_H); S.Bt = Wb + W_DN; S.tstep = (size_t)256 * FF; S.estride = 0;
              pg8::EpiPlain E{Yb, D, XB, (const float*)(F.ws + WS_SWD)};
              RPT(0) PH(10) pg8::gemm_phase<pg8::EpiPlain, 2>(F.lds, FF / 2, S, E, F.wave); }
            GRID_BAR();
            RPT(5) PH(5) ln_pass_plain(F, args.in[1] + (size_t)(L * 2 + 1) * D, args.in[2] + (size_t)(L * 2 + 1) * D, false);
            RPT(4) PH(1) conv_layer(F, args, L + 1);
            GRID_BAR();
        }
        {
            const int L = 2 * lp + 1, i = lp;
            unsigned* cnt = F.ctl + CW_CNT + 64 * i;
            RPT(3) PH(6) s5_phase(F, args, i);
            GRID_BAR();
            { UFRESH(F); pg8::Order S{}; S.nM = T / 256; S.nN = 2 * D / 256; S.nwg = S.nM * S.nN; S.G = F.G; S.c = F.bid; S.A = (const char*)(F.ws + WS_YG); S.Bt = Wb + W_GLU; S.tstep = (size_t)256 * D * 2; S.estride = 0;
              pg8::EpiPair<1> E{Yb, D, XB};
              RPT(0) PH(12) pg8::gemm_phase(F.lds, D, S, E, F.wave); }
            GRID_BAR();
            if ((RG >> 6) & 1) { PH(7) ln_pass_router(F, args.in[1] + (size_t)(L * 2 + 0) * D, args.in[2] + (size_t)(L * 2 + 0) * D, args.in[23] + (size_t)i * D * 8, cnt + 1024, WS_YS - WS_RECI); }
            PH(7) ln_pass_router(F, args.in[1] + (size_t)(L * 2 + 0) * D, args.in[2] + (size_t)(L * 2 + 0) * D, args.in[23] + (size_t)i * D * 8, cnt, 0);
            GRID_BAR();
            RPT(11) PH(8) moe_gather(F, cnt);
            GRID_BAR();
            {
                int tb[9], cn[8]; moe_tiles(cnt, tb, cn);
                const int ntt = tb[8], TC = 256, nch = (ntt + TC - 1) / TC;
RPT(1)
#pragma unroll 1
                for (int ch = 0; ch < nch; ++ch) {
                    const int t0 = ch * TC, t1 = (t0 + TC < ntt) ? t0 + TC : ntt, nM = (t1 > t0) ? t1 - t0 : 0;
                    { UFRESH(F); pg8::Order S{}; S.nM = nM; S.nN = 2 * FF / 256; S.nwg = S.nM * S.nN; S.G = F.G; S.c = F.bid; S.atile0 = t0; S.otile0 = 0; S.etile0 = t0;
                      S.A = (const char*)(F.ws + WS_XS); S.Bt = Wb + W_MGU; S.tstep = (size_t)256 * D; S.estride = (size_t)2 * FF * D;
#pragma unroll
                      for (int e = 0; e < 8; ++e) S.tb[e] = tb[e];
                      pg8::EpiPairI8 E{(unsigned char*)(F.ws + WS_HS), FF, (const float*)(F.ws + WS_SXS), (const float*)(F.ws + WS_SW)};
                      PH(13) pg8::gemm_phase<pg8::EpiPairI8, 1>(F.lds, D / 2, S, E, F.wave); }
                    GRID_BAR();
                    { UFRESH(F); pg8::Order S{}; S.nM = nM; S.nN = D / 256; S.nwg = S.nM * S.nN; S.G = F.G; S.c = F.bid; S.atile0 = 0; S.otile0 = t0; S.etile0 = t0;
                      S.A = (const char*)(F.ws + WS_HS); S.Bt = Wb + W_MDN; S.tstep = (size_t)256 * FF; S.estride = (size_t)D * FF;
#pragma unroll
                      for (int e = 0; e < 8; ++e) S.tb[e] = tb[e];
                      pg8::EpiPlain E{(bf16*)(F.ws + WS_YS), D, nullptr, (const float*)(F.ws + WS_SWD)};
                      PH(14) pg8::gemm_phase<pg8::EpiPlain, 2>(F.lds, FF / 2, S, E, F.wave); }
                    GRID_BAR();
                }
            }
            if ((RG >> 7) & 1) { PH(9) ln_pass_combine(F, args.in[1] + (size_t)(L * 2 + 1) * D, args.in[2] + (size_t)(L * 2 + 1) * D, cnt, L == 3, true); }
            PH(9) ln_pass_combine(F, args.in[1] + (size_t)(L * 2 + 1) * D, args.in[2] + (size_t)(L * 2 + 1) * D, cnt, L == 3, false);
            if (L + 1 < 4) { RPT(4) PH(1) conv_layer(F, args, L + 1); GRID_BAR(); }
        }
    }
}

extern "C" void kernel_launch(void* const* d_in, const int* in_sizes, int n_in, void* d_out, int out_size, void* d_ws, size_t ws_size, hipStream_t stream) {
    static int grid = 0;
    if (grid == 0) {
        if (n_in != 27 || in_sizes[0] != T * D || out_size != T * D || ws_size < WS_END) {
            fprintf(stderr, "kernel_launch: unexpected shapes (n_in %d, in0 %d, out %d, ws %zu; need ws >= %zu); nothing launched\n", n_in, n_in > 0 ? in_sizes[0] : -1, out_size, ws_size, (size_t)WS_END); grid = -1; return; }
        int dev = 0, cus = 0, per_cu = 0;
        if (hipGetDevice(&dev) != hipSuccess || hipDeviceGetAttribute(&cus, hipDeviceAttributeMultiprocessorCount, dev) != hipSuccess) { grid = -1; return; }
        if (hipFuncSetAttribute((const void*)fwd_kernel, hipFuncAttributeMaxDynamicSharedMemorySize, LDS_BYTES) != hipSuccess) { fprintf(stderr, "kernel_launch: hipFuncSetAttribute failed\n"); grid = -1; return; }
        if (hipOccupancyMaxActiveBlocksPerMultiprocessor(&per_cu, (const void*)fwd_kernel, NWAVES * 64, LDS_BYTES) != hipSuccess || per_cu < 1)
            fprintf(stderr, "kernel_launch: note: occupancy query reports %d workgroups per CU\n", per_cu);
        (void)hipGetLastError();
        grid = cus;
    }
    if (grid < 0) return;
    if (hipMemsetAsync((char*)d_ws + WS_CTL, 0, CTL_ZERO_BYTES, stream) != hipSuccess) return;
    Args a{};
    for (int i = 0; i < 27; ++i) a.in[i] = (const float*)d_in[i];
    a.out = (float*)d_out; a.ws = (unsigned char*)d_ws;
    hipLaunchKernelGGL(fwd_kernel, dim3(grid), dim3(NWAVES * 64), LDS_BYTES, stream, a);
}
```

```cpp
#include <hip/hip_runtime.h>
#include <cstdio>
#include <cstdint>

#define LAS __attribute__((address_space(3)))
typedef unsigned short bf16;
typedef short bf16x8 __attribute__((ext_vector_type(8)));
typedef short s16x4 __attribute__((ext_vector_type(4)));
typedef float f32x4 __attribute__((ext_vector_type(4)));
typedef float f32x2 __attribute__((ext_vector_type(2)));
typedef float f32x16 __attribute__((ext_vector_type(16)));
typedef unsigned u32x4 __attribute__((ext_vector_type(4)));
typedef unsigned u32x2 __attribute__((ext_vector_type(2)));
typedef int i32x4 __attribute__((ext_vector_type(4)));
typedef int i32x8 __attribute__((ext_vector_type(8)));
typedef short s16x16 __attribute__((ext_vector_type(16)));
typedef __bf16 bf2_t __attribute__((ext_vector_type(2)));
#define DI __device__ __forceinline__
#define GASP __attribute__((address_space(1)))
template <class T> DI T* as_global(T* p) { return (T*)(GASP T*)p; }
#ifndef PHM
#define PHM 0xFFFFF
#endif
#define PH(b) if (PHM & (1 << (b)))
#ifndef RG
#define RG 0
#endif
#define RPT(g) for (int rep_ = 0, nrep_ = rep_count(((RG) >> (g)) & 1); rep_ < nrep_; ++rep_)
#define UFRESH(F) do { asm volatile("" : "+s"((F).ws), "+s"((F).out), "+s"((F).G), "+s"((F).bid)); (F).ctl = (unsigned*)((F).ws + WS_CTL); } while (0)
#define FRESH(F) do { UFRESH(F); int l_ = lane_id(); asm volatile("" : "+v"(l_)); (F).lane = l_; (F).tid = (F).wave * 64 + l_; } while (0)

constexpr int NWAVES = 8;
constexpr int BATCH = 32, SEQ = 2048, D = 1024, T = BATCH * SEQ;
constexpr int INW = 1792, FF = 2816, NE = 8;
constexpr float ALPHA = 1.6817928305074290f;
constexpr float LN_EPS = 1e-5f;
constexpr float QSCALE = 0.18033688011112042f;
constexpr float LOG2E = 1.4426950408889634f;

constexpr size_t MiB = 1u << 20;
constexpr size_t WS_CTL = 0, CTL_ZERO_BYTES = 1 * MiB;
constexpr size_t WS_ROPE = 1 * MiB;
constexpr size_t WS_RECI = 2 * MiB;
constexpr size_t WS_RECW = 3 * MiB;
constexpr size_t WS_SGUW = 4 * MiB;
constexpr size_t WS_SX = 5 * MiB;
constexpr size_t WS_SW = 6 * MiB;
constexpr size_t WS_SWD = 9 * MiB;
constexpr size_t WS_SXS = 7 * MiB;
constexpr size_t WS_W = 16 * MiB;
constexpr size_t WS_XB = 156 * MiB;
constexpr size_t WS_Y = 284 * MiB;
constexpr size_t WS_R = 412 * MiB;
constexpr size_t WS_Q = WS_R, WS_K = WS_Q + 64 * MiB, WS_V = WS_K + 16 * MiB, WS_ZU = WS_V + 16 * MiB, WS_ZV = WS_ZU + 64 * MiB, WS_MIX = WS_ZV + 64 * MiB;
constexpr size_t WS_H = WS_R;
constexpr size_t WS_YF = WS_R;
constexpr size_t WS_YG = WS_R + 256 * MiB;
constexpr int XS_ROWS = 2 * T + NE * 256;
constexpr int TC_MAX = 264;
constexpr size_t WS_XB8 = 768 * MiB;
constexpr size_t WS_XS = 284 * MiB;
constexpr size_t WS_HS = 416 * MiB;
constexpr size_t WS_YS = 600 * MiB;
constexpr size_t WS_END = 860 * MiB;
constexpr size_t W_IN = 0, W_OUT = 4 * MiB, W_GU = 6 * MiB, W_DN = 17 * MiB;
constexpr size_t W_GLU = 0, W_MGU = 4 * MiB, W_MDN = 48 * MiB;
constexpr int CW_TMO = 0, CW_DBG = 2, CW_BAR = 4096, CW_CNT = 8192;
constexpr int CW_WMAX = 65536;

constexpr int RING_BYTES = 131072;
constexpr int LDSCTL_OFF = RING_BYTES, MISC_OFF = LDSCTL_OFF + 320;
constexpr int LDS_BYTES = 147456;

DI unsigned pk2(float lo, float hi) { f32x2 v = {lo, hi}; return __builtin_bit_cast(unsigned, __builtin_convertvector(v, bf2_t)); }
DI unsigned q8(float v, float inv) { return __float_as_uint(__builtin_fmaf(v, inv, 12582912.0f)) & 0xffu; }
DI unsigned pk4_i8(float a, float b, float c, float d, float inv) { return q8(a, inv) | (q8(b, inv) << 8) | (q8(c, inv) << 16) | (q8(d, inv) << 24); }
DI unsigned pk4_fp8(float a, float b, float c, float d) { int w = 0; w = __builtin_amdgcn_cvt_pk_fp8_f32(a, b, w, false); w = __builtin_amdgcn_cvt_pk_fp8_f32(c, d, w, true); return (unsigned)w; }
DI float bf_lo(unsigned w) { return __uint_as_float(w << 16); }
DI float bf_hi(unsigned w) { return __uint_as_float(w & 0xffff0000u); }
DI float fast_exp2(float x) { return __builtin_amdgcn_exp2f(x); }
DI float fast_rcp(float x) { return __builtin_amdgcn_rcpf(x); }
DI float sigmoidf_(float x) { return fast_rcp(1.0f + fast_exp2(-LOG2E * x)); }
DI float gelu_tanh(float x) { const float z = x + 0.044715f * x * x * x; return x * fast_rcp(1.0f + fast_exp2(-2.302208198f * z)); }
#define dpp_f(v, ctrl) __int_as_float(__builtin_amdgcn_mov_dpp(__float_as_int(v), (ctrl), 0xf, 0xf, true))
#define DPP_XOR1 0xB1
#define DPP_XOR2 0x4E
#define DPP_HMIRROR 0x141
#define DPP_MIRROR 0x140
DI float swz16_f(float v) { return __int_as_float(__builtin_amdgcn_ds_swizzle(__float_as_int(v), 0x401F)); }
DI float sum_x32(float v) { auto r = __builtin_amdgcn_permlane32_swap(__float_as_uint(v), __float_as_uint(v), false, false); return __uint_as_float(r[0]) + __uint_as_float(r[1]); }
DI float max_x32(float v) { auto r = __builtin_amdgcn_permlane32_swap(__float_as_uint(v), __float_as_uint(v), false, false); return fmaxf(__uint_as_float(r[0]), __uint_as_float(r[1])); }
DI float wave_max(float v) {
    v = fmaxf(v, dpp_f(v, DPP_XOR1)); v = fmaxf(v, dpp_f(v, DPP_XOR2)); v = fmaxf(v, dpp_f(v, DPP_HMIRROR)); v = fmaxf(v, dpp_f(v, DPP_MIRROR)); v = fmaxf(v, swz16_f(v)); return max_x32(v);
}
DI float wave_sum(float v) {
    v += dpp_f(v, DPP_XOR1); v += dpp_f(v, DPP_XOR2); v += dpp_f(v, DPP_HMIRROR); v += dpp_f(v, DPP_MIRROR); v += swz16_f(v); return sum_x32(v);
}
#define LDS_WAIT() asm volatile("s_waitcnt lgkmcnt(0)" ::: "memory")
#define VM_WAIT() asm volatile("s_waitcnt vmcnt(0)" ::: "memory")
DI int lane_id() { unsigned ones = ~0u; asm volatile("" : "+s"(ones)); return (int)__builtin_amdgcn_mbcnt_hi(ones, __builtin_amdgcn_mbcnt_lo(ones, 0u)); }
DI int rep_count(int extra) { int n = 1 + extra; asm volatile("" : "+s"(n)); return n; }
DI int crow(int reg, int h) { return (reg & 3) + 8 * (reg >> 2) + 4 * h; }
#define MFMA32(a, b, c) __builtin_amdgcn_mfma_f32_32x32x16_bf16((a), (b), (c), 0, 0, 0)
#define MFMA16(a, b, c) __builtin_amdgcn_mfma_f32_16x16x32_bf16((a), (b), (c), 0, 0, 0)

DI void sincos_d(double th, double& s, double& c) {
    const double tq = th * 0.63661977236758134308;
    const double q = rint(tq);
    const double f = (tq - q) * 1.57079632679489661923;
    const double f2 = f * f;
    const double sp = f * (1.0 + f2 * (-1.0 / 6 + f2 * (1.0 / 120 + f2 * (-1.0 / 5040 + f2 * (1.0 / 362880 + f2 * (-1.0 / 39916800 + f2 * (1.0 / 6227020800.0)))))));
    const double cp = 1.0 + f2 * (-0.5 + f2 * (1.0 / 24 + f2 * (-1.0 / 720 + f2 * (1.0 / 40320 + f2 * (-1.0 / 3628800 + f2 * (1.0 / 479001600.0 + f2 * (-1.0 / 87178291200.0)))))));
    const int qi = ((int)q) & 3;
    s = (qi == 0) ? sp : (qi == 1) ? cp : (qi == 2) ? -sp : -cp;
    c = (qi == 0) ? cp : (qi == 1) ? -sp : (qi == 2) ? -cp : sp;
}
DI double exp_d(double x) {
    const double n = rint(x * 1.4426950408889634074);
    const double r = x - n * 0.69314718055994530942;
    double p = 1.0 / 87178291200.0;
    p = p * r + 1.0 / 6227020800.0; p = p * r + 1.0 / 479001600.0; p = p * r + 1.0 / 39916800.0; p = p * r + 1.0 / 3628800.0; p = p * r + 1.0 / 362880.0;
    p = p * r + 1.0 / 40320.0; p = p * r + 1.0 / 5040.0; p = p * r + 1.0 / 720.0; p = p * r + 1.0 / 120.0; p = p * r + 1.0 / 24.0; p = p * r + 1.0 / 6.0; p = p * r + 0.5; p = p * r + 1.0; p = p * r + 1.0;
    const long long bits = (long long)((int)n + 1023) << 52;
    return p * __builtin_bit_cast(double, bits);
}

namespace pg8 {
constexpr int BM = 256, BK = 64, HALF = 128, HTB = HALF * BK * 2, STAGE_BYTES = 8 * HTB, NXCD = 8, WGM = 8;
DI int lds_byte(int r, int c) { const int st = (r >> 4) * 2 + (c >> 5), rr = r & 15, cc = c & 31, ob = rr * 64 + cc * 2; return st * 1024 + (ob ^ (((ob >> 9) & 1) << 5)); }
DI void stage_rc(int b, int& R, int& C) { const int st = b / 1024, sb = b % 1024, swz = sb ^ (((sb >> 9) & 1) << 5); R = (st >> 1) * 16 + swz / 64; C = (st & 1) * 32 + (swz % 64) / 2; }
DI int perm32(int rho) { const int n = rho >> 4, i = rho & 15; return 8 * (i >> 2) + 4 * n + (i & 3); }

struct Unit { int pm, pn, row0, arow0, e; const char* a; const char* b; };
struct Order {
    int nM, nN, nwg, G, c, atile0, otile0, etile0;
    const char* A; const char* Bt; size_t tstep, estride;
    int tb[8];
    DI bool next(int i, Unit& u) const {
        const long L = (long)i * G + c; if (L >= nwg) return false;
        int wgid = (int)L; { const int q = nwg / NXCD, r = nwg % NXCD, xcd = wgid % NXCD, off = wgid / NXCD; wgid = (xcd < r ? xcd * (q + 1) : r * (q + 1) + (xcd - r) * q) + off; }
        const int nig = WGM * nN, gid = wgid / nig, fm = gid * WGM, gsz = (nM - fm) < WGM ? (nM - fm) : WGM;
        u.pm = fm + ((wgid % nig) % gsz); u.pn = (wgid % nig) / gsz;
        u.row0 = (otile0 + u.pm) * BM;
        int e = 0;
        if (estride) { const int t = etile0 + u.pm;
#pragma unroll
            for (int j = 1; j < 8; ++j) e += (t >= tb[j]) ? 1 : 0; }
        u.e = e; u.arow0 = (atile0 + u.pm) * BM;
        u.a = A + (size_t)(atile0 + u.pm) * tstep; u.b = Bt + (size_t)e * estride + (size_t)u.pn * tstep;
        return true;
    }
};

template <class Epi, int MODE = 0>
DI void gemm_phase(LAS unsigned char* lds, const int K, const Order& S, const Epi& E, const int wid) {
    int lane = lane_id(); asm volatile("" : "+v"(lane));
    const int tid = wid * 64 + lane, wr = wid >> 2, wc = wid & 3, fr = lane & 15, fq = lane >> 4;
    const int nt = K / BK;
    unsigned voffA[2], voffB[2];
#pragma unroll
    for (int i = 0; i < 2; ++i) { int R, C; stage_rc(tid * 16 + i * 8192, R, C); const int Rb = (R & ~31) + perm32(R & 31);
        voffA[i] = (unsigned)(R * K + C) * 2u; voffB[i] = (unsigned)(Rb * K + C) * 2u; }
    const size_t kstep = (size_t)(BK * 2);
    const size_t hstep = (size_t)HALF * K * 2;
    const unsigned ldsw = (unsigned)wid * 1024u;
    constexpr bool I8 = (MODE == 1), F8 = (MODE == 2);
    const int aoff = F8 ? lds_byte(wr * 64 + fr, 32 * (fq >> 1) + 16 * (fq & 1)) : lds_byte(wr * 64 + fr, fq * 8), boff = F8 ? lds_byte(wc * 32 + fr, 32 * (fq >> 1) + 16 * (fq & 1)) : lds_byte(wc * 32 + fr, fq * 8);
#define PG8_SA(b, h) (((b) * 2 + (h)) * HTB)
#define PG8_SB(b, h) ((4 + (b) * 2 + (h)) * HTB)
#define PG8_STAGE(bufoff, gbase, voff) do { _Pragma("unroll") for (int _i = 0; _i < 2; ++_i) \
        __builtin_amdgcn_global_load_lds((const unsigned*)((const char*)(gbase) + (voff)[_i]), (LAS unsigned*)(lds + (bufoff) + ldsw + _i * 8192), 16, 0, 0); } while (0)
#define PG8_LDA(dst, b, h) do { _Pragma("unroll") for (int m = 0; m < 4; ++m) { if constexpr (F8) dst##8[m] = __builtin_bit_cast(i32x8, __builtin_shufflevector(*(const LAS bf16x8*)(lds + PG8_SA(b, h) + aoff + m * 2048), *(const LAS bf16x8*)(lds + PG8_SA(b, h) + aoff + m * 2048 + 16), 0, 1, 2, 3, 4, 5, 6, 7, 8, 9, 10, 11, 12, 13, 14, 15)); \
        else { _Pragma("unroll") for (int k = 0; k < 2; ++k) dst[m][k] = *(const LAS bf16x8*)(lds + PG8_SA(b, h) + aoff + m * 2048 + k * 1024); } } } while (0)
#define PG8_LDB(dst, b, h) do { _Pragma("unroll") for (int n = 0; n < 2; ++n) { if constexpr (F8) dst##8[n] = __builtin_bit_cast(i32x8, __builtin_shufflevector(*(const LAS bf16x8*)(lds + PG8_SB(b, h) + boff + n * 2048), *(const LAS bf16x8*)(lds + PG8_SB(b, h) + boff + n * 2048 + 16), 0, 1, 2, 3, 4, 5, 6, 7, 8, 9, 10, 11, 12, 13, 14, 15)); \
        else { _Pragma("unroll") for (int k = 0; k < 2; ++k) dst[n][k] = *(const LAS bf16x8*)(lds + PG8_SB(b, h) + boff + n * 2048 + k * 1024); } } } while (0)
#define PG8_MMA(ai, bj, At, Bt) do { __builtin_amdgcn_s_setprio(1); _Pragma("unroll") for (int m = 0; m < 4; ++m) _Pragma("unroll") for (int n = 0; n < 2; ++n) { \
        if constexpr (F8) asm volatile("v_mfma_scale_f32_16x16x128_f8f6f4 %0, %1, %2, %0, %3, %3 op_sel_hi:[0,0,0]" : "+v"(acc[ai][bj][m][n]) : "v"(Bt##8[n]), "v"(At##8[m]), "v"(scale1)); \
        else { _Pragma("unroll") for (int k = 0; k < 2; ++k) \
        { if constexpr (I8) acc[ai][bj][m][n] = __builtin_bit_cast(f32x4, __builtin_amdgcn_mfma_i32_16x16x64_i8(__builtin_bit_cast(i32x4, Bt[n][k]), __builtin_bit_cast(i32x4, At[m][k]), __builtin_bit_cast(i32x4, acc[ai][bj][m][n]), 0, 0, 0)); \
          else acc[ai][bj][m][n] = __builtin_amdgcn_mfma_f32_16x16x32_bf16(Bt[n][k], At[m][k], acc[ai][bj][m][n], 0, 0, 0); } } } __builtin_amdgcn_s_setprio(0); } while (0)
#define PG8_WAIT_V(n) asm volatile("s_waitcnt vmcnt(" #n ")" ::: "memory")
#define PG8_WAIT_L(n) asm volatile("s_waitcnt lgkmcnt(" #n ")" ::: "memory")
#define PG8_BAR __builtin_amdgcn_s_barrier()
#define PG8_SCHED __builtin_amdgcn_sched_barrier(0)
    Unit cur, nxt; int ui = 0;
    if (!S.next(0, cur)) return;
    f32x4 acc[2][2][4][2];
#pragma unroll
    for (int a = 0; a < 2; ++a)
#pragma unroll
        for (int b = 0; b < 2; ++b)
#pragma unroll
            for (int m = 0; m < 4; ++m)
#pragma unroll
                for (int n = 0; n < 2; ++n) acc[a][b][m][n] = (f32x4){0.f, 0.f, 0.f, 0.f};
    const int scale1 = 0x7F7F7F7F;
    bf16x8 At[4][2], B0[2][2], B1[2][2]; i32x8 At8[4], B08[2], B18[2];
    const char* cA = cur.a; const char* cB = cur.b;
    PG8_STAGE(PG8_SB(0, 0), cB, voffB); PG8_STAGE(PG8_SB(0, 1), cB + hstep, voffB); PG8_STAGE(PG8_SA(0, 0), cA, voffA); PG8_STAGE(PG8_SA(0, 1), cA + hstep, voffA);
    if (wr == 1) PG8_BAR;
    PG8_WAIT_V(2); PG8_BAR;
    PG8_STAGE(PG8_SB(1, 0), cB + kstep, voffB); PG8_STAGE(PG8_SA(1, 0), cA + kstep, voffA); PG8_STAGE(PG8_SB(1, 1), cB + hstep + kstep, voffB);
    PG8_WAIT_V(6); PG8_BAR;
    for (;;) {
        const bool has_next = S.next(ui + 1, nxt);
        const char* nA = has_next ? nxt.a : cA; const char* nB = has_next ? nxt.b : cB;
#pragma unroll 1
        for (int t = 0; t < nt; t += 2) {
            const bool last = (t == nt - 2);
            const char* a1 = cA + (size_t)(t + 1) * kstep;
            const char* a2 = last ? nA : cA + (size_t)(t + 2) * kstep; const char* b2 = last ? nB : cB + (size_t)(t + 2) * kstep;
            const char* a3 = a2 + kstep; const char* b3 = b2 + kstep;
            PG8_LDB(B0, 0, 0); PG8_LDB(B1, 0, 1); PG8_SCHED; PG8_LDA(At, 0, 0); PG8_STAGE(PG8_SA(1, 1), a1 + hstep, voffA);
            PG8_WAIT_V(8); PG8_WAIT_L(0); PG8_BAR; PG8_MMA(0, 0, At, B0); PG8_MMA(0, 1, At, B1); PG8_BAR; PG8_SCHED;
            PG8_LDA(At, 0, 1); PG8_STAGE(PG8_SB(0, 0), b2, voffB); PG8_STAGE(PG8_SB(0, 1), b2 + hstep, voffB); PG8_STAGE(PG8_SA(0, 0), a2, voffA);
            PG8_WAIT_V(8); PG8_WAIT_L(0); PG8_BAR; PG8_MMA(1, 0, At, B0); PG8_MMA(1, 1, At, B1); PG8_BAR; PG8_SCHED;
            PG8_LDB(B0, 1, 0); PG8_LDB(B1, 1, 1); PG8_SCHED; PG8_LDA(At, 1, 0); PG8_STAGE(PG8_SA(0, 1), a2 + hstep, voffA);
            PG8_WAIT_V(8); PG8_WAIT_L(0); PG8_BAR; PG8_MMA(0, 0, At, B0); PG8_MMA(0, 1, At, B1); PG8_BAR; PG8_SCHED;
            PG8_LDA(At, 1, 1); PG8_STAGE(PG8_SB(1, 0), b3, voffB); PG8_STAGE(PG8_SB(1, 1), b3 + hstep, voffB); PG8_STAGE(PG8_SA(1, 0), a3, voffA);
            PG8_WAIT_V(8); PG8_WAIT_L(0); PG8_BAR; PG8_MMA(1, 0, At, B0); PG8_MMA(1, 1, At, B1); PG8_BAR; PG8_SCHED;
        }
        if (wr == 0) PG8_BAR;
        if constexpr (F8) asm volatile("s_nop 15\n\ts_nop 7" ::: "memory");
        E(acc, cur, wr, wc, fr, fq);
        if (!has_next) break;
#pragma unroll
        for (int a = 0; a < 2; ++a)
#pragma unroll
            for (int b = 0; b < 2; ++b)
#pragma unroll
                for (int m = 0; m < 4; ++m)
#pragma unroll
                    for (int n = 0; n < 2; ++n) acc[a][b][m][n] = (f32x4){0.f, 0.f, 0.f, 0.f};
        cur = nxt; cA = nA; cB = nB; ++ui;
        if (wr == 1) PG8_BAR;
    }
    PG8_WAIT_V(0);
    PG8_BAR;
#undef PG8_SA
#undef PG8_SB
#undef PG8_STAGE
#undef PG8_LDA
#undef PG8_LDB
#undef PG8_MMA
#undef PG8_WAIT_V
#undef PG8_WAIT_L
#undef PG8_BAR
#undef PG8_SCHED
}

DI u32x4 pack8(const f32x4 a, const f32x4 b) { u32x4 w; w.x = pk2(a[0], a[1]); w.y = pk2(a[2], a[3]); w.z = pk2(b[0], b[1]); w.w = pk2(b[2], b[3]); return w; }

DI f32x4 bfx4_lo(const u32x4 w) { return (f32x4){bf_lo(w.x), bf_hi(w.x), bf_lo(w.y), bf_hi(w.y)}; }
DI f32x4 bfx4_hi(const u32x4 w) { return (f32x4){bf_lo(w.z), bf_hi(w.z), bf_lo(w.w), bf_hi(w.w)}; }
struct EpiPlain {
    bf16* O; int ldc; const bf16* R; const float* swd;
    DI void operator()(const f32x4 (&acc)[2][2][4][2], const Unit& u, int wr, int wc, int fr, int fq) const {
        asm volatile("" : "+v"(fr), "+v"(fq));
        const int row0 = u.row0 + wr * 64 + fr, col0 = u.pn * BM + wc * 32 + 8 * fq;
        f32x4 cs[2][2];
#pragma unroll
        for (int bj = 0; bj < 2; ++bj)
#pragma unroll
            for (int n = 0; n < 2; ++n) cs[bj][n] = swd ? *(const f32x4*)(swd + (size_t)u.e * D + col0 + bj * HALF + 4 * n) : (f32x4){1.f, 1.f, 1.f, 1.f};
#define ACS(ai, bj, m, n) (acc[ai][bj][m][n] * cs[bj][n])
        if (R) {
#pragma unroll
            for (int hb = 0; hb < 2; ++hb) {
                u32x4 r0[4], r1[4];
#pragma unroll
                for (int m = 0; m < 4; ++m) { const size_t off = (size_t)(row0 + hb * HALF + m * 16) * ldc + col0; r0[m] = *(const u32x4*)(R + off); r1[m] = *(const u32x4*)(R + off + HALF); }
                asm volatile("" ::: "memory");
#pragma unroll
                for (int m = 0; m < 4; ++m) { const int ai = hb; const size_t off = (size_t)(row0 + ai * HALF + m * 16) * ldc + col0;
                    *(u32x4*)(O + off) = pack8(ACS(ai, 0, m, 0) + bfx4_lo(r0[m]) * ALPHA, ACS(ai, 0, m, 1) + bfx4_hi(r0[m]) * ALPHA);
                    *(u32x4*)(O + off + HALF) = pack8(ACS(ai, 1, m, 0) + bfx4_lo(r1[m]) * ALPHA, ACS(ai, 1, m, 1) + bfx4_hi(r1[m]) * ALPHA); }
                asm volatile("" ::: "memory");
            }
        } else {
#pragma unroll
            for (int ai = 0; ai < 2; ++ai)
#pragma unroll
                for (int m = 0; m < 4; ++m) { const size_t off = (size_t)(row0 + ai * HALF + m * 16) * ldc + col0;
#pragma unroll
                    for (int bj = 0; bj < 2; ++bj) *(u32x4*)(O + off + bj * HALF) = pack8(ACS(ai, bj, m, 0), ACS(ai, bj, m, 1)); }
        }
    }
#undef ACS
};
template <int ACT> struct EpiPair {
    bf16* O; int ldc; const bf16* R;
    DI void operator()(const f32x4 (&acc)[2][2][4][2], const Unit& u, int wr, int wc, int fr, int fq) const {
        asm volatile("" : "+v"(fr), "+v"(fq));
        const int row0 = u.row0 + wr * 64 + fr, col0 = u.pn * HALF + wc * 32 + 8 * fq;
        u32x4 r[8];
#pragma unroll
        for (int g = 0; g < 8; ++g) { r[g] = (u32x4){0u, 0u, 0u, 0u}; if (R) r[g] = *(const u32x4*)(R + (size_t)(row0 + (g >> 2) * HALF + (g & 3) * 16) * ldc + col0); }
        if (R) asm volatile("" ::: "memory");
#pragma unroll
        for (int g = 0; g < 8; ++g) { const int ai = g >> 2, m = g & 3;
            const size_t off = (size_t)(row0 + ai * HALF + m * 16) * ldc + col0;
            f32x4 o[2];
            if (R) { o[0] = bfx4_lo(r[g]) * ALPHA; o[1] = bfx4_hi(r[g]) * ALPHA; } else { o[0] = (f32x4){0.f, 0.f, 0.f, 0.f}; o[1] = o[0]; }
#pragma unroll
            for (int n = 0; n < 2; ++n) { const f32x4 a = acc[ai][0][m][n], b = acc[ai][1][m][n];
#pragma unroll
                for (int j = 0; j < 4; ++j) o[n][j] += (ACT == 0) ? a[j] * sigmoidf_(a[j]) * b[j] : a[j] * sigmoidf_(b[j]); }
            *(u32x4*)(O + off) = pack8(o[0], o[1]); }
    }
};
struct EpiPairI8 {
    unsigned char* O;     int ldc; const float* sx; const float* sw;
    DI void operator()(const f32x4 (&acc)[2][2][4][2], const Unit& u, int wr, int wc, int fr, int fq) const {
        asm volatile("" : "+v"(fr), "+v"(fq));
        const int rloc = wr * 64 + fr, col0 = u.pn * HALF + wc * 32 + 8 * fq;
        const float* swp = sw + (size_t)u.e * (2 * FF) + u.pn * BM + wc * 32 + 8 * fq;
        f32x4 sg[2], su[2];
#pragma unroll
        for (int n = 0; n < 2; ++n) { sg[n] = *(const f32x4*)(swp + 4 * n); su[n] = *(const f32x4*)(swp + HALF + 4 * n); }
        float srv[8];
#pragma unroll
        for (int g = 0; g < 8; ++g) srv[g] = sx[u.arow0 + rloc + (g >> 2) * HALF + (g & 3) * 16];
#pragma unroll
        for (int ai = 0; ai < 2; ++ai)
#pragma unroll
            for (int m = 0; m < 4; ++m) {
                const int rr = rloc + ai * HALF + m * 16;
                const float sr = srv[ai * 4 + m];
                f32x4 o[2];
#pragma unroll
                for (int n = 0; n < 2; ++n) {
                    const f32x4 a = __builtin_convertvector(__builtin_bit_cast(i32x4, acc[ai][0][m][n]), f32x4) * (sg[n] * sr);
                    const f32x4 b = __builtin_convertvector(__builtin_bit_cast(i32x4, acc[ai][1][m][n]), f32x4) * (su[n] * sr);
                    const f32x4 t = a * (-LOG2E);
                    f32x4 e; e[0] = fast_exp2(t[0]); e[1] = fast_exp2(t[1]); e[2] = fast_exp2(t[2]); e[3] = fast_exp2(t[3]);
                    e = e + 1.0f;
                    f32x4 r; r[0] = fast_rcp(e[0]); r[1] = fast_rcp(e[1]); r[2] = fast_rcp(e[2]); r[3] = fast_rcp(e[3]);
                    o[n] = (a * r) * b; }
                u32x2 w8; w8.x = pk4_fp8(o[0][0], o[0][1], o[0][2], o[0][3]); w8.y = pk4_fp8(o[1][0], o[1][1], o[1][2], o[1][3]);
                *(u32x2*)(O + (size_t)(u.row0 + rr) * ldc + col0) = w8;
                asm volatile("" ::: "memory"); }
    }
};
struct EpiWin {
    bf16 *Q, *Kb, *Vb, *ZU, *ZV; const float *cosT, *sinT, *lng, *lnb;
    DI void operator()(const f32x4 (&acc)[2][2][4][2], const Unit& u, int wr, int wc, int fr, int fq) const {
        asm volatile("" : "+v"(fr), "+v"(fq));
        const int rbase = u.row0 + wr * 64 + fr, pn = u.pn;
        if (pn < 2 || (pn == 2 && wc < 2)) {
            bf16* dst; int ld, colb; float sc;
            if (pn < 2) { dst = Q; ld = 512; colb = 64 * (4 * pn + wc); sc = QSCALE; } else { dst = Kb; ld = 128; colb = 64 * wc; sc = 1.0f; }
#pragma unroll
            for (int hb = 0; hb < 2; ++hb) {
                f32x4 cc[4][2], ss[4][2];
#pragma unroll
                for (int m = 0; m < 4; ++m) { const int pos = (rbase + hb * HALF + m * 16) & (SEQ - 1);
#pragma unroll
                    for (int n = 0; n < 2; ++n) { cc[m][n] = *(const f32x4*)(cosT + pos * 32 + 8 * fq + 4 * n); ss[m][n] = *(const f32x4*)(sinT + pos * 32 + 8 * fq + 4 * n); } }
                asm volatile("" ::: "memory");
#pragma unroll
                for (int m = 0; m < 4; ++m) { const int ai = hb; const int row = rbase + ai * HALF + m * 16;
                    f32x4 o1[2], o2[2];
#pragma unroll
                    for (int n = 0; n < 2; ++n) { const f32x4 x1 = acc[ai][0][m][n], x2 = acc[ai][1][m][n];
                        o1[n] = (x1 * cc[m][n] - x2 * ss[m][n]) * sc; o2[n] = (x2 * cc[m][n] + x1 * ss[m][n]) * sc; }
                    bf16* rp = dst + (size_t)row * ld + colb + 8 * fq;
                    *(u32x4*)(rp) = pack8(o1[0], o1[1]); *(u32x4*)(rp + 32) = pack8(o2[0], o2[1]); }
                asm volatile("" ::: "memory");
            }
        } else if (pn == 2) {
#pragma unroll
            for (int ai = 0; ai < 2; ++ai)
#pragma unroll
                for (int m = 0; m < 4; ++m) { int row = rbase + ai * HALF + m * 16; asm volatile("" : "+v"(row) :: "memory"); bf16* rp = Vb + (size_t)row * 128 + 64 * (wc - 2) + 8 * fq;
#pragma unroll
                    for (int bj = 0; bj < 2; ++bj) *(u32x4*)(rp + 32 * bj) = pack8(acc[ai][bj][m][0], acc[ai][bj][m][1]); }
        } else if (pn < 5) {
#pragma unroll
            for (int ai = 0; ai < 2; ++ai)
#pragma unroll
                for (int m = 0; m < 4; ++m) { int row = rbase + ai * HALF + m * 16; asm volatile("" : "+v"(row) :: "memory"); bf16* rp = ZU + (size_t)row * 512 + 256 * (pn - 3) + 64 * wc + 8 * fq;
#pragma unroll
                    for (int bj = 0; bj < 2; ++bj) { f32x4 a = acc[ai][bj][m][0], b = acc[ai][bj][m][1];
#pragma unroll
                        for (int j = 0; j < 4; ++j) { a[j] = gelu_tanh(a[j]); b[j] = gelu_tanh(b[j]); }
                        *(u32x4*)(rp + 32 * bj) = pack8(a, b); } }
        } else {
            const int gi = 4 * (pn - 5) + wc;
            f32x4 gg[2][2], bb[2][2];
#pragma unroll
            for (int bj = 0; bj < 2; ++bj)
#pragma unroll
                for (int n = 0; n < 2; ++n) { gg[bj][n] = *(const f32x4*)(lng + gi * 64 + 32 * bj + 8 * fq + 4 * n); bb[bj][n] = *(const f32x4*)(lnb + gi * 64 + 32 * bj + 8 * fq + 4 * n); }
#pragma unroll
            for (int ai = 0; ai < 2; ++ai)
#pragma unroll
                for (int m = 0; m < 4; ++m) { int row = rbase + ai * HALF + m * 16; asm volatile("" : "+v"(row) :: "memory");
                    f32x4 z[2][2]; float s = 0.f;
#pragma unroll
                    for (int bj = 0; bj < 2; ++bj)
#pragma unroll
                        for (int n = 0; n < 2; ++n) {
#pragma unroll
                            for (int j = 0; j < 4; ++j) { z[bj][n][j] = gelu_tanh(acc[ai][bj][m][n][j]); s += z[bj][n][j]; } }
                    s += swz16_f(s); s = sum_x32(s);
                    const float mean = s * (1.0f / 64.0f); float q = 0.f;
#pragma unroll
                    for (int bj = 0; bj < 2; ++bj)
#pragma unroll
                        for (int n = 0; n < 2; ++n) { z[bj][n] = z[bj][n] - mean; q += (z[bj][n][0] * z[bj][n][0] + z[bj][n][1] * z[bj][n][1]) + (z[bj][n][2] * z[bj][n][2] + z[bj][n][3] * z[bj][n][3]); }
                    q += swz16_f(q); q = sum_x32(q);
                    const float rstd = 1.0f / sqrtf(q * (1.0f / 64.0f) + LN_EPS);
                    bf16* rp = ZV + (size_t)row * 512 + 64 * gi + 8 * fq;
#pragma unroll
                    for (int bj = 0; bj < 2; ++bj) *(u32x4*)(rp + 32 * bj) = pack8(z[bj][0] * rstd * gg[bj][0] + bb[bj][0], z[bj][1] * rstd * gg[bj][1] + bb[bj][1]); asm volatile("" ::: "memory"); }
        }
    }
};
}

#define XB_TMO      128
#define XB_XCNT(j)  (256  + 64 * (j))
#define XB_XSUB(j)  (1280 + 64 * (j))
#define XB_XGEN(j)  (2304 + 64 * (j))
#define XB_TOP      3328
#define XB_TOPGEN   3392
#define XCD_BAR_WORDS 3456
#define XB_SPIN_CAP (1u << 22)
DI unsigned xb_ld(unsigned* p)              { return __hip_atomic_load(p, __ATOMIC_RELAXED, __HIP_MEMORY_SCOPE_AGENT); }
DI unsigned xb_add(unsigned* p, unsigned v) { return __hip_atomic_fetch_add(p, v, __ATOMIC_RELAXED, __HIP_MEMORY_SCOPE_AGENT); }
DI unsigned xb_xcc_id() { return (unsigned)__builtin_amdgcn_s_getreg((3 << 11) | 20) & 0xFu; }
#define XB_SPIN(cond, bar) do { unsigned _sp = 0; while (cond) { __builtin_amdgcn_s_sleep(1); \
    if ((++_sp & 255u) == 0u) { if (xb_ld(&(bar)[XB_TMO])) break; if (_sp > XB_SPIN_CAP) { atomicAdd(&(bar)[XB_TMO], 1u); break; } } } } while (0)
struct XcdBarrier { GASP unsigned* bar; unsigned x; volatile LAS unsigned* st; };
DI XcdBarrier xcd_barrier_post(GASP unsigned* bar, volatile LAS unsigned* st, bool leader) {
    XcdBarrier b; b.bar = bar; b.x = xb_xcc_id(); b.st = st;
    if (leader) (void)xb_add((unsigned*)&bar[XB_XCNT(b.x)], 1u);
    return b;
}
DI void xcd_barrier_complete(unsigned* bar, unsigned x, unsigned& nloc, unsigned& nx) {
    const unsigned G = gridDim.x * gridDim.y * gridDim.z;
    unsigned sum, cnt, mine, sp = 0u;
    for (;;) {
        sum = 0u; cnt = 0u; mine = 0u;
#pragma unroll
        for (unsigned j = 0; j < 16; ++j) { const unsigned c = xb_ld(&bar[XB_XCNT(j)]); sum += c; cnt += (c > 0u) ? 1u : 0u; mine = (j == x) ? c : mine; }
        if (sum == G) break;
        __builtin_amdgcn_s_sleep(1);
        if ((++sp & 255u) == 0u) { if (xb_ld(&bar[XB_TMO])) break; if (sp > XB_SPIN_CAP) { atomicAdd(&bar[XB_TMO], 1u); break; } }
    }
    nloc = mine > 0u ? mine : 1u; nx = cnt > 0u ? cnt : 1u;
}
DI void xcd_barrier(const XcdBarrier& b, int wave) {
    asm volatile("s_waitcnt vmcnt(0)" ::: "memory");
    __syncthreads();
    if (wave == 0 && lane_id() == 0) {
        GASP unsigned* barg = b.bar; unsigned bx = b.x; asm volatile("" : "+s"(barg), "+s"(bx)); unsigned* bar = (unsigned*)barg;
        __builtin_amdgcn_s_waitcnt(0);
        unsigned nloc = b.st[0], nx = b.st[1];
        if (nloc == 0u) { xcd_barrier_complete(bar, bx, nloc, nx); b.st[0] = nloc; b.st[1] = nx; }
        const unsigned old = xb_add(&bar[XB_XSUB(bx)], 1u);
        const unsigned gen = old / nloc;
        if (old + 1u == (gen + 1u) * nloc) {
            __builtin_amdgcn_fence(__ATOMIC_RELEASE, "agent");
            asm volatile("s_waitcnt vmcnt(0)" ::: "memory");
            const unsigned og = xb_add(&bar[XB_TOP], 1u);
            const unsigned tg = og / nx;
            if (og + 1u == (tg + 1u) * nx) xb_add(&bar[XB_TOPGEN], 1u);
            else XB_SPIN(xb_ld(&bar[XB_TOPGEN]) == tg, bar);
            __builtin_amdgcn_fence(__ATOMIC_ACQUIRE, "agent");
            xb_add(&bar[XB_XGEN(bx)], 1u);
            asm volatile("s_waitcnt vmcnt(0)" ::: "memory");
        } else {
            XB_SPIN(xb_ld(&bar[XB_XGEN(bx)]) == gen, bar);
            __builtin_amdgcn_fence(__ATOMIC_ACQUIRE, "agent");
            asm volatile("s_waitcnt vmcnt(0)" ::: "memory");
        }
    }
    __syncthreads();
}

struct Frame {
    LAS unsigned char* lds;
    volatile LAS unsigned* MISC;
    unsigned* ctl;
    int tid, lane, wave, G, bid;
    GASP unsigned char* ws;
    GASP float* out;
};
struct Args { const float* in[27]; float* out; unsigned char* ws; };
typedef const unsigned char __attribute__((address_space(4)))* kptr_t;
DI const float* in_ptr(int k) { kptr_t p = (kptr_t)__builtin_amdgcn_kernarg_segment_ptr(); asm volatile("" : "+s"(p)); return (const float*)(*(GASP const float* const __attribute__((address_space(4)))*)(p + 8 * k)); }
struct ArgsRef { struct Acc { DI const float* operator[](int k) const { return in_ptr(k); } } in; };

template <int MAP>
DI int conv_col(int nb2, int lane, bool& second) {
    second = false;
    if (MAP == 0) return 64 * nb2 + lane;
    const int pn = nb2 >> 2, bj = (nb2 >> 1) & 1, wcp = nb2 & 1;
    if (MAP == 2) { second = bj != 0; return 128 * pn + 64 * wcp + lane; }
    return 256 * pn + 128 * wcp + 32 * bj + 64 * (lane >> 5) + (lane & 31);
}
template <int MAP>
DI void conv_job(Frame& F, const float* s1, const float* s2, bf16* dst, int K, int ldw, int nblk64, int nexp) {
    const int gw = F.bid * NWAVES + F.wave, NGW = F.G * NWAVES, lane = F.lane;
    const int per = (K / 64) * nblk64, total = per * nexp;
    for (int it = gw; it < total; it += NGW) {
        const int e = it / per, r = it - e * per, kb = r / nblk64, nb2 = r - kb * nblk64;
        bool second; const int col = conv_col<MAP>(nb2, lane, second);
        const float* W = (second ? s2 : s1) + (size_t)e * K * ldw + (size_t)(64 * kb) * ldw + col;
        float v[64];
#pragma unroll
        for (int k = 0; k < 64; ++k) v[k] = W[(size_t)k * ldw];
        bf16* drow = dst + ((size_t)e * nblk64 * 64 + (size_t)nb2 * 64 + lane) * K + 64 * kb;
#pragma unroll
        for (int q = 0; q < 8; ++q) { u32x4 o; o.x = pk2(v[8 * q], v[8 * q + 1]); o.y = pk2(v[8 * q + 2], v[8 * q + 3]); o.z = pk2(v[8 * q + 4], v[8 * q + 5]); o.w = pk2(v[8 * q + 6], v[8 * q + 7]); *(u32x4*)(drow + 8 * q) = o; }
    }
}
template <int MAP>
DI void conv_job_i8(Frame& F, const float* s1, const float* s2, unsigned char* dst, float* swout, int ldw, int nblk64, int nexp) {
    constexpr int K = D, KW = K / NWAVES;
    LAS float* wmax = (LAS float*)(F.lds + 124 * 1024);
    LAS float* sinv = wmax + 512;
    const int lane = F.lane, w = F.wave;
    for (int it = F.bid; it < nblk64 * nexp; it += F.G) {
        const int e = it / nblk64, nb2 = it - e * nblk64;
        bool second; const int col = conv_col<MAP>(nb2, lane, second);
        const float* W = (second ? s2 : s1) + (size_t)e * K * ldw + (size_t)(KW * w) * ldw + col;
        float v[KW]; float mx = 0.f;
#pragma unroll
        for (int k = 0; k < KW; ++k) v[k] = W[(size_t)k * ldw];
#pragma unroll
        for (int k = 0; k < KW; ++k) mx = fmaxf(mx, fabsf(v[k]));
        wmax[w * 64 + lane] = mx;
        __syncthreads();
        if (w == 0) { float m = wmax[lane];
#pragma unroll
            for (int j = 1; j < 8; ++j) m = fmaxf(m, wmax[j * 64 + lane]);
            swout[(size_t)e * nblk64 * 64 + nb2 * 64 + lane] = m * (1.0f / 127.0f); sinv[lane] = m > 0.f ? 127.0f / m : 0.f; }
        __syncthreads();
        const float iv = sinv[lane];
        unsigned char* drow = dst + ((size_t)e * nblk64 * 64 + (size_t)nb2 * 64 + lane) * K + KW * w;
#pragma unroll
        for (int q = 0; q < KW / 16; ++q) { u32x4 o;
            o.x = pk4_i8(v[16 * q], v[16 * q + 1], v[16 * q + 2], v[16 * q + 3], iv); o.y = pk4_i8(v[16 * q + 4], v[16 * q + 5], v[16 * q + 6], v[16 * q + 7], iv);
            o.z = pk4_i8(v[16 * q + 8], v[16 * q + 9], v[16 * q + 10], v[16 * q + 11], iv); o.w = pk4_i8(v[16 * q + 12], v[16 * q + 13], v[16 * q + 14], v[16 * q + 15], iv);
            *(u32x4*)(drow + 16 * q) = o; }
        __syncthreads();
    }
}
DI void wmax_job(Frame& F, const float* s1, unsigned* wmax, int K, int ldw, int nexp) {
    const int gw = F.bid * NWAVES + F.wave, NGW = F.G * NWAVES, lane = F.lane;
    const int nb = ldw / 64, ks = K / 352, per = nb * ks, total = per * nexp;
    for (int it = gw; it < total; it += NGW) {
        const int e = it / per, r = it - e * per, kb = r / nb, nb2 = r - kb * nb;
        const float* W = s1 + (size_t)e * K * ldw + (size_t)(352 * kb) * ldw + 64 * nb2 + lane;
        float mx = 0.f;
#pragma unroll 32
        for (int k = 0; k < 352; ++k) mx = fmaxf(mx, fabsf(W[(size_t)k * ldw]));
        atomicMax(wmax + (size_t)e * ldw + 64 * nb2 + lane, __float_as_uint(mx));
    }
}
DI void conv_job_f8(Frame& F, const float* s1, unsigned char* dst, float* swout, const unsigned* wmax, int K, int ldw, int nblk64, int nexp) {
    const int gw = F.bid * NWAVES + F.wave, NGW = F.G * NWAVES, lane = F.lane;
    const int per = (K / 64) * nblk64, total = per * nexp;
    for (int it = gw; it < total; it += NGW) {
        const int e = it / per, r = it - e * per, kb = r / nblk64, nb2 = r - kb * nblk64;
        const float m = __uint_as_float(__hip_atomic_load(wmax + (size_t)e * ldw + 64 * nb2 + lane, __ATOMIC_RELAXED, __HIP_MEMORY_SCOPE_AGENT));
        const float iv = m > 0.f ? 256.0f / m : 0.f;
        if (kb == 0) swout[(size_t)e * nblk64 * 64 + nb2 * 64 + lane] = m * (1.0f / 256.0f);
        const float* W = s1 + (size_t)e * K * ldw + (size_t)(64 * kb) * ldw + 64 * nb2 + lane;
        float v[64];
#pragma unroll
        for (int k = 0; k < 64; ++k) v[k] = W[(size_t)k * ldw];
        unsigned char* drow = dst + ((size_t)e * nblk64 * 64 + (size_t)nb2 * 64 + lane) * K + 64 * kb;
#pragma unroll
        for (int q = 0; q < 4; ++q) { u32x4 o; o.x = pk4_fp8(v[16 * q] * iv, v[16 * q + 1] * iv, v[16 * q + 2] * iv, v[16 * q + 3] * iv); o.y = pk4_fp8(v[16 * q + 4] * iv, v[16 * q + 5] * iv, v[16 * q + 6] * iv, v[16 * q + 7] * iv);
            o.z = pk4_fp8(v[16 * q + 8] * iv, v[16 * q + 9] * iv, v[16 * q + 10] * iv, v[16 * q + 11] * iv); o.w = pk4_fp8(v[16 * q + 12] * iv, v[16 * q + 13] * iv, v[16 * q + 14] * iv, v[16 * q + 15] * iv);
            *(u32x4*)(drow + 16 * q) = o; }
    }
}
DI void wmax_layer(Frame& F, const ArgsRef& a, int L) {
    FRESH(F);
    const int i = L >> 1; unsigned* wm = F.ctl + CW_WMAX + (size_t)i * 9 * D;
    if ((L & 1) == 0) wmax_job(F, a.in[12] + (size_t)i * FF * D, wm + 8 * D, FF, D, 1);
    else wmax_job(F, a.in[26] + (size_t)i * NE * FF * D, wm, FF, D, NE);
}
DI void conv_down(Frame& F, const ArgsRef& a, int L) {
    FRESH(F);
    const int i = L >> 1; const unsigned* wm = F.ctl + CW_WMAX + (size_t)i * 9 * D; unsigned char* Wb8 = (unsigned char*)(F.ws + WS_W);
    if ((L & 1) == 0) conv_job_f8(F, a.in[12] + (size_t)i * FF * D, Wb8 + W_DN, (float*)(F.ws + WS_SWD), wm + 8 * D, FF, D, D / 64, 1);
    else conv_job_f8(F, a.in[26] + (size_t)i * NE * FF * D, Wb8 + W_MDN, (float*)(F.ws + WS_SWD), wm, FF, D, D / 64, NE);
}
DI void conv_layer(Frame& F, const ArgsRef& a, int L) {
    FRESH(F);
    bf16* Wb = (bf16*)(F.ws + WS_W);
    const int i = L >> 1;
    if ((L & 1) == 0) {
        conv_job<1>(F, a.in[3] + (size_t)i * D * INW, nullptr, (bf16*)((char*)Wb + W_IN), D, INW, INW / 64, 1);
        conv_job<0>(F, a.in[9] + (size_t)i * D * D, nullptr, (bf16*)((char*)Wb + W_OUT), D, D, D / 64, 1);
        conv_job_i8<2>(F, a.in[10] + (size_t)i * D * FF, a.in[11] + (size_t)i * D * FF, (unsigned char*)Wb + W_GU, (float*)(F.ws + WS_SW), FF, 2 * FF / 64, 1);
        const float* sw = a.in[5] + (size_t)i * 8 * 128 * 128; bf16* dw = (bf16*)(F.ws + WS_SGUW);
        for (int idx = F.bid * 512 + F.tid; idx < 8 * 128 * 128 / 4; idx += F.G * 512) { const f32x4 v = *(const f32x4*)(sw + 4 * idx); u32x2 o; o.x = pk2(v[0], v[1]); o.y = pk2(v[2], v[3]); *(u32x2*)(dw + 4 * idx) = o; }
    } else {
        conv_job<2>(F, a.in[21] + (size_t)i * D * D, a.in[22] + (size_t)i * D * D, (bf16*)((char*)Wb + W_GLU), D, D, 2 * D / 64, 1);
        conv_job_i8<2>(F, a.in[24] + (size_t)i * NE * D * FF, a.in[25] + (size_t)i * NE * D * FF, (unsigned char*)Wb + W_MGU, (float*)(F.ws + WS_SW), FF, 2 * FF / 64, NE);
    }
}

DI void prologue(Frame& F, const ArgsRef& a) {
    FRESH(F);
    const float* x = a.in[0]; bf16* XB = (bf16*)(F.ws + WS_XB);
    const size_t nthr = (size_t)F.G * 512, t0 = (size_t)F.bid * 512 + F.tid;
    for (size_t i = t0; i < (size_t)T * D / 8; i += nthr) { const f32x4 v0 = *(const f32x4*)(x + 8 * i), v1 = *(const f32x4*)(x + 8 * i + 4); *(u32x4*)(XB + 8 * i) = pg8::pack8(v0, v1); }
    float* cosT = (float*)(F.ws + WS_ROPE); float* sinT = cosT + SEQ * 32;
    for (size_t i = t0; i < (size_t)SEQ * 32; i += nthr) { const int pos = (int)(i >> 5), d = (int)(i & 31);
        const float invf = (float)exp_d(-(double)(2 * d) * (9.2103403719761836 / 64.0));
        const float ang = (float)pos * invf; double s, c; sincos_d((double)ang, s, c); cosT[i] = (float)c; sinT[i] = (float)s; }
}

DI void ln_core(f32x4 (&v)[4], const f32x4 (&g)[4], const f32x4 (&b)[4]) {
    float s = 0.f;
#pragma unroll
    for (int j = 0; j < 4; ++j) s += (v[j][0] + v[j][1]) + (v[j][2] + v[j][3]);
    const float mean = wave_sum(s) * (1.0f / D); float q = 0.f;
#pragma unroll
    for (int j = 0; j < 4; ++j) { v[j] = v[j] - mean; q += (v[j][0] * v[j][0] + v[j][1] * v[j][1]) + (v[j][2] * v[j][2] + v[j][3] * v[j][3]); }
    const float rstd = 1.0f / sqrtf(wave_sum(q) * (1.0f / D) + LN_EPS);
#pragma unroll
    for (int j = 0; j < 4; ++j) v[j] = v[j] * rstd * g[j] + b[j];
}
DI void ln_store(const f32x4 (&v)[4], bf16* XB, size_t row, int lane) {
#pragma unroll
    for (int j = 0; j < 4; ++j) { u32x2 o; o.x = pk2(v[j][0], v[j][1]); o.y = pk2(v[j][2], v[j][3]); *(u32x2*)(XB + row * D + 4 * lane + 256 * j) = o; }
}
DI void ln_load(f32x4 (&v)[4], const bf16* Y, size_t row, int lane) {
#pragma unroll
    for (int j = 0; j < 4; ++j) { const u32x2 yv = *(const u32x2*)(Y + row * D + 4 * lane + 256 * j); v[j] = (f32x4){bf_lo(yv.x), bf_hi(yv.x), bf_lo(yv.y), bf_hi(yv.y)}; }
}
DI void ln_pass_plain(Frame& F, const float* g_, const float* b_, const bool q8copy) {
    FRESH(F);
    const bf16* Y = (const bf16*)(F.ws + WS_Y); bf16* XB = (bf16*)(F.ws + WS_XB);
    f32x4 g[4], b[4];
#pragma unroll
    for (int j = 0; j < 4; ++j) { g[j] = *(const f32x4*)(g_ + 4 * F.lane + 256 * j); b[j] = *(const f32x4*)(b_ + 4 * F.lane + 256 * j); }
    const int gw = F.bid * NWAVES + F.wave, NGW = F.G * NWAVES;
    for (int row = gw; row < T; row += NGW) {
        f32x4 v[4]; ln_load(v, Y, (size_t)row, F.lane);
        ln_core(v, g, b);
        ln_store(v, XB, (size_t)row, F.lane);
        if (q8copy) {
            float mx = 0.f;
#pragma unroll
            for (int j = 0; j < 4; ++j) mx = fmaxf(mx, fmaxf(fmaxf(fabsf(v[j][0]), fabsf(v[j][1])), fmaxf(fabsf(v[j][2]), fabsf(v[j][3]))));
            mx = wave_max(mx);
            const float inv = mx > 0.f ? 127.0f / mx : 0.f;
            unsigned char* X8 = (unsigned char*)(F.ws + WS_XB8);
#pragma unroll
            for (int j = 0; j < 4; ++j) *(unsigned*)(X8 + (size_t)row * D + 4 * F.lane + 256 * j) = pk4_i8(v[j][0], v[j][1], v[j][2], v[j][3], inv);
            if (F.lane == 0) ((float*)(F.ws + WS_SX))[row] = mx * (1.0f / 127.0f);
        }
    }
}
DI void ln_pass_router(Frame& F, const float* g_, const float* b_, const float* rw_, unsigned* cnt, const size_t rec_off) {
    FRESH(F);
    const bf16* Y = (const bf16*)(F.ws + WS_Y); bf16* XB = (bf16*)(F.ws + WS_XB);
    i32x4* RECI = (i32x4*)(F.ws + WS_RECI + rec_off); f32x2* RECW = (f32x2*)(F.ws + WS_RECW + rec_off);
    LAS int* lcnt = (LAS int*)(F.lds); LAS int* lbase = lcnt + 8;
    LAS int* re0 = lcnt + 64; LAS int* re1 = re0 + 256; LAS int* rp0 = re1 + 256; LAS int* rp1 = rp0 + 256; LAS float* rw0 = (LAS float*)(rp1 + 256); LAS float* rw1 = rw0 + 256;
    f32x4 g[4], b[4];
#pragma unroll
    for (int j = 0; j < 4; ++j) { g[j] = *(const f32x4*)(g_ + 4 * F.lane + 256 * j); b[j] = *(const f32x4*)(b_ + 4 * F.lane + 256 * j); }
    f32x4 rwa[4][4], rwb[4][4];
#pragma unroll
    for (int j = 0; j < 4; ++j)
#pragma unroll
        for (int c = 0; c < 4; ++c) { const float* p = rw_ + (size_t)(4 * F.lane + 256 * j + c) * 8; rwa[j][c] = *(const f32x4*)p; rwb[j][c] = *(const f32x4*)(p + 4); }
    for (int pnl = F.bid; pnl < T / 256; pnl += F.G) {
        if (F.tid < 8) lcnt[F.tid] = 0;
        __syncthreads();
        for (int rr = 0; rr < 32; ++rr) {
            const int lr = F.wave + 8 * rr; const size_t row = (size_t)pnl * 256 + lr;
            f32x4 v[4]; ln_load(v, Y, row, F.lane);
            ln_core(v, g, b);
            ln_store(v, XB, row, F.lane);
            f32x4 la = {0.f, 0.f, 0.f, 0.f}, lb = {0.f, 0.f, 0.f, 0.f};
#pragma unroll
            for (int j = 0; j < 4; ++j)
#pragma unroll
                for (int c = 0; c < 4; ++c) { la += rwa[j][c] * v[j][c]; lb += rwb[j][c] * v[j][c]; }
            float lg[8];
#pragma unroll
            for (int e = 0; e < 4; ++e) { lg[e] = wave_sum(la[e]); lg[4 + e] = wave_sum(lb[e]); }
            int i0 = 0; float l0 = lg[0];
#pragma unroll
            for (int e = 1; e < 8; ++e) if (lg[e] > l0) { l0 = lg[e]; i0 = e; }
            int i1 = -1; float l1 = -3.0e38f;
#pragma unroll
            for (int e = 0; e < 8; ++e) if (e != i0 && lg[e] > l1) { l1 = lg[e]; i1 = e; }
            const float w0 = 1.0f / (1.0f + __expf(l1 - l0)), w1 = 1.0f - w0;
            if (F.lane == 0) { const int p0 = atomicAdd((int*)(lcnt + i0), 1), p1 = atomicAdd((int*)(lcnt + i1), 1);
                re0[lr] = i0; re1[lr] = i1; rp0[lr] = p0; rp1[lr] = p1; rw0[lr] = w0; rw1[lr] = w1; }
        }
        __syncthreads();
        if (F.tid < 8) lbase[F.tid] = (int)xb_add(cnt + F.tid, (unsigned)lcnt[F.tid]);
        __syncthreads();
        if (F.tid < 256) { const int e0 = re0[F.tid], e1 = re1[F.tid]; const size_t row = (size_t)pnl * 256 + F.tid;
            RECI[row] = (i32x4){e0, lbase[e0] + rp0[F.tid], e1, lbase[e1] + rp1[F.tid]}; RECW[row] = (f32x2){rw0[F.tid], rw1[F.tid]}; }
        __syncthreads();
    }
}
DI void moe_tiles(const unsigned* cnt, int (&tb)[9], int (&cn)[8]) {
    int acc = 0;
#pragma unroll
    for (int e = 0; e < 8; ++e) { cn[e] = __builtin_amdgcn_readfirstlane((int)__hip_atomic_load(cnt + e, __ATOMIC_RELAXED, __HIP_MEMORY_SCOPE_AGENT)); tb[e] = acc; acc += (cn[e] + 255) >> 8; }
    tb[8] = acc;
}
DI void moe_gather(Frame& F, const unsigned* cnt) {
    FRESH(F);
    int tb[9], cn[8]; moe_tiles(cnt, tb, cn);
    const bf16* XB = (const bf16*)(F.ws + WS_XB); unsigned char* XS = (unsigned char*)(F.ws + WS_XS); float* SXS = (float*)(F.ws + WS_SXS); const i32x4* RECI = (const i32x4*)(F.ws + WS_RECI);
    const int gw = F.bid * NWAVES + F.wave, NGW = F.G * NWAVES;
    for (int t = gw; t < T; t += NGW) {
        const i32x4 r = RECI[t];
        int b0 = 0, b1 = 0;
#pragma unroll
        for (int e = 0; e < 8; ++e) { b0 = (r[0] == e) ? tb[e] : b0; b1 = (r[2] == e) ? tb[e] : b1; }
        const size_t r0 = (size_t)b0 * 256 + r[1], r1 = (size_t)b1 * 256 + r[3];
        const u32x4 v0 = *(const u32x4*)(XB + (size_t)t * D + 8 * F.lane), v1 = *(const u32x4*)(XB + (size_t)t * D + 512 + 8 * F.lane);
        float f[16] = {bf_lo(v0.x), bf_hi(v0.x), bf_lo(v0.y), bf_hi(v0.y), bf_lo(v0.z), bf_hi(v0.z), bf_lo(v0.w), bf_hi(v0.w),
                       bf_lo(v1.x), bf_hi(v1.x), bf_lo(v1.y), bf_hi(v1.y), bf_lo(v1.z), bf_hi(v1.z), bf_lo(v1.w), bf_hi(v1.w)};
        float mx = 0.f;
#pragma unroll
        for (int k = 0; k < 16; ++k) mx = fmaxf(mx, fabsf(f[k]));
        mx = wave_max(mx);
        const float inv = mx > 0.f ? 127.0f / mx : 0.f, sc = mx * (1.0f / 127.0f);
        u32x2 q0, q1;
        q0.x = pk4_i8(f[0], f[1], f[2], f[3], inv); q0.y = pk4_i8(f[4], f[5], f[6], f[7], inv); q1.x = pk4_i8(f[8], f[9], f[10], f[11], inv); q1.y = pk4_i8(f[12], f[13], f[14], f[15], inv);
        *(u32x2*)(XS + r0 * D + 8 * F.lane) = q0; *(u32x2*)(XS + r0 * D + 512 + 8 * F.lane) = q1;
        *(u32x2*)(XS + r1 * D + 8 * F.lane) = q0; *(u32x2*)(XS + r1 * D + 512 + 8 * F.lane) = q1;
        if (F.lane == 0) { SXS[r0] = sc; SXS[r1] = sc; }
    }
#pragma unroll
    for (int e = 0; e < 8; ++e) { const int first = tb[e] * 256 + cn[e], last = tb[e + 1] * 256;
        for (int r = first + gw; r < last; r += NGW) { const u32x2 z = {0u, 0u}; *(u32x2*)(XS + (size_t)r * D + 8 * F.lane) = z; *(u32x2*)(XS + (size_t)r * D + 512 + 8 * F.lane) = z; if (F.lane == 0) SXS[r] = 0.f; } }
}
DI void ln_pass_combine(Frame& F, const float* g_, const float* b_, const unsigned* cnt, const bool final_, const bool dummy_) {
    FRESH(F);
    int tb[9], cn[8]; moe_tiles(cnt, tb, cn);
    const bf16* YS = (const bf16*)(F.ws + WS_YS); bf16* XB = (bf16*)(F.ws + WS_XB); float* X = (float*)F.out;
    const i32x4* RECI = (const i32x4*)(F.ws + WS_RECI); const f32x2* RECW = (const f32x2*)(F.ws + WS_RECW);
    f32x4 g[4], b[4];
#pragma unroll
    for (int j = 0; j < 4; ++j) { g[j] = *(const f32x4*)(g_ + 4 * F.lane + 256 * j); b[j] = *(const f32x4*)(b_ + 4 * F.lane + 256 * j); }
    const int gw = F.bid * NWAVES + F.wave, NGW = F.G * NWAVES;
    for (int row = gw; row < T; row += NGW) {
        const i32x4 r = RECI[row]; const f32x2 w = RECW[row];
        int b0 = 0, b1 = 0;
#pragma unroll
        for (int e = 0; e < 8; ++e) { b0 = (r[0] == e) ? tb[e] : b0; b1 = (r[2] == e) ? tb[e] : b1; }
        const size_t r0 = (size_t)b0 * 256 + r[1], r1 = (size_t)b1 * 256 + r[3];
        f32x4 v[4];
#pragma unroll
        for (int j = 0; j < 4; ++j) { const u32x2 xv = *(const u32x2*)(XB + (size_t)row * D + 4 * F.lane + 256 * j);
            const u32x2 ya = *(const u32x2*)(YS + r0 * D + 4 * F.lane + 256 * j), yb = *(const u32x2*)(YS + r1 * D + 4 * F.lane + 256 * j);
            v[j][0] = ALPHA * bf_lo(xv.x) + (w[0] * bf_lo(ya.x) + w[1] * bf_lo(yb.x)); v[j][1] = ALPHA * bf_hi(xv.x) + (w[0] * bf_hi(ya.x) + w[1] * bf_hi(yb.x));
            v[j][2] = ALPHA * bf_lo(xv.y) + (w[0] * bf_lo(ya.y) + w[1] * bf_lo(yb.y)); v[j][3] = ALPHA * bf_hi(xv.y) + (w[0] * bf_hi(ya.y) + w[1] * bf_hi(yb.y)); }
        ln_core(v, g, b);
        if (dummy_) ln_store(v, (bf16*)(F.ws + WS_XS), (size_t)row, F.lane);
        else if (final_) {
#pragma unroll
            for (int j = 0; j < 4; ++j) *(f32x4*)(X + (size_t)row * D + 4 * F.lane + 256 * j) = v[j];
        } else ln_store(v, XB, (size_t)row, F.lane);
    }
}

constexpr int KL_STRIDE = 144, VT_STRIDE = 776, VT_OFF = 384 * KL_STRIDE;
DI void attn_phase(Frame& F, const float* sink) {
    FRESH(F);
    const bf16* Q = (const bf16*)(F.ws + WS_Q); const bf16* Kb = (const bf16*)(F.ws + WS_K); const bf16* Vb = (const bf16*)(F.ws + WS_V); bf16* MIX = (bf16*)(F.ws + WS_MIX);
    LAS unsigned char* Kl = F.lds; LAS unsigned char* Vt = F.lds + VT_OFF;
    const int lane = F.lane, l31 = lane & 31, h = lane >> 5, w = F.wave;
    for (int unit = F.bid; unit < BATCH * 2 * 16; unit += F.G) {
        const int b = unit >> 5, kvh = (unit >> 4) & 1, n = unit & 15;
        __syncthreads();
        for (int idx = F.tid; idx < 384 * 8; idx += 512) {
            const int key = idx >> 3, ch = idx & 7, kp = (n - 1) * 128 + key;
            u32x4 kv = {0u, 0u, 0u, 0u}, vv = {0u, 0u, 0u, 0u};
            if (kp >= 0 && kp < SEQ) { const size_t off = (size_t)(b * SEQ + kp) * 128 + kvh * 64 + ch * 8; kv = *(const u32x4*)(Kb + off); vv = *(const u32x4*)(Vb + off); }
            *(LAS u32x4*)(Kl + key * KL_STRIDE + ch * 16) = kv;
            LAS unsigned short* vd = (LAS unsigned short*)(Vt + (ch * 8) * VT_STRIDE + key * 2);
            constexpr int RS = VT_STRIDE / 2;
            vd[0 * RS] = (unsigned short)(vv.x & 0xffffu); vd[1 * RS] = (unsigned short)(vv.x >> 16); vd[2 * RS] = (unsigned short)(vv.y & 0xffffu); vd[3 * RS] = (unsigned short)(vv.y >> 16);
            vd[4 * RS] = (unsigned short)(vv.z & 0xffffu); vd[5 * RS] = (unsigned short)(vv.z >> 16); vd[6 * RS] = (unsigned short)(vv.w & 0xffffu); vd[7 * RS] = (unsigned short)(vv.w >> 16);
        }
        __syncthreads();
        const int hq = kvh * 4 + (w >> 1);
        const float m0 = sink[hq] * LOG2E;
        for (int qb = 0; qb < 2; ++qb) {
            const int q0 = 64 * (w & 1) + 32 * qb;
            const size_t qrow = (size_t)(b * SEQ + n * 128 + q0 + l31);
            bf16x8 bq[4];
#pragma unroll
            for (int ks = 0; ks < 4; ++ks) bq[ks] = *(const bf16x8*)(Q + qrow * 512 + hq * 64 + 16 * ks + 8 * h);
            float m2 = m0, l = 1.0f;
            f32x16 O0, O1;
#pragma unroll
            for (int i = 0; i < 16; ++i) { O0[i] = 0.f; O1[i] = 0.f; }
            const int kt0 = q0 >> 5, qk = q0 + l31; const bool edge = (n == 0) || (n == 15);
            for (int kt = kt0; kt <= kt0 + 8; ++kt) {
                f32x16 X;
#pragma unroll
                for (int i = 0; i < 16; ++i) X[i] = 0.f;
#pragma unroll
                for (int ks = 0; ks < 4; ++ks) { const bf16x8 a = *(const LAS bf16x8*)(Kl + (32 * kt + l31) * KL_STRIDE + (16 * ks + 8 * h) * 2); X = MFMA32(a, bq[ks], X); }
                float mx = -1.0e30f;
                if (kt == kt0 || kt == kt0 + 8 || edge) {
#pragma unroll
                    for (int i = 0; i < 16; ++i) { const int kk = 32 * kt + crow(i, h); const int kp = (n - 1) * 128 + kk;
                        const bool valid = (kk >= qk) && (kk <= qk + 256) && (kp >= 0) && (kp < SEQ);
                        X[i] = valid ? X[i] : -1.0e30f; mx = fmaxf(mx, X[i]); }
                } else {
#pragma unroll
                    for (int i = 0; i < 16; ++i) mx = fmaxf(mx, X[i]);
                }
                mx = max_x32(mx);
                const float mn = fmaxf(m2, mx), alpha = fast_exp2(m2 - mn); m2 = mn;
                float ps = 0.f;
#pragma unroll
                for (int i = 0; i < 16; ++i) { X[i] = fast_exp2(X[i] - mn); ps += X[i]; }
                ps = sum_x32(ps);
                l = l * alpha + ps;
#pragma unroll
                for (int i = 0; i < 16; ++i) { O0[i] *= alpha; O1[i] *= alpha; }
#pragma unroll
                for (int s = 0; s < 2; ++s) {
                    u32x4 pw; pw.x = pk2(X[8 * s + 0], X[8 * s + 1]); pw.y = pk2(X[8 * s + 2], X[8 * s + 3]); pw.z = pk2(X[8 * s + 4], X[8 * s + 5]); pw.w = pk2(X[8 * s + 6], X[8 * s + 7]);
                    const bf16x8 pf = __builtin_bit_cast(bf16x8, pw);
                    const int kb = (32 * kt + 16 * s + 4 * h) * 2;
                    { const s16x4 lo = *(const LAS s16x4*)(Vt + l31 * VT_STRIDE + kb), hi = *(const LAS s16x4*)(Vt + l31 * VT_STRIDE + kb + 16);
                      O0 = MFMA32(__builtin_shufflevector(lo, hi, 0, 1, 2, 3, 4, 5, 6, 7), pf, O0); }
                    { const s16x4 lo = *(const LAS s16x4*)(Vt + (32 + l31) * VT_STRIDE + kb), hi = *(const LAS s16x4*)(Vt + (32 + l31) * VT_STRIDE + kb + 16);
                      O1 = MFMA32(__builtin_shufflevector(lo, hi, 0, 1, 2, 3, 4, 5, 6, 7), pf, O1); }
                }
            }
            const float inv = 1.0f / l;
            bf16* orow = MIX + qrow * D + hq * 64;
#pragma unroll
            for (int g4 = 0; g4 < 4; ++g4) {
                u32x2 o; o.x = pk2(O0[4 * g4] * inv, O0[4 * g4 + 1] * inv); o.y = pk2(O0[4 * g4 + 2] * inv, O0[4 * g4 + 3] * inv); *(u32x2*)(orow + 8 * g4 + 4 * h) = o;
                u32x2 p; p.x = pk2(O1[4 * g4] * inv, O1[4 * g4 + 1] * inv); p.y = pk2(O1[4 * g4 + 2] * inv, O1[4 * g4 + 3] * inv); *(u32x2*)(orow + 32 + 8 * g4 + 4 * h) = p;
            }
        }
    }
    __syncthreads();
}

constexpr int SG_STRIDE = 272;
DI void sgu_phase(Frame& F, const float* sgu_b) {
    FRESH(F);
    const bf16* ZU = (const bf16*)(F.ws + WS_ZU); const bf16* ZV = (const bf16*)(F.ws + WS_ZV); const bf16* Wsb = (const bf16*)(F.ws + WS_SGUW); bf16* MIX = (bf16*)(F.ws + WS_MIX);
    LAS unsigned char* VT = F.lds + F.wave * (32 * SG_STRIDE);
    const int lane = F.lane, l31 = lane & 31, h = lane >> 5;
    const int gw = F.bid * NWAVES + F.wave, NGW = F.G * NWAVES;
    for (int su = gw; su < BATCH * 16 * 8 * 2; su += NGW) {
        const int dh = su & 1, g = (su >> 1) & 7, n = (su >> 4) & 15, b = su >> 8;
        const size_t rowb = (size_t)(b * SEQ + n * 128);
#pragma unroll
        for (int i = 0; i < 8; ++i) { const int c = lane + 64 * i, q = c >> 2, ch = c & 3;
            const u32x4 vv = *(const u32x4*)(ZV + (rowb + q) * 512 + 64 * g + 32 * dh + 8 * ch);
            LAS unsigned short* vd = (LAS unsigned short*)(VT + (ch * 8) * SG_STRIDE + q * 2);
            constexpr int RS = SG_STRIDE / 2;
            vd[0 * RS] = (unsigned short)(vv.x & 0xffffu); vd[1 * RS] = (unsigned short)(vv.x >> 16); vd[2 * RS] = (unsigned short)(vv.y & 0xffffu); vd[3 * RS] = (unsigned short)(vv.y >> 16);
            vd[4 * RS] = (unsigned short)(vv.z & 0xffffu); vd[5 * RS] = (unsigned short)(vv.z >> 16); vd[6 * RS] = (unsigned short)(vv.w & 0xffffu); vd[7 * RS] = (unsigned short)(vv.w >> 16); }
        bf16x8 af[8];
#pragma unroll
        for (int ks = 0; ks < 8; ++ks) af[ks] = *(const LAS bf16x8*)(VT + l31 * SG_STRIDE + (16 * ks + 8 * h) * 2);
#pragma unroll
        for (int pt = 0; pt < 4; ++pt) {
            const int p = 32 * pt + l31;
            f32x16 acc;
#pragma unroll
            for (int i = 0; i < 16; ++i) acc[i] = 0.f;
#pragma unroll
            for (int ks = 0; ks < 8; ++ks) { const bf16x8 bw = *(const bf16x8*)(Wsb + ((size_t)g * 128 + p) * 128 + 16 * ks + 8 * h); acc = MFMA32(af[ks], bw, acc); }
            const float bias = sgu_b[g * 128 + p];
            const size_t row = rowb + p;
#pragma unroll
            for (int g4 = 0; g4 < 4; ++g4) { const int d = 32 * dh + 8 * g4 + 4 * h;
                const u32x2 uu = *(const u32x2*)(ZU + row * 512 + 64 * g + d);
                u32x2 o; o.x = pk2(bf_lo(uu.x) * (acc[4 * g4] + bias), bf_hi(uu.x) * (acc[4 * g4 + 1] + bias)); o.y = pk2(bf_lo(uu.y) * (acc[4 * g4 + 2] + bias), bf_hi(uu.y) * (acc[4 * g4 + 3] + bias));
                *(u32x2*)(MIX + row * D + 512 + 64 * g + d) = o; }
        }
        LDS_WAIT();
    }
}

constexpr int S5_STRIDE = 272;
DI void sincos_f(float th, float& s, float& c) {
    const float tq = th * 0.636619772367581f, q = rintf(tq), f = (tq - q) * 1.5707963267948966f, f2 = f * f;
    const float sp = f * (1.0f + f2 * (-1.6666667e-1f + f2 * (8.3333333e-3f + f2 * (-1.9841270e-4f + f2 * 2.7557319e-6f))));
    const float cp = 1.0f + f2 * (-0.5f + f2 * (4.1666667e-2f + f2 * (-1.3888889e-3f + f2 * (2.4801587e-5f + f2 * (-2.7557319e-7f)))));
    const int qi = ((int)q) & 3;
    s = (qi == 0) ? sp : (qi == 1) ? cp : (qi == 2) ? -sp : -cp;
    c = (qi == 0) ? cp : (qi == 1) ? -sp : (qi == 2) ? -cp : sp;
}
DI void zoh_params(float lr, float li, float logdt, float& br, float& bi, float& cr, float& ci) {
    const float dt = expf(logdt);
    const float ea = expf(lr * dt);
    float sn, cs; sincos_f(li * dt, sn, cs);
    br = ea * cs; bi = ea * sn;
    const float nr = br - 1.0f, rden = 1.0f / (lr * lr + li * li);
    cr = (nr * lr + bi * li) * rden; ci = (bi * lr - nr * li) * rden;
}
DI void s5_phase(Frame& F, const ArgsRef& a, int i) {
    FRESH(F);
    const bf16* XB = (const bf16*)(F.ws + WS_XB); bf16* YF = (bf16*)(F.ws + WS_YF);     bf16* YG = (bf16*)(F.ws + WS_YG);
    LAS unsigned char* xs = F.lds + F.wave * (32 * S5_STRIDE);
    const int lane = F.lane, l31 = lane & 31, h = lane >> 5, l15 = lane & 15, q4 = lane >> 4;
    const int gw = F.bid * NWAVES + F.wave, NGW = F.G * NWAVES;
    const bool fwdrow = (l31 & 4) == 0; const int slot = (l31 & 3) + 4 * (l31 >> 3);
    for (int unit = gw; unit < BATCH * 64; unit += NGW) {
        const int b = unit >> 6, g = unit & 63;
        const f32x4 dsk = *(const f32x4*)(a.in[20] + ((size_t)i * 64 + g) * 16 + 4 * q4);
        bf16x8 bfr[2][2][2]; float lbr[2], lbi[2];
#pragma unroll
        for (int dir = 0; dir < 2; ++dir) { const size_t pg = ((size_t)(i * 2 + dir) * 64 + g); const float logdt = a.in[15][pg];
#pragma unroll
            for (int ph = 0; ph < 2; ++ph) { const int pp = 32 * ph + l31; float tbr, tbi, tcr, tci;
                zoh_params(a.in[13][pg * 64 + pp], a.in[14][pg * 64 + pp], logdt, tbr, tbi, tcr, tci);
                if (dir == 0) { lbr[ph] = tbr; lbi[ph] = tbi; } else { lbr[ph] = h ? tbr : lbr[ph]; lbi[ph] = h ? tbi : lbi[ph]; }
                const float* brp = a.in[16] + (pg * 64 + pp) * 16 + 8 * h; const float* bip = a.in[17] + (pg * 64 + pp) * 16 + 8 * h;
                const f32x4 r0 = *(const f32x4*)brp, r1 = *(const f32x4*)(brp + 4), m0 = *(const f32x4*)bip, m1 = *(const f32x4*)(bip + 4);
                bfr[dir][ph][0] = __builtin_bit_cast(bf16x8, pg8::pack8(r0 * tcr - m0 * tci, r1 * tcr - m1 * tci));
                bfr[dir][ph][1] = __builtin_bit_cast(bf16x8, pg8::pack8(m0 * tcr + r0 * tci, m1 * tcr + r1 * tci)); } }
        bf16x8 cf[2][4];
#pragma unroll
        for (int dir = 0; dir < 2; ++dir) { const size_t pg = ((size_t)(i * 2 + dir) * 64 + g);
#pragma unroll
            for (int ks = 0; ks < 4; ++ks) { const size_t co = (pg * 16 + l15) * 64 + 16 * ks + 4 * q4;
                const f32x4 cre = *(const f32x4*)(a.in[18] + co), cim = *(const f32x4*)(a.in[19] + co);
                u32x4 wv; wv.x = pk2(cre[0], -cim[0]); wv.y = pk2(cre[1], -cim[1]); wv.z = pk2(cre[2], -cim[2]); wv.w = pk2(cre[3], -cim[3]);
                cf[dir][ks] = __builtin_bit_cast(bf16x8, wv); } }
        float xr[2] = {0.f, 0.f}, xi[2] = {0.f, 0.f};
        const size_t seq0 = (size_t)b * SEQ;
        bf16x8 au_n = *(const bf16x8*)(XB + (seq0 + (fwdrow ? slot : 16 * 127 + 15 - slot)) * D + 16 * g + 8 * h);
#pragma unroll 1
        for (int j = 0; j < 128; ++j) {
            const bf16x8 au = au_n;
            const size_t orow_f = seq0 + 16 * j + l15, orow_b = seq0 + 16 * (127 - j) + l15;
            const size_t oo_f = orow_f * D + 16 * g + 4 * q4, oo_b = orow_b * D + 16 * g + 4 * q4;
            u32x2 yfp[2], uup[2];
            if (j >= 64) { yfp[0] = *(const u32x2*)(YF + oo_f); yfp[1] = *(const u32x2*)(YF + oo_b); uup[0] = *(const u32x2*)(XB + oo_f); uup[1] = *(const u32x2*)(XB + oo_b); }
            else { yfp[0] = yfp[1] = (u32x2){0u, 0u}; uup[0] = uup[1] = (u32x2){0u, 0u}; }
            const bf16x8 zero8 = {0, 0, 0, 0, 0, 0, 0, 0};
            const bf16x8 a0 = fwdrow ? au : zero8, a1 = fwdrow ? zero8 : au;
            f32x16 z16;
#pragma unroll
            for (int k = 0; k < 16; ++k) z16[k] = 0.f;
            f32x16 P[2][2];
#pragma unroll
            for (int ph = 0; ph < 2; ++ph)
#pragma unroll
                for (int ri = 0; ri < 2; ++ri) { P[ph][ri] = MFMA32(a0, bfr[0][ph][ri], z16); P[ph][ri] = MFMA32(a1, bfr[1][ph][ri], P[ph][ri]); }
            __builtin_amdgcn_sched_barrier(0);
            { const int jn = (j < 127) ? j + 1 : j;
              au_n = *(const bf16x8*)(XB + (seq0 + (fwdrow ? 16 * jn + slot : 16 * (127 - jn) + 15 - slot)) * D + 16 * g + 8 * h); }
#pragma unroll
            for (int t = 0; t < 16; ++t) {
#pragma unroll
                for (int ph = 0; ph < 2; ++ph) {
                    const float t1 = __builtin_fmaf(-lbi[ph], xi[ph], P[ph][0][t]), t2 = __builtin_fmaf(lbi[ph], xr[ph], P[ph][1][t]);
                    xr[ph] = __builtin_fmaf(lbr[ph], xr[ph], t1); xi[ph] = __builtin_fmaf(lbr[ph], xi[ph], t2);
                    asm volatile("" : "+v"(xr[ph]), "+v"(xi[ph]));
                    *(LAS unsigned*)(xs + (16 * h + t) * S5_STRIDE + 4 * (32 * ph + l31)) = pk2(xr[ph], xi[ph]);
                }
            }
            f32x4 y4[2];
#pragma unroll
            for (int dd = 0; dd < 2; ++dd) {
                y4[dd] = (f32x4){0.f, 0.f, 0.f, 0.f};
                const int srow = dd ? 16 + (15 - l15) : l15;
#pragma unroll
                for (int ks = 0; ks < 4; ++ks) { const bf16x8 bx = *(const LAS bf16x8*)(xs + srow * S5_STRIDE + (32 * ks + 8 * q4) * 2); y4[dd] = MFMA16(cf[dd][ks], bx, y4[dd]); }
            }
            if (j < 64) { u32x2 p0, p1; p0.x = pk2(y4[0][0], y4[0][1]); p0.y = pk2(y4[0][2], y4[0][3]); p1.x = pk2(y4[1][0], y4[1][1]); p1.y = pk2(y4[1][2], y4[1][3]); *(u32x2*)(YF + oo_f) = p0; *(u32x2*)(YF + oo_b) = p1; }
            else {
#pragma unroll
                for (int dd = 0; dd < 2; ++dd) { const u32x2 uu = uup[dd];
                    const f32x4 uv = {bf_lo(uu.x), bf_hi(uu.x), bf_lo(uu.y), bf_hi(uu.y)};
                    const f32x4 yp = {bf_lo(yfp[dd].x), bf_hi(yfp[dd].x), bf_lo(yfp[dd].y), bf_hi(yfp[dd].y)};
                    const f32x4 y = yp + y4[dd] + dsk * uv;
                    u32x2 ov; ov.x = pk2(gelu_tanh(y[0]), gelu_tanh(y[1])); ov.y = pk2(gelu_tanh(y[2]), gelu_tanh(y[3])); *(u32x2*)(YG + (dd ? oo_b : oo_f)) = ov; }
            }
            { u32x4 t_ = __builtin_bit_cast(u32x4, au_n); asm volatile("" : "+v"(t_.x), "+v"(t_.y), "+v"(t_.z), "+v"(t_.w)); au_n = __builtin_bit_cast(bf16x8, t_); }
            LDS_WAIT();
        }
    }
}

__global__ void __launch_bounds__(NWAVES * 64, 2) fwd_kernel(Args args_by_value) {
    extern __shared__ __attribute__((aligned(16))) unsigned char lds[];
    Frame F;
    F.lds = (LAS unsigned char*)lds;
    F.MISC = (volatile LAS unsigned*)(F.lds + MISC_OFF);
    F.tid = threadIdx.x; F.lane = F.tid & 63; F.wave = __builtin_amdgcn_readfirstlane(F.tid >> 6);
    F.G = gridDim.x; F.bid = blockIdx.x;
    { kptr_t kp = (kptr_t)__builtin_amdgcn_kernarg_segment_ptr(); F.out = *(GASP float* const __attribute__((address_space(4)))*)(kp + 8 * 27); F.ws = *(GASP unsigned char* const __attribute__((address_space(4)))*)(kp + 8 * 28); }
    F.ctl = (unsigned*)(F.ws + WS_CTL);
    const ArgsRef args{};
    for (int u = F.tid; u < (LDS_BYTES - LDSCTL_OFF) / 4; u += NWAVES * 64) ((LAS unsigned*)(F.lds + LDSCTL_OFF))[u] = 0u;
    __syncthreads();
    XcdBarrier bar = xcd_barrier_post((GASP unsigned*)(F.ws + WS_CTL) + CW_BAR, F.MISC + 8, F.tid == 0);
#define GRID_BAR() xcd_barrier(bar, F.wave)
#define XB ((bf16*)(F.ws + WS_XB))
#define Yb ((bf16*)(F.ws + WS_Y))
#define Wb ((const char*)(F.ws + WS_W))
#define cosT ((const float*)(F.ws + WS_ROPE))
#define sinT ((const float*)(F.ws + WS_ROPE) + SEQ * 32)

    RPT(10) PH(0) prologue(F, args);
    RPT(4) PH(1) conv_layer(F, args, 0);
    wmax_layer(F, args, 0);
    GRID_BAR();

#pragma unroll 1
    for (int lp = 0; lp < 2; ++lp) {
        {
            const int L = 2 * lp, i = lp;
            { UFRESH(F); pg8::Order S{}; S.nM = T / 256; S.nN = INW / 256; S.nwg = S.nM * S.nN; S.G = F.G; S.c = F.bid; S.A = (const char*)XB; S.Bt = Wb + W_IN; S.tstep = (size_t)256 * D * 2; S.estride = 0;
              RPT(0) PH(2) { pg8::EpiWin E{(bf16*)(F.ws + WS_Q), (bf16*)(F.ws + WS_K), (bf16*)(F.ws + WS_V), (bf16*)(F.ws + WS_ZU), (bf16*)(F.ws + WS_ZV), cosT, sinT, args.in[7] + (size_t)i * 512, args.in[8] + (size_t)i * 512};
              pg8::gemm_phase(F.lds, D, S, E, F.wave); } }
            GRID_BAR();
            RPT(2) PH(3) attn_phase(F, args.in[4] + (size_t)i * 8);
            RPT(9) PH(4) sgu_phase(F, args.in[6] + (size_t)i * 8 * 128);
            if (L == 0) conv_down(F, args, 0);
            GRID_BAR();
            { UFRESH(F); pg8::Order S{}; S.nM = T / 256; S.nN = D / 256; S.nwg = S.nM * S.nN; S.G = F.G; S.c = F.bid; S.A = (const char*)(F.ws + WS_MIX); S.Bt = Wb + W_OUT; S.tstep = (size_t)256 * D * 2; S.estride = 0;
              pg8::EpiPlain E{Yb, D, XB, nullptr};
              RPT(0) PH(10) pg8::gemm_phase(F.lds, D, S, E, F.wave); }
            GRID_BAR();
            RPT(5) PH(5) ln_pass_plain(F, args.in[1] + (size_t)(L * 2 + 0) * D, args.in[2] + (size_t)(L * 2 + 0) * D, true);
            wmax_layer(F, args, L + 1);
            GRID_BAR();
            { UFRESH(F); pg8::Order S{}; S.nM = T / 256; S.nN = 2 * FF / 256; S.nwg = S.nM * S.nN; S.G = F.G; S.c = F.bid; S.A = (const char*)(F.ws + WS_XB8); S.Bt = Wb + W_GU; S.tstep = (size_t)256 * D; S.estride = 0;
              pg8::EpiPairI8 E{(unsigned char*)(F.ws + WS_H), FF, (const float*)(F.ws + WS_SX), (const float*)(F.ws + WS_SW)};
              RPT(0) PH(11) pg8::gemm_phase<pg8::EpiPairI8, 1>(F.lds, D / 2, S, E, F.wave); }
            GRID_BAR();
            { UFRESH(F); pg8::Order S{}; S.nM = T / 256; S.nN = D / 256; S.nwg = S.nM * S.nN; S.G = F.G; S.c = F.bid; S.A = (const char*)(F.ws + WS_H); S.Bt = Wb + W_DN; S.tstep = (size_t)256 * FF; S.estride = 0;
              pg8::EpiPlain E{Yb, D, XB, (const float*)(F.ws + WS_SWD)};
              RPT(0) PH(10) pg8::gemm_phase<pg8::EpiPlain, 2>(F.lds, FF / 2, S, E, F.wave); }
            GRID_BAR();
            RPT(5) PH(5) ln_pass_plain(F, args.in[1] + (size_t)(L * 2 + 1) * D, args.in[2] + (size_t)(L * 2 + 1) * D, false);
            RPT(4) PH(1) conv_layer(F, args, L + 1);
            RPT(4) conv_down(F, args, L + 1);
            GRID_BAR();
        }
        {
            const int L = 2 * lp + 1, i = lp;
            unsigned* cnt = F.ctl + CW_CNT + 64 * i;
            RPT(3) PH(6) s5_phase(F, args, i);
            GRID_BAR();
            { UFRESH(F); pg8::Order S{}; S.nM = T / 256; S.nN = 2 * D / 256; S.nwg = S.nM * S.nN; S.G = F.G; S.c = F.bid; S.A = (const char*)(F.ws + WS_YG); S.Bt = Wb + W_GLU; S.tstep = (size_t)256 * D * 2; S.estride = 0;
              pg8::EpiPair<1> E{Yb, D, XB};
              RPT(0) PH(12) pg8::gemm_phase(F.lds, D, S, E, F.wave); }
            GRID_BAR();
            if ((RG >> 6) & 1) { PH(7) ln_pass_router(F, args.in[1] + (size_t)(L * 2 + 0) * D, args.in[2] + (size_t)(L * 2 + 0) * D, args.in[23] + (size_t)i * D * 8, cnt + 1024, WS_YS - WS_RECI); }
            PH(7) ln_pass_router(F, args.in[1] + (size_t)(L * 2 + 0) * D, args.in[2] + (size_t)(L * 2 + 0) * D, args.in[23] + (size_t)i * D * 8, cnt, 0);
            if (L + 1 < 4) wmax_layer(F, args, L + 1);
            GRID_BAR();
            RPT(11) PH(8) moe_gather(F, cnt);
            GRID_BAR();
            {
                int tb[9], cn[8]; moe_tiles(cnt, tb, cn);
                const int ntt = tb[8], TC = 256, nch = (ntt + TC - 1) / TC;
RPT(1)
#pragma unroll 1
                for (int ch = 0; ch < nch; ++ch) {
                    const int t0 = ch * TC, t1 = (t0 + TC < ntt) ? t0 + TC : ntt, nM = (t1 > t0) ? t1 - t0 : 0;
                    { UFRESH(F); pg8::Order S{}; S.nM = nM; S.nN = 2 * FF / 256; S.nwg = S.nM * S.nN; S.G = F.G; S.c = F.bid; S.atile0 = t0; S.otile0 = 0; S.etile0 = t0;
                      S.A = (const char*)(F.ws + WS_XS); S.Bt = Wb + W_MGU; S.tstep = (size_t)256 * D; S.estride = (size_t)2 * FF * D;
#pragma unroll
                      for (int e = 0; e < 8; ++e) S.tb[e] = tb[e];
                      pg8::EpiPairI8 E{(unsigned char*)(F.ws + WS_HS), FF, (const float*)(F.ws + WS_SXS), (const float*)(F.ws + WS_SW)};
                      PH(13) pg8::gemm_phase<pg8::EpiPairI8, 1>(F.lds, D / 2, S, E, F.wave); }
                    GRID_BAR();
                    { UFRESH(F); pg8::Order S{}; S.nM = nM; S.nN = D / 256; S.nwg = S.nM * S.nN; S.G = F.G; S.c = F.bid; S.atile0 = 0; S.otile0 = t0; S.etile0 = t0;
                      S.A = (const char*)(F.ws + WS_HS); S.Bt = Wb + W_MDN; S.tstep = (size_t)256 * FF; S.estride = (size_t)D * FF;
#pragma unroll
                      for (int e = 0; e < 8; ++e) S.tb[e] = tb[e];
                      pg8::EpiPlain E{(bf16*)(F.ws + WS_YS), D, nullptr, (const float*)(F.ws + WS_SWD)};
                      PH(14) pg8::gemm_phase<pg8::EpiPlain, 2>(F.lds, FF / 2, S, E, F.wave); }
                    GRID_BAR();
                }
            }
            if ((RG >> 7) & 1) { PH(9) ln_pass_combine(F, args.in[1] + (size_t)(L * 2 + 1) * D, args.in[2] + (size_t)(L * 2 + 1) * D, cnt, L == 3, true); }
            PH(9) ln_pass_combine(F, args.in[1] + (size_t)(L * 2 + 1) * D, args.in[2] + (size_t)(L * 2 + 1) * D, cnt, L == 3, false);
            if (L + 1 < 4) { RPT(4) PH(1) conv_layer(F, args, L + 1); RPT(4) conv_down(F, args, L + 1); GRID_BAR(); }
        }
    }
}

extern "C" void kernel_launch(void* const* d_in, const int* in_sizes, int n_in, void* d_out, int out_size, void* d_ws, size_t ws_size, hipStream_t stream) {
    static int grid = 0;
    if (grid == 0) {
        if (n_in != 27 || in_sizes[0] != T * D || out_size != T * D || ws_size < WS_END) {
            fprintf(stderr, "kernel_launch: unexpected shapes (n_in %d, in0 %d, out %d, ws %zu; need ws >= %zu); nothing launched\n", n_in, n_in > 0 ? in_sizes[0] : -1, out_size, ws_size, (size_t)WS_END); grid = -1; return; }
        int dev = 0, cus = 0, per_cu = 0;
        if (hipGetDevice(&dev) != hipSuccess || hipDeviceGetAttribute(&cus, hipDeviceAttributeMultiprocessorCount, dev) != hipSuccess) { grid = -1; return; }
        if (hipFuncSetAttribute((const void*)fwd_kernel, hipFuncAttributeMaxDynamicSharedMemorySize, LDS_BYTES) != hipSuccess) { fprintf(stderr, "kernel_launch: hipFuncSetAttribute failed\n"); grid = -1; return; }
        if (hipOccupancyMaxActiveBlocksPerMultiprocessor(&per_cu, (const void*)fwd_kernel, NWAVES * 64, LDS_BYTES) != hipSuccess || per_cu < 1)
            fprintf(stderr, "kernel_launch: note: occupancy query reports %d workgroups per CU\n", per_cu);
        (void)hipGetLastError();
        grid = cus;
    }
    if (grid < 0) return;
    if (hipMemsetAsync((char*)d_ws + WS_CTL, 0, CTL_ZERO_BYTES, stream) != hipSuccess) return;
    Args a{};
    for (int i = 0; i < 27; ++i) a.in[i] = (const float*)d_in[i];
    a.out = (float*)d_out; a.ws = (unsigned char*)d_ws;
    hipLaunchKernelGGL(fwd_kernel, dim3(grid), dim3(NWAVES * 64), LDS_BYTES, stream, a);
}
```

```cpp
#include <hip/hip_runtime.h>
#include <cstdio>
#include <cstdint>

#define LAS __attribute__((address_space(3)))
typedef unsigned short bf16;
typedef short bf16x8 __attribute__((ext_vector_type(8)));
typedef short s16x4 __attribute__((ext_vector_type(4)));
typedef float f32x4 __attribute__((ext_vector_type(4)));
typedef float f32x2 __attribute__((ext_vector_type(2)));
typedef float f32x16 __attribute__((ext_vector_type(16)));
typedef unsigned u32x4 __attribute__((ext_vector_type(4)));
typedef unsigned u32x2 __attribute__((ext_vector_type(2)));
typedef int i32x4 __attribute__((ext_vector_type(4)));
typedef int i32x8 __attribute__((ext_vector_type(8)));
typedef short s16x16 __attribute__((ext_vector_type(16)));
typedef __bf16 bf2_t __attribute__((ext_vector_type(2)));
#define DI __device__ __forceinline__
#define GASP __attribute__((address_space(1)))
template <class T> DI T* as_global(T* p) { return (T*)(GASP T*)p; }
#ifndef PHM
#define PHM 0xFFFFF
#endif
#define PH(b) if (PHM & (1 << (b)))
#ifndef RG
#define RG 0
#endif
#define RPT(g) for (int rep_ = 0, nrep_ = rep_count(((RG) >> (g)) & 1); rep_ < nrep_; ++rep_)
#define UFRESH(F) do { asm volatile("" : "+s"((F).ws), "+s"((F).out), "+s"((F).G), "+s"((F).bid)); (F).ctl = (unsigned*)((F).ws + WS_CTL); } while (0)
#define FRESH(F) do { UFRESH(F); int l_ = lane_id(); asm volatile("" : "+v"(l_)); (F).lane = l_; (F).tid = (F).wave * 64 + l_; } while (0)

constexpr int NWAVES = 8;
constexpr int BATCH = 32, SEQ = 2048, D = 1024, T = BATCH * SEQ;
constexpr int INW = 1792, FF = 2816, NE = 8;
constexpr float ALPHA = 1.6817928305074290f;
constexpr float LN_EPS = 1e-5f;
constexpr float QSCALE = 0.18033688011112042f;
constexpr float LOG2E = 1.4426950408889634f;

constexpr size_t MiB = 1u << 20;
constexpr size_t WS_CTL = 0, CTL_ZERO_BYTES = 1 * MiB;
constexpr size_t WS_ROPE = 1 * MiB;
constexpr size_t WS_RECI = 2 * MiB;
constexpr size_t WS_RECW = 3 * MiB;
constexpr size_t WS_SGUW = 4 * MiB;
constexpr size_t WS_SX = 5 * MiB;
constexpr size_t WS_SW = 6 * MiB;
constexpr size_t WS_SWD = 9 * MiB;
constexpr size_t WS_SXS = 7 * MiB;
constexpr size_t WS_W = 16 * MiB;
constexpr size_t WS_XB = 156 * MiB;
constexpr size_t WS_Y = 284 * MiB;
constexpr size_t WS_R = 412 * MiB;
constexpr size_t WS_Q = WS_R, WS_K = WS_Q + 64 * MiB, WS_V = WS_K + 16 * MiB, WS_ZU = WS_V + 16 * MiB, WS_ZV = WS_ZU + 64 * MiB, WS_MIX = WS_ZV + 64 * MiB;
constexpr size_t WS_H = WS_R;
constexpr size_t WS_YF = WS_R;
constexpr size_t WS_YG = WS_R + 256 * MiB;
constexpr int XS_ROWS = 2 * T + NE * 256;
constexpr int TC_MAX = 264;
constexpr size_t WS_XB8 = 768 * MiB;
constexpr size_t WS_XS = 284 * MiB;
constexpr size_t WS_HS = 416 * MiB;
constexpr size_t WS_YS = 600 * MiB;
constexpr size_t WS_END = 860 * MiB;
constexpr size_t W_IN = 0, W_OUT = 4 * MiB, W_GU = 6 * MiB, W_DN = 17 * MiB;
constexpr size_t W_GLU = 0, W_MGU = 4 * MiB, W_MDN = 48 * MiB;
constexpr int CW_TMO = 0, CW_DBG = 2, CW_BAR = 4096, CW_CNT = 8192;
constexpr int CW_WMAX = 65536;

constexpr int RING_BYTES = 131072;
constexpr int LDSCTL_OFF = RING_BYTES, MISC_OFF = LDSCTL_OFF + 320;
constexpr int LDS_BYTES = 147456;

DI unsigned pk2(float lo, float hi) { f32x2 v = {lo, hi}; return __builtin_bit_cast(unsigned, __builtin_convertvector(v, bf2_t)); }
DI unsigned q8(float v, float inv) { return __float_as_uint(__builtin_fmaf(v, inv, 12582912.0f)) & 0xffu; }
DI unsigned pk4_i8(float a, float b, float c, float d, float inv) { return q8(a, inv) | (q8(b, inv) << 8) | (q8(c, inv) << 16) | (q8(d, inv) << 24); }
DI unsigned pk4_fp8(float a, float b, float c, float d) { int w = 0; w = __builtin_amdgcn_cvt_pk_fp8_f32(a, b, w, false); w = __builtin_amdgcn_cvt_pk_fp8_f32(c, d, w, true); return (unsigned)w; }
DI float bf_lo(unsigned w) { return __uint_as_float(w << 16); }
DI float bf_hi(unsigned w) { return __uint_as_float(w & 0xffff0000u); }
DI float fast_exp2(float x) { return __builtin_amdgcn_exp2f(x); }
DI float fast_rcp(float x) { return __builtin_amdgcn_rcpf(x); }
DI float sigmoidf_(float x) { return fast_rcp(1.0f + fast_exp2(-LOG2E * x)); }
DI float gelu_tanh(float x) { const float z = x + 0.044715f * x * x * x; return x * fast_rcp(1.0f + fast_exp2(-2.302208198f * z)); }
#define dpp_f(v, ctrl) __int_as_float(__builtin_amdgcn_mov_dpp(__float_as_int(v), (ctrl), 0xf, 0xf, true))
#define DPP_XOR1 0xB1
#define DPP_XOR2 0x4E
#define DPP_HMIRROR 0x141
#define DPP_MIRROR 0x140
DI float swz16_f(float v) { return __int_as_float(__builtin_amdgcn_ds_swizzle(__float_as_int(v), 0x401F)); }
DI float sum_x32(float v) { auto r = __builtin_amdgcn_permlane32_swap(__float_as_uint(v), __float_as_uint(v), false, false); return __uint_as_float(r[0]) + __uint_as_float(r[1]); }
DI float max_x32(float v) { auto r = __builtin_amdgcn_permlane32_swap(__float_as_uint(v), __float_as_uint(v), false, false); return fmaxf(__uint_as_float(r[0]), __uint_as_float(r[1])); }
DI float wave_max(float v) {
    v = fmaxf(v, dpp_f(v, DPP_XOR1)); v = fmaxf(v, dpp_f(v, DPP_XOR2)); v = fmaxf(v, dpp_f(v, DPP_HMIRROR)); v = fmaxf(v, dpp_f(v, DPP_MIRROR)); v = fmaxf(v, swz16_f(v)); return max_x32(v);
}
DI float wave_sum(float v) {
    v += dpp_f(v, DPP_XOR1); v += dpp_f(v, DPP_XOR2); v += dpp_f(v, DPP_HMIRROR); v += dpp_f(v, DPP_MIRROR); v += swz16_f(v); return sum_x32(v);
}
#define LDS_WAIT() asm volatile("s_waitcnt lgkmcnt(0)" ::: "memory")
#define VM_WAIT() asm volatile("s_waitcnt vmcnt(0)" ::: "memory")
DI int lane_id() { unsigned ones = ~0u; asm volatile("" : "+s"(ones)); return (int)__builtin_amdgcn_mbcnt_hi(ones, __builtin_amdgcn_mbcnt_lo(ones, 0u)); }
DI int rep_count(int extra) { int n = 1 + extra; asm volatile("" : "+s"(n)); return n; }
DI int crow(int reg, int h) { return (reg & 3) + 8 * (reg >> 2) + 4 * h; }
#define MFMA32(a, b, c) __builtin_amdgcn_mfma_f32_32x32x16_bf16((a), (b), (c), 0, 0, 0)
#define MFMA16(a, b, c) __builtin_amdgcn_mfma_f32_16x16x32_bf16((a), (b), (c), 0, 0, 0)

DI void sincos_d(double th, double& s, double& c) {
    const double tq = th * 0.63661977236758134308;
    const double q = rint(tq);
    const double f = (tq - q) * 1.57079632679489661923;
    const double f2 = f * f;
    const double sp = f * (1.0 + f2 * (-1.0 / 6 + f2 * (1.0 / 120 + f2 * (-1.0 / 5040 + f2 * (1.0 / 362880 + f2 * (-1.0 / 39916800 + f2 * (1.0 / 6227020800.0)))))));
    const double cp = 1.0 + f2 * (-0.5 + f2 * (1.0 / 24 + f2 * (-1.0 / 720 + f2 * (1.0 / 40320 + f2 * (-1.0 / 3628800 + f2 * (1.0 / 479001600.0 + f2 * (-1.0 / 87178291200.0)))))));
    const int qi = ((int)q) & 3;
    s = (qi == 0) ? sp : (qi == 1) ? cp : (qi == 2) ? -sp : -cp;
    c = (qi == 0) ? cp : (qi == 1) ? -sp : (qi == 2) ? -cp : sp;
}
DI double exp_d(double x) {
    const double n = rint(x * 1.4426950408889634074);
    const double r = x - n * 0.69314718055994530942;
    double p = 1.0 / 87178291200.0;
    p = p * r + 1.0 / 6227020800.0; p = p * r + 1.0 / 479001600.0; p = p * r + 1.0 / 39916800.0; p = p * r + 1.0 / 3628800.0; p = p * r + 1.0 / 362880.0;
    p = p * r + 1.0 / 40320.0; p = p * r + 1.0 / 5040.0; p = p * r + 1.0 / 720.0; p = p * r + 1.0 / 120.0; p = p * r + 1.0 / 24.0; p = p * r + 1.0 / 6.0; p = p * r + 0.5; p = p * r + 1.0; p = p * r + 1.0;
    const long long bits = (long long)((int)n + 1023) << 52;
    return p * __builtin_bit_cast(double, bits);
}

namespace pg8 {
constexpr int SCALE_LDS_OFF = 131072 + 1024;
constexpr int BM = 256, BK = 64, HALF = 128, HTB = HALF * BK * 2, STAGE_BYTES = 8 * HTB, NXCD = 8, WGM = 8;
DI int lds_byte(int r, int c) { const int st = (r >> 4) * 2 + (c >> 5), rr = r & 15, cc = c & 31, ob = rr * 64 + cc * 2; return st * 1024 + (ob ^ (((ob >> 9) & 1) << 5)); }
DI void stage_rc(int b, int& R, int& C) { const int st = b / 1024, sb = b % 1024, swz = sb ^ (((sb >> 9) & 1) << 5); R = (st >> 1) * 16 + swz / 64; C = (st & 1) * 32 + (swz % 64) / 2; }
DI int perm32(int rho) { const int n = rho >> 4, i = rho & 15; return 8 * (i >> 2) + 4 * n + (i & 3); }

struct Unit { int pm, pn, row0, arow0, e; const char* a; const char* b; };
struct Order {
    int nM, nN, nwg, G, c, atile0, otile0, etile0;
    const char* A; const char* Bt; size_t tstep, estride;
    int tb[8];
    DI bool next(int i, Unit& u) const {
        const long L = (long)i * G + c; if (L >= nwg) return false;
        int wgid = (int)L; { const int q = nwg / NXCD, r = nwg % NXCD, xcd = wgid % NXCD, off = wgid / NXCD; wgid = (xcd < r ? xcd * (q + 1) : r * (q + 1) + (xcd - r) * q) + off; }
        const int nig = WGM * nN, gid = wgid / nig, fm = gid * WGM, gsz = (nM - fm) < WGM ? (nM - fm) : WGM;
        u.pm = fm + ((wgid % nig) % gsz); u.pn = (wgid % nig) / gsz;
        u.row0 = (otile0 + u.pm) * BM;
        int e = 0;
        if (estride) { const int t = etile0 + u.pm;
#pragma unroll
            for (int j = 1; j < 8; ++j) e += (t >= tb[j]) ? 1 : 0; }
        u.e = e; u.arow0 = (atile0 + u.pm) * BM;
        u.a = A + (size_t)(atile0 + u.pm) * tstep; u.b = Bt + (size_t)e * estride + (size_t)u.pn * tstep;
        return true;
    }
};

template <class Epi, int MODE = 0>
DI void gemm_phase(LAS unsigned char* lds, const int K, const Order& S, const Epi& E, const int wid) {
    int lane = lane_id(); asm volatile("" : "+v"(lane));
    const int tid = wid * 64 + lane, wr = wid >> 2, wc = wid & 3, fr = lane & 15, fq = lane >> 4;
    const int nt = K / BK;
    unsigned voffA[2], voffB[2];
#pragma unroll
    for (int i = 0; i < 2; ++i) { int R, C; stage_rc(tid * 16 + i * 8192, R, C); const int Rb = (R & ~31) + perm32(R & 31);
        voffA[i] = (unsigned)(R * K + C) * 2u; voffB[i] = (unsigned)(Rb * K + C) * 2u; }
    const size_t kstep = (size_t)(BK * 2);
    const size_t hstep = (size_t)HALF * K * 2;
    const unsigned ldsw = (unsigned)wid * 1024u;
    constexpr bool I8 = (MODE == 1), F8 = (MODE == 2);
    const int aoff = F8 ? lds_byte(wr * 64 + fr, 32 * (fq >> 1) + 16 * (fq & 1)) : lds_byte(wr * 64 + fr, fq * 8), boff = F8 ? lds_byte(wc * 32 + fr, 32 * (fq >> 1) + 16 * (fq & 1)) : lds_byte(wc * 32 + fr, fq * 8);
#define PG8_SA(b, h) (((b) * 2 + (h)) * HTB)
#define PG8_SB(b, h) ((4 + (b) * 2 + (h)) * HTB)
#define PG8_STAGE(bufoff, gbase, voff) do { _Pragma("unroll") for (int _i = 0; _i < 2; ++_i) \
        __builtin_amdgcn_global_load_lds((const unsigned*)((const char*)(gbase) + (voff)[_i]), (LAS unsigned*)(lds + (bufoff) + ldsw + _i * 8192), 16, 0, 0); } while (0)
#define PG8_LDA(dst, b, h) do { _Pragma("unroll") for (int m = 0; m < 4; ++m) { if constexpr (F8) dst##8[m] = __builtin_bit_cast(i32x8, __builtin_shufflevector(*(const LAS bf16x8*)(lds + PG8_SA(b, h) + aoff + m * 2048), *(const LAS bf16x8*)(lds + PG8_SA(b, h) + aoff + m * 2048 + 16), 0, 1, 2, 3, 4, 5, 6, 7, 8, 9, 10, 11, 12, 13, 14, 15)); \
        else { _Pragma("unroll") for (int k = 0; k < 2; ++k) dst[m][k] = *(const LAS bf16x8*)(lds + PG8_SA(b, h) + aoff + m * 2048 + k * 1024); } } } while (0)
#define PG8_LDB(dst, b, h) do { _Pragma("unroll") for (int n = 0; n < 2; ++n) { if constexpr (F8) dst##8[n] = __builtin_bit_cast(i32x8, __builtin_shufflevector(*(const LAS bf16x8*)(lds + PG8_SB(b, h) + boff + n * 2048), *(const LAS bf16x8*)(lds + PG8_SB(b, h) + boff + n * 2048 + 16), 0, 1, 2, 3, 4, 5, 6, 7, 8, 9, 10, 11, 12, 13, 14, 15)); \
        else { _Pragma("unroll") for (int k = 0; k < 2; ++k) dst[n][k] = *(const LAS bf16x8*)(lds + PG8_SB(b, h) + boff + n * 2048 + k * 1024); } } } while (0)
#define PG8_MMA(ai, bj, At, Bt) do { __builtin_amdgcn_s_setprio(1); _Pragma("unroll") for (int m = 0; m < 4; ++m) _Pragma("unroll") for (int n = 0; n < 2; ++n) { \
        if constexpr (F8) asm volatile("v_mfma_scale_f32_16x16x128_f8f6f4 %0, %1, %2, %0, %3, %3 op_sel_hi:[0,0,0]" : "+v"(acc[ai][bj][m][n]) : "v"(Bt##8[n]), "v"(At##8[m]), "v"(scale1)); \
        else { _Pragma("unroll") for (int k = 0; k < 2; ++k) \
        { if constexpr (I8) acc[ai][bj][m][n] = __builtin_bit_cast(f32x4, __builtin_amdgcn_mfma_i32_16x16x64_i8(__builtin_bit_cast(i32x4, Bt[n][k]), __builtin_bit_cast(i32x4, At[m][k]), __builtin_bit_cast(i32x4, acc[ai][bj][m][n]), 0, 0, 0)); \
          else acc[ai][bj][m][n] = __builtin_amdgcn_mfma_f32_16x16x32_bf16(Bt[n][k], At[m][k], acc[ai][bj][m][n], 0, 0, 0); } } } __builtin_amdgcn_s_setprio(0); } while (0)
#define PG8_WAIT_V(n) asm volatile("s_waitcnt vmcnt(" #n ")" ::: "memory")
#define PG8_WAIT_L(n) asm volatile("s_waitcnt lgkmcnt(" #n ")" ::: "memory")
#define PG8_BAR __builtin_amdgcn_s_barrier()
#define PG8_SCHED __builtin_amdgcn_sched_barrier(0)
    Unit cur, nxt; int ui = 0;
    if (!S.next(0, cur)) return;
    f32x4 acc[2][2][4][2];
#pragma unroll
    for (int a = 0; a < 2; ++a)
#pragma unroll
        for (int b = 0; b < 2; ++b)
#pragma unroll
            for (int m = 0; m < 4; ++m)
#pragma unroll
                for (int n = 0; n < 2; ++n) acc[a][b][m][n] = (f32x4){0.f, 0.f, 0.f, 0.f};
    const int scale1 = 0x7F7F7F7F;
    bf16x8 At[4][2], B0[2][2], B1[2][2]; i32x8 At8[4], B08[2], B18[2];
    const char* cA = cur.a; const char* cB = cur.b;
    PG8_STAGE(PG8_SB(0, 0), cB, voffB); PG8_STAGE(PG8_SB(0, 1), cB + hstep, voffB); PG8_STAGE(PG8_SA(0, 0), cA, voffA); PG8_STAGE(PG8_SA(0, 1), cA + hstep, voffA);
    if (wr == 1) PG8_BAR;
    PG8_WAIT_V(2); PG8_BAR;
    PG8_STAGE(PG8_SB(1, 0), cB + kstep, voffB); PG8_STAGE(PG8_SA(1, 0), cA + kstep, voffA); PG8_STAGE(PG8_SB(1, 1), cB + hstep + kstep, voffB);
    PG8_WAIT_V(6); PG8_BAR;
    for (;;) {
        const bool has_next = S.next(ui + 1, nxt);
        const char* nA = has_next ? nxt.a : cA; const char* nB = has_next ? nxt.b : cB;
#pragma unroll 1
        for (int t = 0; t < nt; t += 2) {
            const bool last = (t == nt - 2);
            const char* a1 = cA + (size_t)(t + 1) * kstep;
            const char* a2 = last ? nA : cA + (size_t)(t + 2) * kstep; const char* b2 = last ? nB : cB + (size_t)(t + 2) * kstep;
            const char* a3 = a2 + kstep; const char* b3 = b2 + kstep;
            if constexpr (Epi::STAGED) { if (last) E.stage(lds + SCALE_LDS_OFF, cur, wid, lane); }
            PG8_LDB(B0, 0, 0); PG8_LDB(B1, 0, 1); PG8_SCHED; PG8_LDA(At, 0, 0); PG8_STAGE(PG8_SA(1, 1), a1 + hstep, voffA);
            PG8_WAIT_V(8); PG8_WAIT_L(0); PG8_BAR; PG8_MMA(0, 0, At, B0); PG8_MMA(0, 1, At, B1); PG8_BAR; PG8_SCHED;
            PG8_LDA(At, 0, 1); PG8_STAGE(PG8_SB(0, 0), b2, voffB); PG8_STAGE(PG8_SB(0, 1), b2 + hstep, voffB); PG8_STAGE(PG8_SA(0, 0), a2, voffA);
            PG8_WAIT_V(8); PG8_WAIT_L(0); PG8_BAR; PG8_MMA(1, 0, At, B0); PG8_MMA(1, 1, At, B1); PG8_BAR; PG8_SCHED;
            PG8_LDB(B0, 1, 0); PG8_LDB(B1, 1, 1); PG8_SCHED; PG8_LDA(At, 1, 0); PG8_STAGE(PG8_SA(0, 1), a2 + hstep, voffA);
            PG8_WAIT_V(8); PG8_WAIT_L(0); PG8_BAR; PG8_MMA(0, 0, At, B0); PG8_MMA(0, 1, At, B1); PG8_BAR; PG8_SCHED;
            PG8_LDA(At, 1, 1); PG8_STAGE(PG8_SB(1, 0), b3, voffB); PG8_STAGE(PG8_SB(1, 1), b3 + hstep, voffB); PG8_STAGE(PG8_SA(1, 0), a3, voffA);
            PG8_WAIT_V(8); PG8_WAIT_L(0); PG8_BAR; PG8_MMA(1, 0, At, B0); PG8_MMA(1, 1, At, B1); PG8_BAR; PG8_SCHED;
        }
        if (wr == 0) PG8_BAR;
        if constexpr (F8) asm volatile("s_nop 15\n\ts_nop 7" ::: "memory");
        if constexpr (Epi::STAGED) E(acc, cur, wr, wc, fr, fq, lds + SCALE_LDS_OFF); else E(acc, cur, wr, wc, fr, fq);
        if (!has_next) break;
#pragma unroll
        for (int a = 0; a < 2; ++a)
#pragma unroll
            for (int b = 0; b < 2; ++b)
#pragma unroll
                for (int m = 0; m < 4; ++m)
#pragma unroll
                    for (int n = 0; n < 2; ++n) acc[a][b][m][n] = (f32x4){0.f, 0.f, 0.f, 0.f};
        cur = nxt; cA = nA; cB = nB; ++ui;
        if (wr == 1) PG8_BAR;
    }
    PG8_WAIT_V(0);
    PG8_BAR;
#undef PG8_SA
#undef PG8_SB
#undef PG8_STAGE
#undef PG8_LDA
#undef PG8_LDB
#undef PG8_MMA
#undef PG8_WAIT_V
#undef PG8_WAIT_L
#undef PG8_BAR
#undef PG8_SCHED
}

DI u32x4 pack8(const f32x4 a, const f32x4 b) { u32x4 w; w.x = pk2(a[0], a[1]); w.y = pk2(a[2], a[3]); w.z = pk2(b[0], b[1]); w.w = pk2(b[2], b[3]); return w; }

DI f32x4 bfx4_lo(const u32x4 w) { return (f32x4){bf_lo(w.x), bf_hi(w.x), bf_lo(w.y), bf_hi(w.y)}; }
DI f32x4 bfx4_hi(const u32x4 w) { return (f32x4){bf_lo(w.z), bf_hi(w.z), bf_lo(w.w), bf_hi(w.w)}; }
template <bool RES, bool SC> struct EpiPlain {
    static constexpr bool STAGED = false;
    bf16* O; int ldc; const bf16* R; const float* swd;
    DI void operator()(const f32x4 (&acc)[2][2][4][2], const Unit& u, int wr, int wc, int fr, int fq) const {
        asm volatile("" : "+v"(fr), "+v"(fq));
        const int row0 = u.row0 + wr * 64 + fr, col0 = u.pn * BM + wc * 32 + 8 * fq;
        f32x4 cs[2][2];
#pragma unroll
        for (int bj = 0; bj < 2; ++bj)
#pragma unroll
            for (int n = 0; n < 2; ++n) cs[bj][n] = SC ? *(const f32x4*)(swd + (size_t)u.e * D + col0 + bj * HALF + 4 * n) : (f32x4){1.f, 1.f, 1.f, 1.f};
#define ACS(ai, bj, m, n) (SC ? acc[ai][bj][m][n] * cs[bj][n] : acc[ai][bj][m][n])
        if constexpr (RES) {
#pragma unroll
            for (int hb = 0; hb < 2; ++hb) {
                u32x4 r0[4], r1[4];
#pragma unroll
                for (int m = 0; m < 4; ++m) { const size_t off = (size_t)(row0 + hb * HALF + m * 16) * ldc + col0; r0[m] = *(const u32x4*)(R + off); r1[m] = *(const u32x4*)(R + off + HALF); }
                asm volatile("" ::: "memory");
#pragma unroll
                for (int m = 0; m < 4; ++m) { const int ai = hb; const size_t off = (size_t)(row0 + ai * HALF + m * 16) * ldc + col0;
                    *(u32x4*)(O + off) = pack8(ACS(ai, 0, m, 0) + bfx4_lo(r0[m]) * ALPHA, ACS(ai, 0, m, 1) + bfx4_hi(r0[m]) * ALPHA);
                    *(u32x4*)(O + off + HALF) = pack8(ACS(ai, 1, m, 0) + bfx4_lo(r1[m]) * ALPHA, ACS(ai, 1, m, 1) + bfx4_hi(r1[m]) * ALPHA); }
                asm volatile("" ::: "memory");
            }
        } else {
#pragma unroll
            for (int ai = 0; ai < 2; ++ai)
#pragma unroll
                for (int m = 0; m < 4; ++m) { const size_t off = (size_t)(row0 + ai * HALF + m * 16) * ldc + col0;
#pragma unroll
                    for (int bj = 0; bj < 2; ++bj) *(u32x4*)(O + off + bj * HALF) = pack8(ACS(ai, bj, m, 0), ACS(ai, bj, m, 1)); }
        }
    }
#undef ACS
};
template <int ACT, bool RES> struct EpiPair {
    static constexpr bool STAGED = false;
    bf16* O; int ldc; const bf16* R;
    DI void operator()(const f32x4 (&acc)[2][2][4][2], const Unit& u, int wr, int wc, int fr, int fq) const {
        asm volatile("" : "+v"(fr), "+v"(fq));
        const int row0 = u.row0 + wr * 64 + fr, col0 = u.pn * HALF + wc * 32 + 8 * fq;
        u32x4 r[8];
#pragma unroll
        for (int g = 0; g < 8; ++g) { r[g] = (u32x4){0u, 0u, 0u, 0u}; if constexpr (RES) r[g] = *(const u32x4*)(R + (size_t)(row0 + (g >> 2) * HALF + (g & 3) * 16) * ldc + col0); }
        if constexpr (RES) asm volatile("" ::: "memory");
#pragma unroll
        for (int g = 0; g < 8; ++g) { const int ai = g >> 2, m = g & 3;
            const size_t off = (size_t)(row0 + ai * HALF + m * 16) * ldc + col0;
            f32x4 o[2];
            if constexpr (RES) { o[0] = bfx4_lo(r[g]) * ALPHA; o[1] = bfx4_hi(r[g]) * ALPHA; } else { o[0] = (f32x4){0.f, 0.f, 0.f, 0.f}; o[1] = o[0]; }
#pragma unroll
            for (int n = 0; n < 2; ++n) { const f32x4 a = acc[ai][0][m][n], b = acc[ai][1][m][n];
#pragma unroll
                for (int j = 0; j < 4; ++j) o[n][j] += (ACT == 0) ? a[j] * sigmoidf_(a[j]) * b[j] : a[j] * sigmoidf_(b[j]); }
            *(u32x4*)(O + off) = pack8(o[0], o[1]); }
    }
};
struct EpiPairI8 {
    static constexpr bool STAGED = true;
    unsigned char* O;     int ldc; const float* sx; const float* sw;
    DI void stage(LAS unsigned char* lds_sc, const Unit& u, int wid, int lane) const {
        const int wr = wid >> 2, wc = wid & 3;
        LAS unsigned* base = (LAS unsigned*)(lds_sc + 768 * wid);
        __builtin_amdgcn_global_load_lds((const unsigned*)(sw + (size_t)u.e * (2 * FF) + u.pn * BM + (lane >> 5) * HALF + wc * 32 + (lane & 31)), base, 4, 0, 0);
        __builtin_amdgcn_global_load_lds((const unsigned*)(sx + u.arow0 + wr * 64 + lane), base + 64, 4, 0, 0);
        __builtin_amdgcn_global_load_lds((const unsigned*)(sx + u.arow0 + HALF + wr * 64 + lane), base + 128, 4, 0, 0);
    }
    DI void operator()(const f32x4 (&acc)[2][2][4][2], const Unit& u, int wr, int wc, int fr, int fq, const LAS unsigned char* lds_sc) const {
        asm volatile("" : "+v"(fr), "+v"(fq));
        const int rloc = wr * 64 + fr, col0 = u.pn * HALF + wc * 32 + 8 * fq;
        const LAS unsigned char* wb = lds_sc + 768 * (wr * 4 + wc);
        f32x4 sg[2], su[2];
#pragma unroll
        for (int n = 0; n < 2; ++n) { sg[n] = __builtin_bit_cast(f32x4, *(const LAS bf16x8*)(wb + 4 * (8 * fq + 4 * n))); su[n] = __builtin_bit_cast(f32x4, *(const LAS bf16x8*)(wb + 4 * (32 + 8 * fq + 4 * n))); }
        float srv[8];
#pragma unroll
        for (int g = 0; g < 8; ++g) { typedef short s16x2 __attribute__((ext_vector_type(2))); srv[g] = __builtin_bit_cast(float, *(const LAS s16x2*)(wb + 4 * (64 + (g >> 2) * 64 + (g & 3) * 16 + fr))); }
#pragma unroll
        for (int ai = 0; ai < 2; ++ai)
#pragma unroll
            for (int m = 0; m < 4; ++m) {
                const int rr = rloc + ai * HALF + m * 16;
                const float sr = srv[ai * 4 + m];
                f32x4 o[2];
#pragma unroll
                for (int n = 0; n < 2; ++n) {
                    const f32x4 a = __builtin_convertvector(__builtin_bit_cast(i32x4, acc[ai][0][m][n]), f32x4) * (sg[n] * sr);
                    const f32x4 b = __builtin_convertvector(__builtin_bit_cast(i32x4, acc[ai][1][m][n]), f32x4) * (su[n] * sr);
                    const f32x4 t = a * (-LOG2E);
                    f32x4 e; e[0] = fast_exp2(t[0]); e[1] = fast_exp2(t[1]); e[2] = fast_exp2(t[2]); e[3] = fast_exp2(t[3]);
                    e = e + 1.0f;
                    f32x4 r; r[0] = fast_rcp(e[0]); r[1] = fast_rcp(e[1]); r[2] = fast_rcp(e[2]); r[3] = fast_rcp(e[3]);
                    o[n] = (a * r) * b; }
                u32x2 w8; w8.x = pk4_fp8(o[0][0], o[0][1], o[0][2], o[0][3]); w8.y = pk4_fp8(o[1][0], o[1][1], o[1][2], o[1][3]);
                *(u32x2*)(O + (size_t)(u.row0 + rr) * ldc + col0) = w8; }
    }
};
struct EpiWin {
    static constexpr bool STAGED = false;
    bf16 *Q, *Kb, *Vb, *ZU, *ZV; const float *cosT, *sinT, *lng, *lnb;
    DI void operator()(const f32x4 (&acc)[2][2][4][2], const Unit& u, int wr, int wc, int fr, int fq) const {
        asm volatile("" : "+v"(fr), "+v"(fq));
        const int rbase = u.row0 + wr * 64 + fr, pn = u.pn;
        if (pn < 2 || (pn == 2 && wc < 2)) {
            bf16* dst; int ld, colb; float sc;
            if (pn < 2) { dst = Q; ld = 512; colb = 64 * (4 * pn + wc); sc = QSCALE; } else { dst = Kb; ld = 128; colb = 64 * wc; sc = 1.0f; }
#pragma unroll
            for (int hb = 0; hb < 2; ++hb) {
                f32x4 cc[4][2], ss[4][2];
#pragma unroll
                for (int m = 0; m < 4; ++m) { const int pos = (rbase + hb * HALF + m * 16) & (SEQ - 1);
#pragma unroll
                    for (int n = 0; n < 2; ++n) { cc[m][n] = *(const f32x4*)(cosT + pos * 32 + 8 * fq + 4 * n); ss[m][n] = *(const f32x4*)(sinT + pos * 32 + 8 * fq + 4 * n); } }
                asm volatile("" ::: "memory");
#pragma unroll
                for (int m = 0; m < 4; ++m) { const int ai = hb; const int row = rbase + ai * HALF + m * 16;
                    f32x4 o1[2], o2[2];
#pragma unroll
                    for (int n = 0; n < 2; ++n) { const f32x4 x1 = acc[ai][0][m][n], x2 = acc[ai][1][m][n];
                        o1[n] = (x1 * cc[m][n] - x2 * ss[m][n]) * sc; o2[n] = (x2 * cc[m][n] + x1 * ss[m][n]) * sc; }
                    bf16* rp = dst + (size_t)row * ld + colb + 8 * fq;
                    *(u32x4*)(rp) = pack8(o1[0], o1[1]); *(u32x4*)(rp + 32) = pack8(o2[0], o2[1]); }
                asm volatile("" ::: "memory");
            }
        } else if (pn == 2) {
#pragma unroll
            for (int ai = 0; ai < 2; ++ai)
#pragma unroll
                for (int m = 0; m < 4; ++m) { int row = rbase + ai * HALF + m * 16; asm volatile("" : "+v"(row) :: "memory"); bf16* rp = Vb + (size_t)row * 128 + 64 * (wc - 2) + 8 * fq;
#pragma unroll
                    for (int bj = 0; bj < 2; ++bj) *(u32x4*)(rp + 32 * bj) = pack8(acc[ai][bj][m][0], acc[ai][bj][m][1]); }
        } else if (pn < 5) {
#pragma unroll
            for (int ai = 0; ai < 2; ++ai)
#pragma unroll
                for (int m = 0; m < 4; ++m) { int row = rbase + ai * HALF + m * 16; asm volatile("" : "+v"(row) :: "memory"); bf16* rp = ZU + (size_t)row * 512 + 256 * (pn - 3) + 64 * wc + 8 * fq;
#pragma unroll
                    for (int bj = 0; bj < 2; ++bj) { f32x4 a = acc[ai][bj][m][0], b = acc[ai][bj][m][1];
#pragma unroll
                        for (int j = 0; j < 4; ++j) { a[j] = gelu_tanh(a[j]); b[j] = gelu_tanh(b[j]); }
                        *(u32x4*)(rp + 32 * bj) = pack8(a, b); } }
        } else {
            const int gi = 4 * (pn - 5) + wc;
            f32x4 gg[2][2], bb[2][2];
#pragma unroll
            for (int bj = 0; bj < 2; ++bj)
#pragma unroll
                for (int n = 0; n < 2; ++n) { gg[bj][n] = *(const f32x4*)(lng + gi * 64 + 32 * bj + 8 * fq + 4 * n); bb[bj][n] = *(const f32x4*)(lnb + gi * 64 + 32 * bj + 8 * fq + 4 * n); }
#pragma unroll
            for (int ai = 0; ai < 2; ++ai)
#pragma unroll
                for (int m = 0; m < 4; ++m) { int row = rbase + ai * HALF + m * 16; asm volatile("" : "+v"(row) :: "memory");
                    f32x4 z[2][2]; float s = 0.f;
#pragma unroll
                    for (int bj = 0; bj < 2; ++bj)
#pragma unroll
                        for (int n = 0; n < 2; ++n) {
#pragma unroll
                            for (int j = 0; j < 4; ++j) { z[bj][n][j] = gelu_tanh(acc[ai][bj][m][n][j]); s += z[bj][n][j]; } }
                    s += swz16_f(s); s = sum_x32(s);
                    const float mean = s * (1.0f / 64.0f); float q = 0.f;
#pragma unroll
                    for (int bj = 0; bj < 2; ++bj)
#pragma unroll
                        for (int n = 0; n < 2; ++n) { z[bj][n] = z[bj][n] - mean; q += (z[bj][n][0] * z[bj][n][0] + z[bj][n][1] * z[bj][n][1]) + (z[bj][n][2] * z[bj][n][2] + z[bj][n][3] * z[bj][n][3]); }
                    q += swz16_f(q); q = sum_x32(q);
                    const float rstd = 1.0f / sqrtf(q * (1.0f / 64.0f) + LN_EPS);
                    bf16* rp = ZV + (size_t)row * 512 + 64 * gi + 8 * fq;
#pragma unroll
                    for (int bj = 0; bj < 2; ++bj) *(u32x4*)(rp + 32 * bj) = pack8(z[bj][0] * rstd * gg[bj][0] + bb[bj][0], z[bj][1] * rstd * gg[bj][1] + bb[bj][1]); asm volatile("" ::: "memory"); }
        }
    }
};
}

#define XB_TMO      128
#define XB_XCNT(j)  (256  + 64 * (j))
#define XB_XSUB(j)  (1280 + 64 * (j))
#define XB_XGEN(j)  (2304 + 64 * (j))
#define XB_TOP      3328
#define XB_TOPGEN   3392
#define XCD_BAR_WORDS 3456
#define XB_SPIN_CAP (1u << 22)
DI unsigned xb_ld(unsigned* p)              { return __hip_atomic_load(p, __ATOMIC_RELAXED, __HIP_MEMORY_SCOPE_AGENT); }
DI unsigned xb_add(unsigned* p, unsigned v) { return __hip_atomic_fetch_add(p, v, __ATOMIC_RELAXED, __HIP_MEMORY_SCOPE_AGENT); }
DI unsigned xb_xcc_id() { return (unsigned)__builtin_amdgcn_s_getreg((3 << 11) | 20) & 0xFu; }
#define XB_SPIN(cond, bar) do { unsigned _sp = 0; while (cond) { __builtin_amdgcn_s_sleep(1); \
    if ((++_sp & 255u) == 0u) { if (xb_ld(&(bar)[XB_TMO])) break; if (_sp > XB_SPIN_CAP) { atomicAdd(&(bar)[XB_TMO], 1u); break; } } } } while (0)
struct XcdBarrier { GASP unsigned* bar; unsigned x; volatile LAS unsigned* st; };
DI XcdBarrier xcd_barrier_post(GASP unsigned* bar, volatile LAS unsigned* st, bool leader) {
    XcdBarrier b; b.bar = bar; b.x = xb_xcc_id(); b.st = st;
    if (leader) (void)xb_add((unsigned*)&bar[XB_XCNT(b.x)], 1u);
    return b;
}
DI void xcd_barrier_complete(unsigned* bar, unsigned x, unsigned& nloc, unsigned& nx) {
    const unsigned G = gridDim.x * gridDim.y * gridDim.z;
    unsigned sum, cnt, mine, sp = 0u;
    for (;;) {
        sum = 0u; cnt = 0u; mine = 0u;
#pragma unroll
        for (unsigned j = 0; j < 16; ++j) { const unsigned c = xb_ld(&bar[XB_XCNT(j)]); sum += c; cnt += (c > 0u) ? 1u : 0u; mine = (j == x) ? c : mine; }
        if (sum == G) break;
        __builtin_amdgcn_s_sleep(1);
        if ((++sp & 255u) == 0u) { if (xb_ld(&bar[XB_TMO])) break; if (sp > XB_SPIN_CAP) { atomicAdd(&bar[XB_TMO], 1u); break; } }
    }
    nloc = mine > 0u ? mine : 1u; nx = cnt > 0u ? cnt : 1u;
}
DI void xcd_barrier(const XcdBarrier& b, int wave) {
    asm volatile("s_waitcnt vmcnt(0)" ::: "memory");
    __syncthreads();
    if (wave == 0 && lane_id() == 0) {
        GASP unsigned* barg = b.bar; unsigned bx = b.x; asm volatile("" : "+s"(barg), "+s"(bx)); unsigned* bar = (unsigned*)barg;
        __builtin_amdgcn_s_waitcnt(0);
        unsigned nloc = b.st[0], nx = b.st[1];
        if (nloc == 0u) { xcd_barrier_complete(bar, bx, nloc, nx); b.st[0] = nloc; b.st[1] = nx; }
        const unsigned old = xb_add(&bar[XB_XSUB(bx)], 1u);
        const unsigned gen = old / nloc;
        if (old + 1u == (gen + 1u) * nloc) {
            __builtin_amdgcn_fence(__ATOMIC_RELEASE, "agent");
            asm volatile("s_waitcnt vmcnt(0)" ::: "memory");
            const unsigned og = xb_add(&bar[XB_TOP], 1u);
            const unsigned tg = og / nx;
            if (og + 1u == (tg + 1u) * nx) xb_add(&bar[XB_TOPGEN], 1u);
            else XB_SPIN(xb_ld(&bar[XB_TOPGEN]) == tg, bar);
            __builtin_amdgcn_fence(__ATOMIC_ACQUIRE, "agent");
            xb_add(&bar[XB_XGEN(bx)], 1u);
            asm volatile("s_waitcnt vmcnt(0)" ::: "memory");
        } else {
            XB_SPIN(xb_ld(&bar[XB_XGEN(bx)]) == gen, bar);
            __builtin_amdgcn_fence(__ATOMIC_ACQUIRE, "agent");
            asm volatile("s_waitcnt vmcnt(0)" ::: "memory");
        }
    }
    __syncthreads();
}

struct Frame {
    LAS unsigned char* lds;
    volatile LAS unsigned* MISC;
    unsigned* ctl;
    int tid, lane, wave, G, bid;
    GASP unsigned char* ws;
    GASP float* out;
};
struct Args { const float* in[27]; float* out; unsigned char* ws; };
typedef const unsigned char __attribute__((address_space(4)))* kptr_t;
DI const float* in_ptr(int k) { kptr_t p = (kptr_t)__builtin_amdgcn_kernarg_segment_ptr(); asm volatile("" : "+s"(p)); return (const float*)(*(GASP const float* const __attribute__((address_space(4)))*)(p + 8 * k)); }
struct ArgsRef { struct Acc { DI const float* operator[](int k) const { return in_ptr(k); } } in; };

template <int MAP>
DI int conv_col(int nb2, int lane, bool& second) {
    second = false;
    if (MAP == 0) return 64 * nb2 + lane;
    const int pn = nb2 >> 2, bj = (nb2 >> 1) & 1, wcp = nb2 & 1;
    if (MAP == 2) { second = bj != 0; return 128 * pn + 64 * wcp + lane; }
    return 256 * pn + 128 * wcp + 32 * bj + 64 * (lane >> 5) + (lane & 31);
}
template <int MAP>
DI void conv_job(Frame& F, const float* s1, const float* s2, bf16* dst, int K, int ldw, int nblk64, int nexp) {
    const int gw = F.bid * NWAVES + F.wave, NGW = F.G * NWAVES, lane = F.lane;
    const int per = (K / 64) * nblk64, total = per * nexp;
    for (int it = gw; it < total; it += NGW) {
        const int e = it / per, r = it - e * per, kb = r / nblk64, nb2 = r - kb * nblk64;
        bool second; const int col = conv_col<MAP>(nb2, lane, second);
        const float* W = (second ? s2 : s1) + (size_t)e * K * ldw + (size_t)(64 * kb) * ldw + col;
        float v[64];
#pragma unroll
        for (int k = 0; k < 64; ++k) v[k] = W[(size_t)k * ldw];
        bf16* drow = dst + ((size_t)e * nblk64 * 64 + (size_t)nb2 * 64 + lane) * K + 64 * kb;
#pragma unroll
        for (int q = 0; q < 8; ++q) { u32x4 o; o.x = pk2(v[8 * q], v[8 * q + 1]); o.y = pk2(v[8 * q + 2], v[8 * q + 3]); o.z = pk2(v[8 * q + 4], v[8 * q + 5]); o.w = pk2(v[8 * q + 6], v[8 * q + 7]); *(u32x4*)(drow + 8 * q) = o; }
    }
}
template <int MAP>
DI void conv_job_i8(Frame& F, const float* s1, const float* s2, unsigned char* dst, float* swout, int ldw, int nblk64, int nexp) {
    constexpr int K = D, KW = K / NWAVES;
    LAS float* wmax = (LAS float*)(F.lds + 124 * 1024);
    LAS float* sinv = wmax + 512;
    const int lane = F.lane, w = F.wave;
    for (int it = F.bid; it < nblk64 * nexp; it += F.G) {
        const int e = it / nblk64, nb2 = it - e * nblk64;
        bool second; const int col = conv_col<MAP>(nb2, lane, second);
        const float* W = (second ? s2 : s1) + (size_t)e * K * ldw + (size_t)(KW * w) * ldw + col;
        float v[KW]; float mx = 0.f;
#pragma unroll
        for (int k = 0; k < KW; ++k) v[k] = W[(size_t)k * ldw];
#pragma unroll
        for (int k = 0; k < KW; ++k) mx = fmaxf(mx, fabsf(v[k]));
        wmax[w * 64 + lane] = mx;
        __syncthreads();
        if (w == 0) { float m = wmax[lane];
#pragma unroll
            for (int j = 1; j < 8; ++j) m = fmaxf(m, wmax[j * 64 + lane]);
            swout[(size_t)e * nblk64 * 64 + nb2 * 64 + lane] = m * (1.0f / 127.0f); sinv[lane] = m > 0.f ? 127.0f / m : 0.f; }
        __syncthreads();
        const float iv = sinv[lane];
        unsigned char* drow = dst + ((size_t)e * nblk64 * 64 + (size_t)nb2 * 64 + lane) * K + KW * w;
#pragma unroll
        for (int q = 0; q < KW / 16; ++q) { u32x4 o;
            o.x = pk4_i8(v[16 * q], v[16 * q + 1], v[16 * q + 2], v[16 * q + 3], iv); o.y = pk4_i8(v[16 * q + 4], v[16 * q + 5], v[16 * q + 6], v[16 * q + 7], iv);
            o.z = pk4_i8(v[16 * q + 8], v[16 * q + 9], v[16 * q + 10], v[16 * q + 11], iv); o.w = pk4_i8(v[16 * q + 12], v[16 * q + 13], v[16 * q + 14], v[16 * q + 15], iv);
            *(u32x4*)(drow + 16 * q) = o; }
        __syncthreads();
    }
}
DI void wmax_job(Frame& F, const float* s1, unsigned* wmax, int K, int ldw, int nexp) {
    const int gw = F.bid * NWAVES + F.wave, NGW = F.G * NWAVES, lane = F.lane;
    const int nb = ldw / 64, ks = K / 352, per = nb * ks, total = per * nexp;
    for (int it = gw; it < total; it += NGW) {
        const int e = it / per, r = it - e * per, kb = r / nb, nb2 = r - kb * nb;
        const float* W = s1 + (size_t)e * K * ldw + (size_t)(352 * kb) * ldw + 64 * nb2 + lane;
        float mx = 0.f;
#pragma unroll 32
        for (int k = 0; k < 352; ++k) mx = fmaxf(mx, fabsf(W[(size_t)k * ldw]));
        atomicMax(wmax + (size_t)e * ldw + 64 * nb2 + lane, __float_as_uint(mx));
    }
}
DI void conv_job_f8(Frame& F, const float* s1, unsigned char* dst, float* swout, const unsigned* wmax, int K, int ldw, int nblk64, int nexp) {
    const int gw = F.bid * NWAVES + F.wave, NGW = F.G * NWAVES, lane = F.lane;
    const int per = (K / 64) * nblk64, total = per * nexp;
    for (int it = gw; it < total; it += NGW) {
        const int e = it / per, r = it - e * per, kb = r / nblk64, nb2 = r - kb * nblk64;
        const float m = __uint_as_float(__hip_atomic_load(wmax + (size_t)e * ldw + 64 * nb2 + lane, __ATOMIC_RELAXED, __HIP_MEMORY_SCOPE_AGENT));
        const float iv = m > 0.f ? 256.0f / m : 0.f;
        if (kb == 0) swout[(size_t)e * nblk64 * 64 + nb2 * 64 + lane] = m * (1.0f / 256.0f);
        const float* W = s1 + (size_t)e * K * ldw + (size_t)(64 * kb) * ldw + 64 * nb2 + lane;
        float v[64];
#pragma unroll
        for (int k = 0; k < 64; ++k) v[k] = W[(size_t)k * ldw];
        unsigned char* drow = dst + ((size_t)e * nblk64 * 64 + (size_t)nb2 * 64 + lane) * K + 64 * kb;
#pragma unroll
        for (int q = 0; q < 4; ++q) { u32x4 o; o.x = pk4_fp8(v[16 * q] * iv, v[16 * q + 1] * iv, v[16 * q + 2] * iv, v[16 * q + 3] * iv); o.y = pk4_fp8(v[16 * q + 4] * iv, v[16 * q + 5] * iv, v[16 * q + 6] * iv, v[16 * q + 7] * iv);
            o.z = pk4_fp8(v[16 * q + 8] * iv, v[16 * q + 9] * iv, v[16 * q + 10] * iv, v[16 * q + 11] * iv); o.w = pk4_fp8(v[16 * q + 12] * iv, v[16 * q + 13] * iv, v[16 * q + 14] * iv, v[16 * q + 15] * iv);
            *(u32x4*)(drow + 16 * q) = o; }
    }
}
DI void wmax_layer(Frame& F, const ArgsRef& a, int L) {
    FRESH(F);
    const int i = L >> 1; unsigned* wm = F.ctl + CW_WMAX + (size_t)i * 9 * D;
    if ((L & 1) == 0) wmax_job(F, a.in[12] + (size_t)i * FF * D, wm + 8 * D, FF, D, 1);
    else wmax_job(F, a.in[26] + (size_t)i * NE * FF * D, wm, FF, D, NE);
}
DI void conv_down(Frame& F, const ArgsRef& a, int L) {
    FRESH(F);
    const int i = L >> 1; const unsigned* wm = F.ctl + CW_WMAX + (size_t)i * 9 * D; unsigned char* Wb8 = (unsigned char*)(F.ws + WS_W);
    if ((L & 1) == 0) conv_job_f8(F, a.in[12] + (size_t)i * FF * D, Wb8 + W_DN, (float*)(F.ws + WS_SWD), wm + 8 * D, FF, D, D / 64, 1);
    else conv_job_f8(F, a.in[26] + (size_t)i * NE * FF * D, Wb8 + W_MDN, (float*)(F.ws + WS_SWD), wm, FF, D, D / 64, NE);
}
DI void conv_layer(Frame& F, const ArgsRef& a, int L) {
    FRESH(F);
    bf16* Wb = (bf16*)(F.ws + WS_W);
    const int i = L >> 1;
    if ((L & 1) == 0) {
        conv_job<1>(F, a.in[3] + (size_t)i * D * INW, nullptr, (bf16*)((char*)Wb + W_IN), D, INW, INW / 64, 1);
        conv_job<0>(F, a.in[9] + (size_t)i * D * D, nullptr, (bf16*)((char*)Wb + W_OUT), D, D, D / 64, 1);
        conv_job_i8<2>(F, a.in[10] + (size_t)i * D * FF, a.in[11] + (size_t)i * D * FF, (unsigned char*)Wb + W_GU, (float*)(F.ws + WS_SW), FF, 2 * FF / 64, 1);
        const float* sw = a.in[5] + (size_t)i * 8 * 128 * 128; bf16* dw = (bf16*)(F.ws + WS_SGUW);
        for (int idx = F.bid * 512 + F.tid; idx < 8 * 128 * 128 / 4; idx += F.G * 512) { const f32x4 v = *(const f32x4*)(sw + 4 * idx); u32x2 o; o.x = pk2(v[0], v[1]); o.y = pk2(v[2], v[3]); *(u32x2*)(dw + 4 * idx) = o; }
    } else {
        conv_job<2>(F, a.in[21] + (size_t)i * D * D, a.in[22] + (size_t)i * D * D, (bf16*)((char*)Wb + W_GLU), D, D, 2 * D / 64, 1);
        conv_job_i8<2>(F, a.in[24] + (size_t)i * NE * D * FF, a.in[25] + (size_t)i * NE * D * FF, (unsigned char*)Wb + W_MGU, (float*)(F.ws + WS_SW), FF, 2 * FF / 64, NE);
    }
}

DI void prologue(Frame& F, const ArgsRef& a) {
    FRESH(F);
    const float* x = a.in[0]; bf16* XB = (bf16*)(F.ws + WS_XB);
    const size_t nthr = (size_t)F.G * 512, t0 = (size_t)F.bid * 512 + F.tid;
    for (size_t i = t0; i < (size_t)T * D / 8; i += nthr) { const f32x4 v0 = *(const f32x4*)(x + 8 * i), v1 = *(const f32x4*)(x + 8 * i + 4); *(u32x4*)(XB + 8 * i) = pg8::pack8(v0, v1); }
    float* cosT = (float*)(F.ws + WS_ROPE); float* sinT = cosT + SEQ * 32;
    for (size_t i = t0; i < (size_t)SEQ * 32; i += nthr) { const int pos = (int)(i >> 5), d = (int)(i & 31);
        const float invf = (float)exp_d(-(double)(2 * d) * (9.2103403719761836 / 64.0));
        const float ang = (float)pos * invf; double s, c; sincos_d((double)ang, s, c); cosT[i] = (float)c; sinT[i] = (float)s; }
}

DI void ln_core(f32x4 (&v)[4], const f32x4 (&g)[4], const f32x4 (&b)[4]) {
    float s = 0.f;
#pragma unroll
    for (int j = 0; j < 4; ++j) s += (v[j][0] + v[j][1]) + (v[j][2] + v[j][3]);
    const float mean = wave_sum(s) * (1.0f / D); float q = 0.f;
#pragma unroll
    for (int j = 0; j < 4; ++j) { v[j] = v[j] - mean; q += (v[j][0] * v[j][0] + v[j][1] * v[j][1]) + (v[j][2] * v[j][2] + v[j][3] * v[j][3]); }
    const float rstd = 1.0f / sqrtf(wave_sum(q) * (1.0f / D) + LN_EPS);
#pragma unroll
    for (int j = 0; j < 4; ++j) v[j] = v[j] * rstd * g[j] + b[j];
}
DI void ln_store(const f32x4 (&v)[4], bf16* XB, size_t row, int lane) {
#pragma unroll
    for (int j = 0; j < 4; ++j) { u32x2 o; o.x = pk2(v[j][0], v[j][1]); o.y = pk2(v[j][2], v[j][3]); *(u32x2*)(XB + row * D + 4 * lane + 256 * j) = o; }
}
DI void ln_load(f32x4 (&v)[4], const bf16* Y, size_t row, int lane) {
#pragma unroll
    for (int j = 0; j < 4; ++j) { const u32x2 yv = *(const u32x2*)(Y + row * D + 4 * lane + 256 * j); v[j] = (f32x4){bf_lo(yv.x), bf_hi(yv.x), bf_lo(yv.y), bf_hi(yv.y)}; }
}
DI void ln_pass_plain(Frame& F, const float* g_, const float* b_, const bool q8copy) {
    FRESH(F);
    const bf16* Y = (const bf16*)(F.ws + WS_Y); bf16* XB = (bf16*)(F.ws + WS_XB);
    f32x4 g[4], b[4];
#pragma unroll
    for (int j = 0; j < 4; ++j) { g[j] = *(const f32x4*)(g_ + 4 * F.lane + 256 * j); b[j] = *(const f32x4*)(b_ + 4 * F.lane + 256 * j); }
    const int gw = F.bid * NWAVES + F.wave, NGW = F.G * NWAVES;
    for (int row = gw; row < T; row += NGW) {
        f32x4 v[4]; ln_load(v, Y, (size_t)row, F.lane);
        ln_core(v, g, b);
        ln_store(v, XB, (size_t)row, F.lane);
        if (q8copy) {
            float mx = 0.f;
#pragma unroll
            for (int j = 0; j < 4; ++j) mx = fmaxf(mx, fmaxf(fmaxf(fabsf(v[j][0]), fabsf(v[j][1])), fmaxf(fabsf(v[j][2]), fabsf(v[j][3]))));
            mx = wave_max(mx);
            const float inv = mx > 0.f ? 127.0f / mx : 0.f;
            unsigned char* X8 = (unsigned char*)(F.ws + WS_XB8);
#pragma unroll
            for (int j = 0; j < 4; ++j) *(unsigned*)(X8 + (size_t)row * D + 4 * F.lane + 256 * j) = pk4_i8(v[j][0], v[j][1], v[j][2], v[j][3], inv);
            if (F.lane == 0) ((float*)(F.ws + WS_SX))[row] = mx * (1.0f / 127.0f);
        }
    }
}
DI void ln_pass_router(Frame& F, const float* g_, const float* b_, const float* rw_, unsigned* cnt, const size_t rec_off) {
    FRESH(F);
    const bf16* Y = (const bf16*)(F.ws + WS_Y); bf16* XB = (bf16*)(F.ws + WS_XB);
    i32x4* RECI = (i32x4*)(F.ws + WS_RECI + rec_off); f32x2* RECW = (f32x2*)(F.ws + WS_RECW + rec_off);
    LAS int* lcnt = (LAS int*)(F.lds); LAS int* lbase = lcnt + 8;
    LAS int* re0 = lcnt + 64; LAS int* re1 = re0 + 256; LAS int* rp0 = re1 + 256; LAS int* rp1 = rp0 + 256; LAS float* rw0 = (LAS float*)(rp1 + 256); LAS float* rw1 = rw0 + 256;
    f32x4 g[4], b[4];
#pragma unroll
    for (int j = 0; j < 4; ++j) { g[j] = *(const f32x4*)(g_ + 4 * F.lane + 256 * j); b[j] = *(const f32x4*)(b_ + 4 * F.lane + 256 * j); }
    f32x4 rwa[4][4], rwb[4][4];
#pragma unroll
    for (int j = 0; j < 4; ++j)
#pragma unroll
        for (int c = 0; c < 4; ++c) { const float* p = rw_ + (size_t)(4 * F.lane + 256 * j + c) * 8; rwa[j][c] = *(const f32x4*)p; rwb[j][c] = *(const f32x4*)(p + 4); }
    for (int pnl = F.bid; pnl < T / 256; pnl += F.G) {
        if (F.tid < 8) lcnt[F.tid] = 0;
        __syncthreads();
        for (int rr = 0; rr < 32; ++rr) {
            const int lr = F.wave + 8 * rr; const size_t row = (size_t)pnl * 256 + lr;
            f32x4 v[4]; ln_load(v, Y, row, F.lane);
            ln_core(v, g, b);
            ln_store(v, XB, row, F.lane);
            f32x4 la = {0.f, 0.f, 0.f, 0.f}, lb = {0.f, 0.f, 0.f, 0.f};
#pragma unroll
            for (int j = 0; j < 4; ++j)
#pragma unroll
                for (int c = 0; c < 4; ++c) { la += rwa[j][c] * v[j][c]; lb += rwb[j][c] * v[j][c]; }
            float lg[8];
#pragma unroll
            for (int e = 0; e < 4; ++e) { lg[e] = wave_sum(la[e]); lg[4 + e] = wave_sum(lb[e]); }
            int i0 = 0; float l0 = lg[0];
#pragma unroll
            for (int e = 1; e < 8; ++e) if (lg[e] > l0) { l0 = lg[e]; i0 = e; }
            int i1 = -1; float l1 = -3.0e38f;
#pragma unroll
            for (int e = 0; e < 8; ++e) if (e != i0 && lg[e] > l1) { l1 = lg[e]; i1 = e; }
            const float w0 = 1.0f / (1.0f + __expf(l1 - l0)), w1 = 1.0f - w0;
            if (F.lane == 0) { const int p0 = atomicAdd((int*)(lcnt + i0), 1), p1 = atomicAdd((int*)(lcnt + i1), 1);
                re0[lr] = i0; re1[lr] = i1; rp0[lr] = p0; rp1[lr] = p1; rw0[lr] = w0; rw1[lr] = w1; }
        }
        __syncthreads();
        if (F.tid < 8) lbase[F.tid] = (int)xb_add(cnt + F.tid, (unsigned)lcnt[F.tid]);
        __syncthreads();
        if (F.tid < 256) { const int e0 = re0[F.tid], e1 = re1[F.tid]; const size_t row = (size_t)pnl * 256 + F.tid;
            RECI[row] = (i32x4){e0, lbase[e0] + rp0[F.tid], e1, lbase[e1] + rp1[F.tid]}; RECW[row] = (f32x2){rw0[F.tid], rw1[F.tid]}; }
        __syncthreads();
    }
}
DI void moe_tiles(const unsigned* cnt, int (&tb)[9], int (&cn)[8]) {
    int acc = 0;
#pragma unroll
    for (int e = 0; e < 8; ++e) { cn[e] = __builtin_amdgcn_readfirstlane((int)__hip_atomic_load(cnt + e, __ATOMIC_RELAXED, __HIP_MEMORY_SCOPE_AGENT)); tb[e] = acc; acc += (cn[e] + 255) >> 8; }
    tb[8] = acc;
}
DI void moe_gather(Frame& F, const unsigned* cnt) {
    FRESH(F);
    int tb[9], cn[8]; moe_tiles(cnt, tb, cn);
    const bf16* XB = (const bf16*)(F.ws + WS_XB); unsigned char* XS = (unsigned char*)(F.ws + WS_XS); float* SXS = (float*)(F.ws + WS_SXS); const i32x4* RECI = (const i32x4*)(F.ws + WS_RECI);
    const int gw = F.bid * NWAVES + F.wave, NGW = F.G * NWAVES;
    for (int t = gw; t < T; t += NGW) {
        const i32x4 r = RECI[t];
        int b0 = 0, b1 = 0;
#pragma unroll
        for (int e = 0; e < 8; ++e) { b0 = (r[0] == e) ? tb[e] : b0; b1 = (r[2] == e) ? tb[e] : b1; }
        const size_t r0 = (size_t)b0 * 256 + r[1], r1 = (size_t)b1 * 256 + r[3];
        const u32x4 v0 = *(const u32x4*)(XB + (size_t)t * D + 8 * F.lane), v1 = *(const u32x4*)(XB + (size_t)t * D + 512 + 8 * F.lane);
        float f[16] = {bf_lo(v0.x), bf_hi(v0.x), bf_lo(v0.y), bf_hi(v0.y), bf_lo(v0.z), bf_hi(v0.z), bf_lo(v0.w), bf_hi(v0.w),
                       bf_lo(v1.x), bf_hi(v1.x), bf_lo(v1.y), bf_hi(v1.y), bf_lo(v1.z), bf_hi(v1.z), bf_lo(v1.w), bf_hi(v1.w)};
        float mx = 0.f;
#pragma unroll
        for (int k = 0; k < 16; ++k) mx = fmaxf(mx, fabsf(f[k]));
        mx = wave_max(mx);
        const float inv = mx > 0.f ? 127.0f / mx : 0.f, sc = mx * (1.0f / 127.0f);
        u32x2 q0, q1;
        q0.x = pk4_i8(f[0], f[1], f[2], f[3], inv); q0.y = pk4_i8(f[4], f[5], f[6], f[7], inv); q1.x = pk4_i8(f[8], f[9], f[10], f[11], inv); q1.y = pk4_i8(f[12], f[13], f[14], f[15], inv);
        *(u32x2*)(XS + r0 * D + 8 * F.lane) = q0; *(u32x2*)(XS + r0 * D + 512 + 8 * F.lane) = q1;
        *(u32x2*)(XS + r1 * D + 8 * F.lane) = q0; *(u32x2*)(XS + r1 * D + 512 + 8 * F.lane) = q1;
        if (F.lane == 0) { SXS[r0] = sc; SXS[r1] = sc; }
    }
#pragma unroll
    for (int e = 0; e < 8; ++e) { const int first = tb[e] * 256 + cn[e], last = tb[e + 1] * 256;
        for (int r = first + gw; r < last; r += NGW) { const u32x2 z = {0u, 0u}; *(u32x2*)(XS + (size_t)r * D + 8 * F.lane) = z; *(u32x2*)(XS + (size_t)r * D + 512 + 8 * F.lane) = z; if (F.lane == 0) SXS[r] = 0.f; } }
}
DI void ln_pass_combine(Frame& F, const float* g_, const float* b_, const unsigned* cnt, const bool final_, const bool dummy_) {
    FRESH(F);
    int tb[9], cn[8]; moe_tiles(cnt, tb, cn);
    const bf16* YS = (const bf16*)(F.ws + WS_YS); bf16* XB = (bf16*)(F.ws + WS_XB); float* X = (float*)F.out;
    const i32x4* RECI = (const i32x4*)(F.ws + WS_RECI); const f32x2* RECW = (const f32x2*)(F.ws + WS_RECW);
    f32x4 g[4], b[4];
#pragma unroll
    for (int j = 0; j < 4; ++j) { g[j] = *(const f32x4*)(g_ + 4 * F.lane + 256 * j); b[j] = *(const f32x4*)(b_ + 4 * F.lane + 256 * j); }
    const int gw = F.bid * NWAVES + F.wave, NGW = F.G * NWAVES;
    for (int row = gw; row < T; row += NGW) {
        const i32x4 r = RECI[row]; const f32x2 w = RECW[row];
        int b0 = 0, b1 = 0;
#pragma unroll
        for (int e = 0; e < 8; ++e) { b0 = (r[0] == e) ? tb[e] : b0; b1 = (r[2] == e) ? tb[e] : b1; }
        const size_t r0 = (size_t)b0 * 256 + r[1], r1 = (size_t)b1 * 256 + r[3];
        f32x4 v[4];
#pragma unroll
        for (int j = 0; j < 4; ++j) { const u32x2 xv = *(const u32x2*)(XB + (size_t)row * D + 4 * F.lane + 256 * j);
            const u32x2 ya = *(const u32x2*)(YS + r0 * D + 4 * F.lane + 256 * j), yb = *(const u32x2*)(YS + r1 * D + 4 * F.lane + 256 * j);
            v[j][0] = ALPHA * bf_lo(xv.x) + (w[0] * bf_lo(ya.x) + w[1] * bf_lo(yb.x)); v[j][1] = ALPHA * bf_hi(xv.x) + (w[0] * bf_hi(ya.x) + w[1] * bf_hi(yb.x));
            v[j][2] = ALPHA * bf_lo(xv.y) + (w[0] * bf_lo(ya.y) + w[1] * bf_lo(yb.y)); v[j][3] = ALPHA * bf_hi(xv.y) + (w[0] * bf_hi(ya.y) + w[1] * bf_hi(yb.y)); }
        ln_core(v, g, b);
        if (dummy_) ln_store(v, (bf16*)(F.ws + WS_XS), (size_t)row, F.lane);
        else if (final_) {
#pragma unroll
            for (int j = 0; j < 4; ++j) *(f32x4*)(X + (size_t)row * D + 4 * F.lane + 256 * j) = v[j];
        } else ln_store(v, XB, (size_t)row, F.lane);
    }
}

constexpr int KL_STRIDE = 144, VT_STRIDE = 776, VT_OFF = 384 * KL_STRIDE;
DI void attn_phase(Frame& F, const float* sink) {
    FRESH(F);
    const bf16* Q = (const bf16*)(F.ws + WS_Q); const bf16* Kb = (const bf16*)(F.ws + WS_K); const bf16* Vb = (const bf16*)(F.ws + WS_V); bf16* MIX = (bf16*)(F.ws + WS_MIX);
    LAS unsigned char* Kl = F.lds; LAS unsigned char* Vt = F.lds + VT_OFF;
    const int lane = F.lane, l31 = lane & 31, h = lane >> 5, w = F.wave;
    for (int unit = F.bid; unit < BATCH * 2 * 16; unit += F.G) {
        const int b = unit >> 5, kvh = (unit >> 4) & 1, n = unit & 15;
        __syncthreads();
        for (int idx = F.tid; idx < 384 * 8; idx += 512) {
            const int key = idx >> 3, ch = idx & 7, kp = (n - 1) * 128 + key;
            u32x4 kv = {0u, 0u, 0u, 0u}, vv = {0u, 0u, 0u, 0u};
            if (kp >= 0 && kp < SEQ) { const size_t off = (size_t)(b * SEQ + kp) * 128 + kvh * 64 + ch * 8; kv = *(const u32x4*)(Kb + off); vv = *(const u32x4*)(Vb + off); }
            *(LAS u32x4*)(Kl + key * KL_STRIDE + ch * 16) = kv;
            LAS unsigned short* vd = (LAS unsigned short*)(Vt + (ch * 8) * VT_STRIDE + key * 2);
            constexpr int RS = VT_STRIDE / 2;
            vd[0 * RS] = (unsigned short)(vv.x & 0xffffu); vd[1 * RS] = (unsigned short)(vv.x >> 16); vd[2 * RS] = (unsigned short)(vv.y & 0xffffu); vd[3 * RS] = (unsigned short)(vv.y >> 16);
            vd[4 * RS] = (unsigned short)(vv.z & 0xffffu); vd[5 * RS] = (unsigned short)(vv.z >> 16); vd[6 * RS] = (unsigned short)(vv.w & 0xffffu); vd[7 * RS] = (unsigned short)(vv.w >> 16);
        }
        __syncthreads();
        const int hq = kvh * 4 + (w >> 1);
        const float m0 = sink[hq] * LOG2E;
        for (int qb = 0; qb < 2; ++qb) {
            const int q0 = 64 * (w & 1) + 32 * qb;
            const size_t qrow = (size_t)(b * SEQ + n * 128 + q0 + l31);
            bf16x8 bq[4];
#pragma unroll
            for (int ks = 0; ks < 4; ++ks) bq[ks] = *(const bf16x8*)(Q + qrow * 512 + hq * 64 + 16 * ks + 8 * h);
            float m2 = m0, l = 1.0f;
            f32x16 O0, O1;
#pragma unroll
            for (int i = 0; i < 16; ++i) { O0[i] = 0.f; O1[i] = 0.f; }
            const int kt0 = q0 >> 5, qk = q0 + l31; const bool edge = (n == 0) || (n == 15);
            for (int kt = kt0; kt <= kt0 + 8; ++kt) {
                f32x16 X;
#pragma unroll
                for (int i = 0; i < 16; ++i) X[i] = 0.f;
#pragma unroll
                for (int ks = 0; ks < 4; ++ks) { const bf16x8 a = *(const LAS bf16x8*)(Kl + (32 * kt + l31) * KL_STRIDE + (16 * ks + 8 * h) * 2); X = MFMA32(a, bq[ks], X); }
                float mx = -1.0e30f;
                if (kt == kt0 || kt == kt0 + 8 || edge) {
#pragma unroll
                    for (int i = 0; i < 16; ++i) { const int kk = 32 * kt + crow(i, h); const int kp = (n - 1) * 128 + kk;
                        const bool valid = (kk >= qk) && (kk <= qk + 256) && (kp >= 0) && (kp < SEQ);
                        X[i] = valid ? X[i] : -1.0e30f; mx = fmaxf(mx, X[i]); }
                } else {
#pragma unroll
                    for (int i = 0; i < 16; ++i) mx = fmaxf(mx, X[i]);
                }
                mx = max_x32(mx);
                const float mn = fmaxf(m2, mx), alpha = fast_exp2(m2 - mn); m2 = mn;
                float ps = 0.f;
#pragma unroll
                for (int i = 0; i < 16; ++i) { X[i] = fast_exp2(X[i] - mn); ps += X[i]; }
                ps = sum_x32(ps);
                l = l * alpha + ps;
#pragma unroll
                for (int i = 0; i < 16; ++i) { O0[i] *= alpha; O1[i] *= alpha; }
#pragma unroll
                for (int s = 0; s < 2; ++s) {
                    u32x4 pw; pw.x = pk2(X[8 * s + 0], X[8 * s + 1]); pw.y = pk2(X[8 * s + 2], X[8 * s + 3]); pw.z = pk2(X[8 * s + 4], X[8 * s + 5]); pw.w = pk2(X[8 * s + 6], X[8 * s + 7]);
                    const bf16x8 pf = __builtin_bit_cast(bf16x8, pw);
                    const int kb = (32 * kt + 16 * s + 4 * h) * 2;
                    { const s16x4 lo = *(const LAS s16x4*)(Vt + l31 * VT_STRIDE + kb), hi = *(const LAS s16x4*)(Vt + l31 * VT_STRIDE + kb + 16);
                      O0 = MFMA32(__builtin_shufflevector(lo, hi, 0, 1, 2, 3, 4, 5, 6, 7), pf, O0); }
                    { const s16x4 lo = *(const LAS s16x4*)(Vt + (32 + l31) * VT_STRIDE + kb), hi = *(const LAS s16x4*)(Vt + (32 + l31) * VT_STRIDE + kb + 16);
                      O1 = MFMA32(__builtin_shufflevector(lo, hi, 0, 1, 2, 3, 4, 5, 6, 7), pf, O1); }
                }
            }
            const float inv = 1.0f / l;
            bf16* orow = MIX + qrow * D + hq * 64;
#pragma unroll
            for (int g4 = 0; g4 < 4; ++g4) {
                u32x2 o; o.x = pk2(O0[4 * g4] * inv, O0[4 * g4 + 1] * inv); o.y = pk2(O0[4 * g4 + 2] * inv, O0[4 * g4 + 3] * inv); *(u32x2*)(orow + 8 * g4 + 4 * h) = o;
                u32x2 p; p.x = pk2(O1[4 * g4] * inv, O1[4 * g4 + 1] * inv); p.y = pk2(O1[4 * g4 + 2] * inv, O1[4 * g4 + 3] * inv); *(u32x2*)(orow + 32 + 8 * g4 + 4 * h) = p;
            }
        }
    }
    __syncthreads();
}

constexpr int SG_STRIDE = 272;
DI void sgu_phase(Frame& F, const float* sgu_b) {
    FRESH(F);
    const bf16* ZU = (const bf16*)(F.ws + WS_ZU); const bf16* ZV = (const bf16*)(F.ws + WS_ZV); const bf16* Wsb = (const bf16*)(F.ws + WS_SGUW); bf16* MIX = (bf16*)(F.ws + WS_MIX);
    LAS unsigned char* VT = F.lds + F.wave * (32 * SG_STRIDE);
    const int lane = F.lane, l31 = lane & 31, h = lane >> 5;
    const int gw = F.bid * NWAVES + F.wave, NGW = F.G * NWAVES;
    for (int su = gw; su < BATCH * 16 * 8 * 2; su += NGW) {
        const int dh = su & 1, g = (su >> 1) & 7, n = (su >> 4) & 15, b = su >> 8;
        const size_t rowb = (size_t)(b * SEQ + n * 128);
#pragma unroll
        for (int i = 0; i < 8; ++i) { const int c = lane + 64 * i, q = c >> 2, ch = c & 3;
            const u32x4 vv = *(const u32x4*)(ZV + (rowb + q) * 512 + 64 * g + 32 * dh + 8 * ch);
            LAS unsigned short* vd = (LAS unsigned short*)(VT + (ch * 8) * SG_STRIDE + q * 2);
            constexpr int RS = SG_STRIDE / 2;
            vd[0 * RS] = (unsigned short)(vv.x & 0xffffu); vd[1 * RS] = (unsigned short)(vv.x >> 16); vd[2 * RS] = (unsigned short)(vv.y & 0xffffu); vd[3 * RS] = (unsigned short)(vv.y >> 16);
            vd[4 * RS] = (unsigned short)(vv.z & 0xffffu); vd[5 * RS] = (unsigned short)(vv.z >> 16); vd[6 * RS] = (unsigned short)(vv.w & 0xffffu); vd[7 * RS] = (unsigned short)(vv.w >> 16); }
        bf16x8 af[8];
#pragma unroll
        for (int ks = 0; ks < 8; ++ks) af[ks] = *(const LAS bf16x8*)(VT + l31 * SG_STRIDE + (16 * ks + 8 * h) * 2);
#pragma unroll
        for (int pt = 0; pt < 4; ++pt) {
            const int p = 32 * pt + l31;
            f32x16 acc;
#pragma unroll
            for (int i = 0; i < 16; ++i) acc[i] = 0.f;
#pragma unroll
            for (int ks = 0; ks < 8; ++ks) { const bf16x8 bw = *(const bf16x8*)(Wsb + ((size_t)g * 128 + p) * 128 + 16 * ks + 8 * h); acc = MFMA32(af[ks], bw, acc); }
            const float bias = sgu_b[g * 128 + p];
            const size_t row = rowb + p;
#pragma unroll
            for (int g4 = 0; g4 < 4; ++g4) { const int d = 32 * dh + 8 * g4 + 4 * h;
                const u32x2 uu = *(const u32x2*)(ZU + row * 512 + 64 * g + d);
                u32x2 o; o.x = pk2(bf_lo(uu.x) * (acc[4 * g4] + bias), bf_hi(uu.x) * (acc[4 * g4 + 1] + bias)); o.y = pk2(bf_lo(uu.y) * (acc[4 * g4 + 2] + bias), bf_hi(uu.y) * (acc[4 * g4 + 3] + bias));
                *(u32x2*)(MIX + row * D + 512 + 64 * g + d) = o; }
        }
        LDS_WAIT();
    }
}

constexpr int S5_STRIDE = 272;
DI void sincos_f(float th, float& s, float& c) {
    const float tq = th * 0.636619772367581f, q = rintf(tq), f = (tq - q) * 1.5707963267948966f, f2 = f * f;
    const float sp = f * (1.0f + f2 * (-1.6666667e-1f + f2 * (8.3333333e-3f + f2 * (-1.9841270e-4f + f2 * 2.7557319e-6f))));
    const float cp = 1.0f + f2 * (-0.5f + f2 * (4.1666667e-2f + f2 * (-1.3888889e-3f + f2 * (2.4801587e-5f + f2 * (-2.7557319e-7f)))));
    const int qi = ((int)q) & 3;
    s = (qi == 0) ? sp : (qi == 1) ? cp : (qi == 2) ? -sp : -cp;
    c = (qi == 0) ? cp : (qi == 1) ? -sp : (qi == 2) ? -cp : sp;
}
DI void zoh_params(float lr, float li, float logdt, float& br, float& bi, float& cr, float& ci) {
    const float dt = expf(logdt);
    const float ea = expf(lr * dt);
    float sn, cs; sincos_f(li * dt, sn, cs);
    br = ea * cs; bi = ea * sn;
    const float nr = br - 1.0f, rden = 1.0f / (lr * lr + li * li);
    cr = (nr * lr + bi * li) * rden; ci = (bi * lr - nr * li) * rden;
}
DI void s5_phase(Frame& F, const ArgsRef& a, int i) {
    FRESH(F);
    const bf16* XB = (const bf16*)(F.ws + WS_XB); bf16* YF = (bf16*)(F.ws + WS_YF);     bf16* YG = (bf16*)(F.ws + WS_YG);
    LAS unsigned char* xs = F.lds + F.wave * (32 * S5_STRIDE);
    const int lane = F.lane, l31 = lane & 31, h = lane >> 5, l15 = lane & 15, q4 = lane >> 4;
    const int gw = F.bid * NWAVES + F.wave, NGW = F.G * NWAVES;
    const bool fwdrow = (l31 & 4) == 0; const int slot = (l31 & 3) + 4 * (l31 >> 3);
    for (int unit = gw; unit < BATCH * 64; unit += NGW) {
        const int b = unit >> 6, g = unit & 63;
        const f32x4 dsk = *(const f32x4*)(a.in[20] + ((size_t)i * 64 + g) * 16 + 4 * q4);
        bf16x8 bfr[2][2][2]; float lbr[2], lbi[2];
#pragma unroll
        for (int dir = 0; dir < 2; ++dir) { const size_t pg = ((size_t)(i * 2 + dir) * 64 + g); const float logdt = a.in[15][pg];
#pragma unroll
            for (int ph = 0; ph < 2; ++ph) { const int pp = 32 * ph + l31; float tbr, tbi, tcr, tci;
                zoh_params(a.in[13][pg * 64 + pp], a.in[14][pg * 64 + pp], logdt, tbr, tbi, tcr, tci);
                if (dir == 0) { lbr[ph] = tbr; lbi[ph] = tbi; } else { lbr[ph] = h ? tbr : lbr[ph]; lbi[ph] = h ? tbi : lbi[ph]; }
                const float* brp = a.in[16] + (pg * 64 + pp) * 16 + 8 * h; const float* bip = a.in[17] + (pg * 64 + pp) * 16 + 8 * h;
                const f32x4 r0 = *(const f32x4*)brp, r1 = *(const f32x4*)(brp + 4), m0 = *(const f32x4*)bip, m1 = *(const f32x4*)(bip + 4);
                bfr[dir][ph][0] = __builtin_bit_cast(bf16x8, pg8::pack8(r0 * tcr - m0 * tci, r1 * tcr - m1 * tci));
                bfr[dir][ph][1] = __builtin_bit_cast(bf16x8, pg8::pack8(m0 * tcr + r0 * tci, m1 * tcr + r1 * tci)); } }
        bf16x8 cf[2][4];
#pragma unroll
        for (int dir = 0; dir < 2; ++dir) { const size_t pg = ((size_t)(i * 2 + dir) * 64 + g);
#pragma unroll
            for (int ks = 0; ks < 4; ++ks) { const size_t co = (pg * 16 + l15) * 64 + 16 * ks + 4 * q4;
                const f32x4 cre = *(const f32x4*)(a.in[18] + co), cim = *(const f32x4*)(a.in[19] + co);
                u32x4 wv; wv.x = pk2(cre[0], -cim[0]); wv.y = pk2(cre[1], -cim[1]); wv.z = pk2(cre[2], -cim[2]); wv.w = pk2(cre[3], -cim[3]);
                cf[dir][ks] = __builtin_bit_cast(bf16x8, wv); } }
        float xr[2] = {0.f, 0.f}, xi[2] = {0.f, 0.f};
        const size_t seq0 = (size_t)b * SEQ;
        bf16x8 au_n = *(const bf16x8*)(XB + (seq0 + (fwdrow ? slot : 16 * 127 + 15 - slot)) * D + 16 * g + 8 * h);
#pragma unroll 1
        for (int j = 0; j < 128; ++j) {
            const bf16x8 au = au_n;
            const size_t orow_f = seq0 + 16 * j + l15, orow_b = seq0 + 16 * (127 - j) + l15;
            const size_t oo_f = orow_f * D + 16 * g + 4 * q4, oo_b = orow_b * D + 16 * g + 4 * q4;
            u32x2 yfp[2], uup[2];
            if (j >= 64) { yfp[0] = *(const u32x2*)(YF + oo_f); yfp[1] = *(const u32x2*)(YF + oo_b); uup[0] = *(const u32x2*)(XB + oo_f); uup[1] = *(const u32x2*)(XB + oo_b); }
            else { yfp[0] = yfp[1] = (u32x2){0u, 0u}; uup[0] = uup[1] = (u32x2){0u, 0u}; }
            const bf16x8 zero8 = {0, 0, 0, 0, 0, 0, 0, 0};
            const bf16x8 a0 = fwdrow ? au : zero8, a1 = fwdrow ? zero8 : au;
            f32x16 z16;
#pragma unroll
            for (int k = 0; k < 16; ++k) z16[k] = 0.f;
            f32x16 P[2][2];
#pragma unroll
            for (int ph = 0; ph < 2; ++ph)
#pragma unroll
                for (int ri = 0; ri < 2; ++ri) { P[ph][ri] = MFMA32(a0, bfr[0][ph][ri], z16); P[ph][ri] = MFMA32(a1, bfr[1][ph][ri], P[ph][ri]); }
            __builtin_amdgcn_sched_barrier(0);
            { const int jn = (j < 127) ? j + 1 : j;
              au_n = *(const bf16x8*)(XB + (seq0 + (fwdrow ? 16 * jn + slot : 16 * (127 - jn) + 15 - slot)) * D + 16 * g + 8 * h); }
#pragma unroll
            for (int t = 0; t < 16; ++t) {
#pragma unroll
                for (int ph = 0; ph < 2; ++ph) {
                    const float t1 = __builtin_fmaf(-lbi[ph], xi[ph], P[ph][0][t]), t2 = __builtin_fmaf(lbi[ph], xr[ph], P[ph][1][t]);
                    xr[ph] = __builtin_fmaf(lbr[ph], xr[ph], t1); xi[ph] = __builtin_fmaf(lbr[ph], xi[ph], t2);
                    asm volatile("" : "+v"(xr[ph]), "+v"(xi[ph]));
                    *(LAS unsigned*)(xs + (16 * h + t) * S5_STRIDE + 4 * (32 * ph + l31)) = pk2(xr[ph], xi[ph]);
                }
            }
            f32x4 y4[2];
#pragma unroll
            for (int dd = 0; dd < 2; ++dd) {
                y4[dd] = (f32x4){0.f, 0.f, 0.f, 0.f};
                const int srow = dd ? 16 + (15 - l15) : l15;
#pragma unroll
                for (int ks = 0; ks < 4; ++ks) { const bf16x8 bx = *(const LAS bf16x8*)(xs + srow * S5_STRIDE + (32 * ks + 8 * q4) * 2); y4[dd] = MFMA16(cf[dd][ks], bx, y4[dd]); }
            }
            if (j < 64) { u32x2 p0, p1; p0.x = pk2(y4[0][0], y4[0][1]); p0.y = pk2(y4[0][2], y4[0][3]); p1.x = pk2(y4[1][0], y4[1][1]); p1.y = pk2(y4[1][2], y4[1][3]); *(u32x2*)(YF + oo_f) = p0; *(u32x2*)(YF + oo_b) = p1; }
            else {
#pragma unroll
                for (int dd = 0; dd < 2; ++dd) { const u32x2 uu = uup[dd];
                    const f32x4 uv = {bf_lo(uu.x), bf_hi(uu.x), bf_lo(uu.y), bf_hi(uu.y)};
                    const f32x4 yp = {bf_lo(yfp[dd].x), bf_hi(yfp[dd].x), bf_lo(yfp[dd].y), bf_hi(yfp[dd].y)};
                    const f32x4 y = yp + y4[dd] + dsk * uv;
                    u32x2 ov; ov.x = pk2(gelu_tanh(y[0]), gelu_tanh(y[1])); ov.y = pk2(gelu_tanh(y[2]), gelu_tanh(y[3])); *(u32x2*)(YG + (dd ? oo_b : oo_f)) = ov; }
            }
            { u32x4 t_ = __builtin_bit_cast(u32x4, au_n); asm volatile("" : "+v"(t_.x), "+v"(t_.y), "+v"(t_.z), "+v"(t_.w)); au_n = __builtin_bit_cast(bf16x8, t_); }
            LDS_WAIT();
        }
    }
}

__global__ void __launch_bounds__(NWAVES * 64, 2) fwd_kernel(Args args_by_value) {
    extern __shared__ __attribute__((aligned(16))) unsigned char lds[];
    Frame F;
    F.lds = (LAS unsigned char*)lds;
    F.MISC = (volatile LAS unsigned*)(F.lds + MISC_OFF);
    F.tid = threadIdx.x; F.lane = F.tid & 63; F.wave = __builtin_amdgcn_readfirstlane(F.tid >> 6);
    F.G = gridDim.x; F.bid = blockIdx.x;
    { kptr_t kp = (kptr_t)__builtin_amdgcn_kernarg_segment_ptr(); F.out = *(GASP float* const __attribute__((address_space(4)))*)(kp + 8 * 27); F.ws = *(GASP unsigned char* const __attribute__((address_space(4)))*)(kp + 8 * 28); }
    F.ctl = (unsigned*)(F.ws + WS_CTL);
    const ArgsRef args{};
    for (int u = F.tid; u < (LDS_BYTES - LDSCTL_OFF) / 4; u += NWAVES * 64) ((LAS unsigned*)(F.lds + LDSCTL_OFF))[u] = 0u;
    __syncthreads();
    XcdBarrier bar = xcd_barrier_post((GASP unsigned*)(F.ws + WS_CTL) + CW_BAR, F.MISC + 8, F.tid == 0);
#define GRID_BAR() xcd_barrier(bar, F.wave)
#define XB ((bf16*)(F.ws + WS_XB))
#define Yb ((bf16*)(F.ws + WS_Y))
#define Wb ((const char*)(F.ws + WS_W))
#define cosT ((const float*)(F.ws + WS_ROPE))
#define sinT ((const float*)(F.ws + WS_ROPE) + SEQ * 32)

    RPT(10) PH(0) prologue(F, args);
    RPT(4) PH(1) conv_layer(F, args, 0);
    wmax_layer(F, args, 0);
    GRID_BAR();

#pragma unroll 1
    for (int lp = 0; lp < 2; ++lp) {
        {
            const int L = 2 * lp, i = lp;
            { UFRESH(F); pg8::Order S{}; S.nM = T / 256; S.nN = INW / 256; S.nwg = S.nM * S.nN; S.G = F.G; S.c = F.bid; S.A = (const char*)XB; S.Bt = Wb + W_IN; S.tstep = (size_t)256 * D * 2; S.estride = 0;
              RPT(0) PH(2) { pg8::EpiWin E{(bf16*)(F.ws + WS_Q), (bf16*)(F.ws + WS_K), (bf16*)(F.ws + WS_V), (bf16*)(F.ws + WS_ZU), (bf16*)(F.ws + WS_ZV), cosT, sinT, args.in[7] + (size_t)i * 512, args.in[8] + (size_t)i * 512};
              pg8::gemm_phase(F.lds, D, S, E, F.wave); } }
            GRID_BAR();
            RPT(2) PH(3) attn_phase(F, args.in[4] + (size_t)i * 8);
            RPT(9) PH(4) sgu_phase(F, args.in[6] + (size_t)i * 8 * 128);
            if (L == 0) conv_down(F, args, 0);
            GRID_BAR();
            { UFRESH(F); pg8::Order S{}; S.nM = T / 256; S.nN = D / 256; S.nwg = S.nM * S.nN; S.G = F.G; S.c = F.bid; S.A = (const char*)(F.ws + WS_MIX); S.Bt = Wb + W_OUT; S.tstep = (size_t)256 * D * 2; S.estride = 0;
              pg8::EpiPlain<true, false> E{Yb, D, XB, nullptr};
              RPT(0) PH(10) pg8::gemm_phase(F.lds, D, S, E, F.wave); }
            GRID_BAR();
            RPT(5) PH(5) ln_pass_plain(F, args.in[1] + (size_t)(L * 2 + 0) * D, args.in[2] + (size_t)(L * 2 + 0) * D, true);
            wmax_layer(F, args, L + 1);
            GRID_BAR();
            { UFRESH(F); pg8::Order S{}; S.nM = T / 256; S.nN = 2 * FF / 256; S.nwg = S.nM * S.nN; S.G = F.G; S.c = F.bid; S.A = (const char*)(F.ws + WS_XB8); S.Bt = Wb + W_GU; S.tstep = (size_t)256 * D; S.estride = 0;
              pg8::EpiPairI8 E{(unsigned char*)(F.ws + WS_H), FF, (const float*)(F.ws + WS_SX), (const float*)(F.ws + WS_SW)};
              RPT(0) PH(11) pg8::gemm_phase<pg8::EpiPairI8, 1>(F.lds, D / 2, S, E, F.wave); }
            GRID_BAR();
            { UFRESH(F); pg8::Order S{}; S.nM = T / 256; S.nN = D / 256; S.nwg = S.nM * S.nN; S.G = F.G; S.c = F.bid; S.A = (const char*)(F.ws + WS_H); S.Bt = Wb + W_DN; S.tstep = (size_t)256 * FF; S.estride = 0;
              pg8::EpiPlain<true, true> E{Yb, D, XB, (const float*)(F.ws + WS_SWD)};
              RPT(0) PH(10) pg8::gemm_phase<pg8::EpiPlain<true, true>, 2>(F.lds, FF / 2, S, E, F.wave); }
            GRID_BAR();
            RPT(5) PH(5) ln_pass_plain(F, args.in[1] + (size_t)(L * 2 + 1) * D, args.in[2] + (size_t)(L * 2 + 1) * D, false);
            RPT(4) PH(1) conv_layer(F, args, L + 1);
            RPT(4) conv_down(F, args, L + 1);
            GRID_BAR();
        }
        {
            const int L = 2 * lp + 1, i = lp;
            unsigned* cnt = F.ctl + CW_CNT + 64 * i;
            RPT(3) PH(6) s5_phase(F, args, i);
            GRID_BAR();
            { UFRESH(F); pg8::Order S{}; S.nM = T / 256; S.nN = 2 * D / 256; S.nwg = S.nM * S.nN; S.G = F.G; S.c = F.bid; S.A = (const char*)(F.ws + WS_YG); S.Bt = Wb + W_GLU; S.tstep = (size_t)256 * D * 2; S.estride = 0;
              pg8::EpiPair<1, true> E{Yb, D, XB};
              RPT(0) PH(12) pg8::gemm_phase(F.lds, D, S, E, F.wave); }
            GRID_BAR();
            if ((RG >> 6) & 1) { PH(7) ln_pass_router(F, args.in[1] + (size_t)(L * 2 + 0) * D, args.in[2] + (size_t)(L * 2 + 0) * D, args.in[23] + (size_t)i * D * 8, cnt + 1024, WS_YS - WS_RECI); }
            PH(7) ln_pass_router(F, args.in[1] + (size_t)(L * 2 + 0) * D, args.in[2] + (size_t)(L * 2 + 0) * D, args.in[23] + (size_t)i * D * 8, cnt, 0);
            if (L + 1 < 4) wmax_layer(F, args, L + 1);
            GRID_BAR();
            RPT(11) PH(8) moe_gather(F, cnt);
            GRID_BAR();
            {
                int tb[9], cn[8]; moe_tiles(cnt, tb, cn);
                const int ntt = tb[8], TC = 256, nch = (ntt + TC - 1) / TC;
RPT(1)
#pragma unroll 1
                for (int ch = 0; ch < nch; ++ch) {
                    const int t0 = ch * TC, t1 = (t0 + TC < ntt) ? t0 + TC : ntt, nM = (t1 > t0) ? t1 - t0 : 0;
                    { UFRESH(F); pg8::Order S{}; S.nM = nM; S.nN = 2 * FF / 256; S.nwg = S.nM * S.nN; S.G = F.G; S.c = F.bid; S.atile0 = t0; S.otile0 = 0; S.etile0 = t0;
                      S.A = (const char*)(F.ws + WS_XS); S.Bt = Wb + W_MGU; S.tstep = (size_t)256 * D; S.estride = (size_t)2 * FF * D;
#pragma unroll
                      for (int e = 0; e < 8; ++e) S.tb[e] = tb[e];
                      pg8::EpiPairI8 E{(unsigned char*)(F.ws + WS_HS), FF, (const float*)(F.ws + WS_SXS), (const float*)(F.ws + WS_SW)};
                      PH(13) pg8::gemm_phase<pg8::EpiPairI8, 1>(F.lds, D / 2, S, E, F.wave); }
                    GRID_BAR();
                    { UFRESH(F); pg8::Order S{}; S.nM = nM; S.nN = D / 256; S.nwg = S.nM * S.nN; S.G = F.G; S.c = F.bid; S.atile0 = 0; S.otile0 = t0; S.etile0 = t0;
                      S.A = (const char*)(F.ws + WS_HS); S.Bt = Wb + W_MDN; S.tstep = (size_t)256 * FF; S.estride = (size_t)D * FF;
#pragma unroll
                      for (int e = 0; e < 8; ++e) S.tb[e] = tb[e];
                      pg8::EpiPlain<false, true> E{(bf16*)(F.ws + WS_YS), D, nullptr, (const float*)(F.ws + WS_SWD)};
                      PH(14) pg8::gemm_phase<pg8::EpiPlain<false, true>, 2>(F.lds, FF / 2, S, E, F.wave); }
                    GRID_BAR();
                }
            }
            if ((RG >> 7) & 1) { PH(9) ln_pass_combine(F, args.in[1] + (size_t)(L * 2 + 1) * D, args.in[2] + (size_t)(L * 2 + 1) * D, cnt, L == 3, true); }
            PH(9) ln_pass_combine(F, args.in[1] + (size_t)(L * 2 + 1) * D, args.in[2] + (size_t)(L * 2 + 1) * D, cnt, L == 3, false);
            if (L + 1 < 4) { RPT(4) PH(1) conv_layer(F, args, L + 1); RPT(4) conv_down(F, args, L + 1); GRID_BAR(); }
        }
    }
}

extern "C" void kernel_launch(void* const* d_in, const int* in_sizes, int n_in, void* d_out, int out_size, void* d_ws, size_t ws_size, hipStream_t stream) {
    static int grid = 0;
    if (grid == 0) {
        if (n_in != 27 || in_sizes[0] != T * D || out_size != T * D || ws_size < WS_END) {
            fprintf(stderr, "kernel_launch: unexpected shapes (n_in %d, in0 %d, out %d, ws %zu; need ws >= %zu); nothing launched\n", n_in, n_in > 0 ? in_sizes[0] : -1, out_size, ws_size, (size_t)WS_END); grid = -1; return; }
        int dev = 0, cus = 0, per_cu = 0;
        if (hipGetDevice(&dev) != hipSuccess || hipDeviceGetAttribute(&cus, hipDeviceAttributeMultiprocessorCount, dev) != hipSuccess) { grid = -1; return; }
        if (hipFuncSetAttribute((const void*)fwd_kernel, hipFuncAttributeMaxDynamicSharedMemorySize, LDS_BYTES) != hipSuccess) { fprintf(stderr, "kernel_launch: hipFuncSetAttribute failed\n"); grid = -1; return; }
        if (hipOccupancyMaxActiveBlocksPerMultiprocessor(&per_cu, (const void*)fwd_kernel, NWAVES * 64, LDS_BYTES) != hipSuccess || per_cu < 1)
            fprintf(stderr, "kernel_launch: note: occupancy query reports %d workgroups per CU\n", per_cu);
        (void)hipGetLastError();
        grid = cus;
    }
    if (grid < 0) return;
    if (hipMemsetAsync((char*)d_ws + WS_CTL, 0, CTL_ZERO_BYTES, stream) != hipSuccess) return;
    Args a{};
    for (int i = 0; i < 27; ++i) a.in[i] = (const float*)d_in[i];
    a.out = (float*)d_out; a.ws = (unsigned char*)d_ws;
    hipLaunchKernelGGL(fwd_kernel, dim3(grid), dim3(NWAVES * 64), LDS_BYTES, stream, a);
}
```

```cpp
#include <hip/hip_runtime.h>
#include <cstdio>
#include <cstdint>

#define LAS __attribute__((address_space(3)))
typedef unsigned short bf16;
typedef short bf16x8 __attribute__((ext_vector_type(8)));
typedef short s16x4 __attribute__((ext_vector_type(4)));
typedef float f32x4 __attribute__((ext_vector_type(4)));
typedef float f32x2 __attribute__((ext_vector_type(2)));
typedef float f32x16 __attribute__((ext_vector_type(16)));
typedef unsigned u32x4 __attribute__((ext_vector_type(4)));
typedef unsigned u32x2 __attribute__((ext_vector_type(2)));
typedef int i32x4 __attribute__((ext_vector_type(4)));
typedef int i32x8 __attribute__((ext_vector_type(8)));
typedef short s16x16 __attribute__((ext_vector_type(16)));
typedef __bf16 bf2_t __attribute__((ext_vector_type(2)));
#define DI __device__ __forceinline__
#define GASP __attribute__((address_space(1)))
template <class T> DI T* as_global(T* p) { return (T*)(GASP T*)p; }
#ifndef PHM
#define PHM 0xFFFFF
#endif
#define PH(b) if (PHM & (1 << (b)))
#ifndef RG
#define RG 0
#endif
#define RPT(g) for (int rep_ = 0, nrep_ = rep_count(((RG) >> (g)) & 1); rep_ < nrep_; ++rep_)
#define UFRESH(F) do { asm volatile("" : "+s"((F).ws), "+s"((F).out), "+s"((F).G), "+s"((F).bid)); (F).ctl = (unsigned*)((F).ws + WS_CTL); } while (0)
#define FRESH(F) do { UFRESH(F); int l_ = lane_id(); asm volatile("" : "+v"(l_)); (F).lane = l_; (F).tid = (F).wave * 64 + l_; } while (0)

constexpr int NWAVES = 8;
constexpr int BATCH = 32, SEQ = 2048, D = 1024, T = BATCH * SEQ;
constexpr int INW = 1792, FF = 2816, NE = 8;
constexpr float ALPHA = 1.6817928305074290f;
constexpr float LN_EPS = 1e-5f;
constexpr float QSCALE = 0.18033688011112042f;
constexpr float LOG2E = 1.4426950408889634f;

constexpr size_t MiB = 1u << 20;
constexpr size_t WS_CTL = 0, CTL_ZERO_BYTES = 1 * MiB;
constexpr size_t WS_ROPE = 1 * MiB;
constexpr size_t WS_RECI = 2 * MiB;
constexpr size_t WS_RECW = 3 * MiB;
constexpr size_t WS_SGUW = 4 * MiB;
constexpr size_t WS_SX = 5 * MiB;
constexpr size_t WS_SW = 6 * MiB;
constexpr size_t WS_SWD = 9 * MiB;
constexpr size_t WS_SXS = 7 * MiB;
constexpr size_t WS_W = 16 * MiB;
constexpr size_t WS_XB = 156 * MiB;
constexpr size_t WS_Y = 284 * MiB;
constexpr size_t WS_R = 412 * MiB;
constexpr size_t WS_Q = WS_R, WS_K = WS_Q + 64 * MiB, WS_V = WS_K + 16 * MiB, WS_ZU = WS_V + 16 * MiB, WS_ZV = WS_ZU + 64 * MiB, WS_MIX = WS_ZV + 64 * MiB;
constexpr size_t WS_H = WS_R;
constexpr size_t WS_YF = WS_R;
constexpr size_t WS_YG = WS_R + 256 * MiB;
constexpr int XS_ROWS = 2 * T + NE * 256;
constexpr int TC_MAX = 264;
constexpr size_t WS_XB8 = 768 * MiB;
constexpr size_t WS_XS = 284 * MiB;
constexpr size_t WS_HS = 416 * MiB;
constexpr size_t WS_YS = 600 * MiB;
constexpr size_t WS_END = 860 * MiB;
constexpr size_t W_IN = 0, W_OUT = 4 * MiB, W_GU = 6 * MiB, W_DN = 17 * MiB;
constexpr size_t W_GLU = 0, W_MGU = 4 * MiB, W_MDN = 48 * MiB;
constexpr int CW_TMO = 0, CW_DBG = 2, CW_BAR = 4096, CW_CNT = 8192;
constexpr int CW_WMAX = 65536;

constexpr int RING_BYTES = 131072;
constexpr int LDSCTL_OFF = RING_BYTES, MISC_OFF = LDSCTL_OFF + 320;
constexpr int LDS_BYTES = 147456;

DI unsigned pk2(float lo, float hi) { f32x2 v = {lo, hi}; return __builtin_bit_cast(unsigned, __builtin_convertvector(v, bf2_t)); }
DI unsigned q8(float v, float inv) { return __float_as_uint(__builtin_fmaf(v, inv, 12582912.0f)) & 0xffu; }
DI unsigned pk4_i8(float a, float b, float c, float d, float inv) { return q8(a, inv) | (q8(b, inv) << 8) | (q8(c, inv) << 16) | (q8(d, inv) << 24); }
DI unsigned pk4_fp8(float a, float b, float c, float d) { int w = 0; w = __builtin_amdgcn_cvt_pk_fp8_f32(a, b, w, false); w = __builtin_amdgcn_cvt_pk_fp8_f32(c, d, w, true); return (unsigned)w; }
DI float bf_lo(unsigned w) { return __uint_as_float(w << 16); }
DI float bf_hi(unsigned w) { return __uint_as_float(w & 0xffff0000u); }
DI float fast_exp2(float x) { return __builtin_amdgcn_exp2f(x); }
DI float fast_rcp(float x) { return __builtin_amdgcn_rcpf(x); }
DI float sigmoidf_(float x) { return fast_rcp(1.0f + fast_exp2(-LOG2E * x)); }
DI float gelu_tanh(float x) { const float z = x + 0.044715f * x * x * x; return x * fast_rcp(1.0f + fast_exp2(-2.302208198f * z)); }
#define dpp_f(v, ctrl) __int_as_float(__builtin_amdgcn_mov_dpp(__float_as_int(v), (ctrl), 0xf, 0xf, true))
#define DPP_XOR1 0xB1
#define DPP_XOR2 0x4E
#define DPP_HMIRROR 0x141
#define DPP_MIRROR 0x140
DI float swz16_f(float v) { return __int_as_float(__builtin_amdgcn_ds_swizzle(__float_as_int(v), 0x401F)); }
DI float sum_x32(float v) { auto r = __builtin_amdgcn_permlane32_swap(__float_as_uint(v), __float_as_uint(v), false, false); return __uint_as_float(r[0]) + __uint_as_float(r[1]); }
DI float max_x32(float v) { auto r = __builtin_amdgcn_permlane32_swap(__float_as_uint(v), __float_as_uint(v), false, false); return fmaxf(__uint_as_float(r[0]), __uint_as_float(r[1])); }
DI float wave_max(float v) {
    v = fmaxf(v, dpp_f(v, DPP_XOR1)); v = fmaxf(v, dpp_f(v, DPP_XOR2)); v = fmaxf(v, dpp_f(v, DPP_HMIRROR)); v = fmaxf(v, dpp_f(v, DPP_MIRROR)); v = fmaxf(v, swz16_f(v)); return max_x32(v);
}
DI float wave_sum(float v) {
    v += dpp_f(v, DPP_XOR1); v += dpp_f(v, DPP_XOR2); v += dpp_f(v, DPP_HMIRROR); v += dpp_f(v, DPP_MIRROR); v += swz16_f(v); return sum_x32(v);
}
#define LDS_WAIT() asm volatile("s_waitcnt lgkmcnt(0)" ::: "memory")
#define VM_WAIT() asm volatile("s_waitcnt vmcnt(0)" ::: "memory")
DI int lane_id() { unsigned ones = ~0u; asm volatile("" : "+s"(ones)); return (int)__builtin_amdgcn_mbcnt_hi(ones, __builtin_amdgcn_mbcnt_lo(ones, 0u)); }
DI int rep_count(int extra) { int n = 1 + extra; asm volatile("" : "+s"(n)); return n; }
DI int crow(int reg, int h) { return (reg & 3) + 8 * (reg >> 2) + 4 * h; }
#define MFMA32(a, b, c) __builtin_amdgcn_mfma_f32_32x32x16_bf16((a), (b), (c), 0, 0, 0)
#define MFMA16(a, b, c) __builtin_amdgcn_mfma_f32_16x16x32_bf16((a), (b), (c), 0, 0, 0)

DI void sincos_d(double th, double& s, double& c) {
    const double tq = th * 0.63661977236758134308;
    const double q = rint(tq);
    const double f = (tq - q) * 1.57079632679489661923;
    const double f2 = f * f;
    const double sp = f * (1.0 + f2 * (-1.0 / 6 + f2 * (1.0 / 120 + f2 * (-1.0 / 5040 + f2 * (1.0 / 362880 + f2 * (-1.0 / 39916800 + f2 * (1.0 / 6227020800.0)))))));
    const double cp = 1.0 + f2 * (-0.5 + f2 * (1.0 / 24 + f2 * (-1.0 / 720 + f2 * (1.0 / 40320 + f2 * (-1.0 / 3628800 + f2 * (1.0 / 479001600.0 + f2 * (-1.0 / 87178291200.0)))))));
    const int qi = ((int)q) & 3;
    s = (qi == 0) ? sp : (qi == 1) ? cp : (qi == 2) ? -sp : -cp;
    c = (qi == 0) ? cp : (qi == 1) ? -sp : (qi == 2) ? -cp : sp;
}
DI double exp_d(double x) {
    const double n = rint(x * 1.4426950408889634074);
    const double r = x - n * 0.69314718055994530942;
    double p = 1.0 / 87178291200.0;
    p = p * r + 1.0 / 6227020800.0; p = p * r + 1.0 / 479001600.0; p = p * r + 1.0 / 39916800.0; p = p * r + 1.0 / 3628800.0; p = p * r + 1.0 / 362880.0;
    p = p * r + 1.0 / 40320.0; p = p * r + 1.0 / 5040.0; p = p * r + 1.0 / 720.0; p = p * r + 1.0 / 120.0; p = p * r + 1.0 / 24.0; p = p * r + 1.0 / 6.0; p = p * r + 0.5; p = p * r + 1.0; p = p * r + 1.0;
    const long long bits = (long long)((int)n + 1023) << 52;
    return p * __builtin_bit_cast(double, bits);
}

namespace pg8 {
constexpr int SCALE_LDS_OFF = 131072 + 1024;
constexpr int BM = 256, BK = 64, HALF = 128, HTB = HALF * BK * 2, STAGE_BYTES = 8 * HTB, NXCD = 8, WGM = 4;
DI int lds_byte(int r, int c) { const int st = (r >> 4) * 2 + (c >> 5), rr = r & 15, cc = c & 31, ob = rr * 64 + cc * 2; return st * 1024 + (ob ^ (((ob >> 9) & 1) << 5)); }
DI void stage_rc(int b, int& R, int& C) { const int st = b / 1024, sb = b % 1024, swz = sb ^ (((sb >> 9) & 1) << 5); R = (st >> 1) * 16 + swz / 64; C = (st & 1) * 32 + (swz % 64) / 2; }
DI int perm32(int rho) { const int n = rho >> 4, i = rho & 15; return 8 * (i >> 2) + 4 * n + (i & 3); }

struct Unit { int pm, pn, row0, arow0, e; const char* a; const char* b; };
struct Order {
    int nM, nN, nwg, G, c, atile0, otile0, etile0;
    const char* A; const char* Bt; size_t tstep, estride;
    int tb[8];
    DI bool next(int i, Unit& u) const {
        const long L = (long)i * G + c; if (L >= nwg) return false;
        int wgid = (int)L; { const int q = nwg / NXCD, r = nwg % NXCD, xcd = wgid % NXCD, off = wgid / NXCD; wgid = (xcd < r ? xcd * (q + 1) : r * (q + 1) + (xcd - r) * q) + off; }
        const int nig = WGM * nN, gid = wgid / nig, fm = gid * WGM, gsz = (nM - fm) < WGM ? (nM - fm) : WGM;
        u.pm = fm + ((wgid % nig) % gsz); u.pn = (wgid % nig) / gsz;
        u.row0 = (otile0 + u.pm) * BM;
        int e = 0;
        if (estride) { const int t = etile0 + u.pm;
#pragma unroll
            for (int j = 1; j < 8; ++j) e += (t >= tb[j]) ? 1 : 0; }
        u.e = e; u.arow0 = (atile0 + u.pm) * BM;
        u.a = A + (size_t)(atile0 + u.pm) * tstep; u.b = Bt + (size_t)e * estride + (size_t)u.pn * tstep;
        return true;
    }
};

template <class Epi, int MODE = 0>
DI void gemm_phase(LAS unsigned char* lds, const int K, const Order& S, const Epi& E, const int wid) {
    int lane = lane_id(); asm volatile("" : "+v"(lane));
    const int tid = wid * 64 + lane, wr = wid >> 2, wc = wid & 3, fr = lane & 15, fq = lane >> 4;
    const int nt = K / BK;
    unsigned voffA[2], voffB[2];
#pragma unroll
    for (int i = 0; i < 2; ++i) { int R, C; stage_rc(tid * 16 + i * 8192, R, C); const int Rb = (R & ~31) + perm32(R & 31);
        voffA[i] = (unsigned)(R * K + C) * 2u; voffB[i] = (unsigned)(Rb * K + C) * 2u; }
    const size_t kstep = (size_t)(BK * 2);
    const size_t hstep = (size_t)HALF * K * 2;
    const unsigned ldsw = (unsigned)wid * 1024u;
    constexpr bool I8 = (MODE == 1), F8 = (MODE == 2);
    const int aoff = F8 ? lds_byte(wr * 64 + fr, 32 * (fq >> 1) + 16 * (fq & 1)) : lds_byte(wr * 64 + fr, fq * 8), boff = F8 ? lds_byte(wc * 32 + fr, 32 * (fq >> 1) + 16 * (fq & 1)) : lds_byte(wc * 32 + fr, fq * 8);
#define PG8_SA(b, h) (((b) * 2 + (h)) * HTB)
#define PG8_SB(b, h) ((4 + (b) * 2 + (h)) * HTB)
#define PG8_STAGE(bufoff, gbase, voff) do { _Pragma("unroll") for (int _i = 0; _i < 2; ++_i) \
        __builtin_amdgcn_global_load_lds((const unsigned*)((const char*)(gbase) + (voff)[_i]), (LAS unsigned*)(lds + (bufoff) + ldsw + _i * 8192), 16, 0, 0); } while (0)
#define PG8_LDA(dst, b, h) do { _Pragma("unroll") for (int m = 0; m < 4; ++m) { if constexpr (F8) dst##8[m] = __builtin_bit_cast(i32x8, __builtin_shufflevector(*(const LAS bf16x8*)(lds + PG8_SA(b, h) + aoff + m * 2048), *(const LAS bf16x8*)(lds + PG8_SA(b, h) + aoff + m * 2048 + 16), 0, 1, 2, 3, 4, 5, 6, 7, 8, 9, 10, 11, 12, 13, 14, 15)); \
        else { _Pragma("unroll") for (int k = 0; k < 2; ++k) dst[m][k] = *(const LAS bf16x8*)(lds + PG8_SA(b, h) + aoff + m * 2048 + k * 1024); } } } while (0)
#define PG8_LDB(dst, b, h) do { _Pragma("unroll") for (int n = 0; n < 2; ++n) { if constexpr (F8) dst##8[n] = __builtin_bit_cast(i32x8, __builtin_shufflevector(*(const LAS bf16x8*)(lds + PG8_SB(b, h) + boff + n * 2048), *(const LAS bf16x8*)(lds + PG8_SB(b, h) + boff + n * 2048 + 16), 0, 1, 2, 3, 4, 5, 6, 7, 8, 9, 10, 11, 12, 13, 14, 15)); \
        else { _Pragma("unroll") for (int k = 0; k < 2; ++k) dst[n][k] = *(const LAS bf16x8*)(lds + PG8_SB(b, h) + boff + n * 2048 + k * 1024); } } } while (0)
#define PG8_MMA(ai, bj, At, Bt) do { __builtin_amdgcn_s_setprio(1); _Pragma("unroll") for (int m = 0; m < 4; ++m) _Pragma("unroll") for (int n = 0; n < 2; ++n) { \
        if constexpr (F8) asm volatile("v_mfma_scale_f32_16x16x128_f8f6f4 %0, %1, %2, %0, %3, %3 op_sel_hi:[0,0,0]" : "+v"(acc[ai][bj][m][n]) : "v"(Bt##8[n]), "v"(At##8[m]), "v"(scale1)); \
        else { _Pragma("unroll") for (int k = 0; k < 2; ++k) \
        { if constexpr (I8) acc[ai][bj][m][n] = __builtin_bit_cast(f32x4, __builtin_amdgcn_mfma_i32_16x16x64_i8(__builtin_bit_cast(i32x4, Bt[n][k]), __builtin_bit_cast(i32x4, At[m][k]), __builtin_bit_cast(i32x4, acc[ai][bj][m][n]), 0, 0, 0)); \
          else acc[ai][bj][m][n] = __builtin_amdgcn_mfma_f32_16x16x32_bf16(Bt[n][k], At[m][k], acc[ai][bj][m][n], 0, 0, 0); } } } __builtin_amdgcn_s_setprio(0); } while (0)
#define PG8_WAIT_V(n) asm volatile("s_waitcnt vmcnt(" #n ")" ::: "memory")
#define PG8_WAIT_L(n) asm volatile("s_waitcnt lgkmcnt(" #n ")" ::: "memory")
#define PG8_BAR __builtin_amdgcn_s_barrier()
#define PG8_SCHED __builtin_amdgcn_sched_barrier(0)
    Unit cur, nxt; int ui = 0;
    if (!S.next(0, cur)) return;
    f32x4 acc[2][2][4][2];
#pragma unroll
    for (int a = 0; a < 2; ++a)
#pragma unroll
        for (int b = 0; b < 2; ++b)
#pragma unroll
            for (int m = 0; m < 4; ++m)
#pragma unroll
                for (int n = 0; n < 2; ++n) acc[a][b][m][n] = (f32x4){0.f, 0.f, 0.f, 0.f};
    const int scale1 = 0x7F7F7F7F;
    bf16x8 At[4][2], B0[2][2], B1[2][2]; i32x8 At8[4], B08[2], B18[2];
    const char* cA = cur.a; const char* cB = cur.b;
    PG8_STAGE(PG8_SB(0, 0), cB, voffB); PG8_STAGE(PG8_SB(0, 1), cB + hstep, voffB); PG8_STAGE(PG8_SA(0, 0), cA, voffA); PG8_STAGE(PG8_SA(0, 1), cA + hstep, voffA);
    if (wr == 1) PG8_BAR;
    PG8_WAIT_V(2); PG8_BAR;
    PG8_STAGE(PG8_SB(1, 0), cB + kstep, voffB); PG8_STAGE(PG8_SA(1, 0), cA + kstep, voffA); PG8_STAGE(PG8_SB(1, 1), cB + hstep + kstep, voffB);
    PG8_WAIT_V(6); PG8_BAR;
    for (;;) {
        const bool has_next = S.next(ui + 1, nxt);
        const char* nA = has_next ? nxt.a : cA; const char* nB = has_next ? nxt.b : cB;
#pragma unroll 1
        for (int t = 0; t < nt; t += 2) {
            const bool last = (t == nt - 2);
            const char* a1 = cA + (size_t)(t + 1) * kstep;
            const char* a2 = last ? nA : cA + (size_t)(t + 2) * kstep; const char* b2 = last ? nB : cB + (size_t)(t + 2) * kstep;
            const char* a3 = a2 + kstep; const char* b3 = b2 + kstep;
            if constexpr (Epi::STAGED) { if (last) E.stage(lds + SCALE_LDS_OFF, cur, wid, lane); }
            PG8_LDB(B0, 0, 0); PG8_LDB(B1, 0, 1); PG8_SCHED; PG8_LDA(At, 0, 0); PG8_STAGE(PG8_SA(1, 1), a1 + hstep, voffA);
            PG8_WAIT_V(8); PG8_WAIT_L(0); PG8_BAR; PG8_MMA(0, 0, At, B0); PG8_MMA(0, 1, At, B1); PG8_BAR; PG8_SCHED;
            PG8_LDA(At, 0, 1); PG8_STAGE(PG8_SB(0, 0), b2, voffB); PG8_STAGE(PG8_SB(0, 1), b2 + hstep, voffB); PG8_STAGE(PG8_SA(0, 0), a2, voffA);
            PG8_WAIT_V(8); PG8_WAIT_L(0); PG8_BAR; PG8_MMA(1, 0, At, B0); PG8_MMA(1, 1, At, B1); PG8_BAR; PG8_SCHED;
            PG8_LDB(B0, 1, 0); PG8_LDB(B1, 1, 1); PG8_SCHED; PG8_LDA(At, 1, 0); PG8_STAGE(PG8_SA(0, 1), a2 + hstep, voffA);
            PG8_WAIT_V(8); PG8_WAIT_L(0); PG8_BAR; PG8_MMA(0, 0, At, B0); PG8_MMA(0, 1, At, B1); PG8_BAR; PG8_SCHED;
            PG8_LDA(At, 1, 1); PG8_STAGE(PG8_SB(1, 0), b3, voffB); PG8_STAGE(PG8_SB(1, 1), b3 + hstep, voffB); PG8_STAGE(PG8_SA(1, 0), a3, voffA);
            PG8_WAIT_V(8); PG8_WAIT_L(0); PG8_BAR; PG8_MMA(1, 0, At, B0); PG8_MMA(1, 1, At, B1); PG8_BAR; PG8_SCHED;
        }
        if (wr == 0) PG8_BAR;
        if constexpr (F8) asm volatile("s_nop 15\n\ts_nop 7" ::: "memory");
        if constexpr (Epi::STAGED) E(acc, cur, wr, wc, fr, fq, lds + SCALE_LDS_OFF); else E(acc, cur, wr, wc, fr, fq);
        if (!has_next) break;
#pragma unroll
        for (int a = 0; a < 2; ++a)
#pragma unroll
            for (int b = 0; b < 2; ++b)
#pragma unroll
                for (int m = 0; m < 4; ++m)
#pragma unroll
                    for (int n = 0; n < 2; ++n) acc[a][b][m][n] = (f32x4){0.f, 0.f, 0.f, 0.f};
        cur = nxt; cA = nA; cB = nB; ++ui;
        if (wr == 1) PG8_BAR;
    }
    PG8_WAIT_V(0);
    PG8_BAR;
#undef PG8_SA
#undef PG8_SB
#undef PG8_STAGE
#undef PG8_LDA
#undef PG8_LDB
#undef PG8_MMA
#undef PG8_WAIT_V
#undef PG8_WAIT_L
#undef PG8_BAR
#undef PG8_SCHED
}

DI u32x4 pack8(const f32x4 a, const f32x4 b) { u32x4 w; w.x = pk2(a[0], a[1]); w.y = pk2(a[2], a[3]); w.z = pk2(b[0], b[1]); w.w = pk2(b[2], b[3]); return w; }

DI f32x4 bfx4_lo(const u32x4 w) { return (f32x4){bf_lo(w.x), bf_hi(w.x), bf_lo(w.y), bf_hi(w.y)}; }
DI f32x4 bfx4_hi(const u32x4 w) { return (f32x4){bf_lo(w.z), bf_hi(w.z), bf_lo(w.w), bf_hi(w.w)}; }
template <bool RES, bool SC> struct EpiPlain {
    static constexpr bool STAGED = false;
    bf16* O; int ldc; const bf16* R; const float* swd;
    DI void operator()(const f32x4 (&acc)[2][2][4][2], const Unit& u, int wr, int wc, int fr, int fq) const {
        asm volatile("" : "+v"(fr), "+v"(fq));
        const int row0 = u.row0 + wr * 64 + fr, col0 = u.pn * BM + wc * 32 + 8 * fq;
        f32x4 cs[2][2];
#pragma unroll
        for (int bj = 0; bj < 2; ++bj)
#pragma unroll
            for (int n = 0; n < 2; ++n) cs[bj][n] = SC ? *(const f32x4*)(swd + (size_t)u.e * D + col0 + bj * HALF + 4 * n) : (f32x4){1.f, 1.f, 1.f, 1.f};
#define ACS(ai, bj, m, n) (SC ? acc[ai][bj][m][n] * cs[bj][n] : acc[ai][bj][m][n])
        if constexpr (RES) {
#pragma unroll
            for (int hb = 0; hb < 2; ++hb) {
                u32x4 r0[4], r1[4];
#pragma unroll
                for (int m = 0; m < 4; ++m) { const size_t off = (size_t)(row0 + hb * HALF + m * 16) * ldc + col0; r0[m] = *(const u32x4*)(R + off); r1[m] = *(const u32x4*)(R + off + HALF); }
                asm volatile("" ::: "memory");
#pragma unroll
                for (int m = 0; m < 4; ++m) { const int ai = hb; const size_t off = (size_t)(row0 + ai * HALF + m * 16) * ldc + col0;
                    *(u32x4*)(O + off) = pack8(ACS(ai, 0, m, 0) + bfx4_lo(r0[m]) * ALPHA, ACS(ai, 0, m, 1) + bfx4_hi(r0[m]) * ALPHA);
                    *(u32x4*)(O + off + HALF) = pack8(ACS(ai, 1, m, 0) + bfx4_lo(r1[m]) * ALPHA, ACS(ai, 1, m, 1) + bfx4_hi(r1[m]) * ALPHA); }
                asm volatile("" ::: "memory");
            }
        } else {
#pragma unroll
            for (int ai = 0; ai < 2; ++ai)
#pragma unroll
                for (int m = 0; m < 4; ++m) { const size_t off = (size_t)(row0 + ai * HALF + m * 16) * ldc + col0;
#pragma unroll
                    for (int bj = 0; bj < 2; ++bj) *(u32x4*)(O + off + bj * HALF) = pack8(ACS(ai, bj, m, 0), ACS(ai, bj, m, 1)); }
        }
    }
#undef ACS
};
template <int ACT, bool RES> struct EpiPair {
    static constexpr bool STAGED = false;
    bf16* O; int ldc; const bf16* R;
    DI void operator()(const f32x4 (&acc)[2][2][4][2], const Unit& u, int wr, int wc, int fr, int fq) const {
        asm volatile("" : "+v"(fr), "+v"(fq));
        const int row0 = u.row0 + wr * 64 + fr, col0 = u.pn * HALF + wc * 32 + 8 * fq;
        u32x4 r[8];
#pragma unroll
        for (int g = 0; g < 8; ++g) { r[g] = (u32x4){0u, 0u, 0u, 0u}; if constexpr (RES) r[g] = *(const u32x4*)(R + (size_t)(row0 + (g >> 2) * HALF + (g & 3) * 16) * ldc + col0); }
        if constexpr (RES) asm volatile("" ::: "memory");
#pragma unroll
        for (int g = 0; g < 8; ++g) { const int ai = g >> 2, m = g & 3;
            const size_t off = (size_t)(row0 + ai * HALF + m * 16) * ldc + col0;
            f32x4 o[2];
            if constexpr (RES) { o[0] = bfx4_lo(r[g]) * ALPHA; o[1] = bfx4_hi(r[g]) * ALPHA; } else { o[0] = (f32x4){0.f, 0.f, 0.f, 0.f}; o[1] = o[0]; }
#pragma unroll
            for (int n = 0; n < 2; ++n) { const f32x4 a = acc[ai][0][m][n], b = acc[ai][1][m][n];
#pragma unroll
                for (int j = 0; j < 4; ++j) o[n][j] += (ACT == 0) ? a[j] * sigmoidf_(a[j]) * b[j] : a[j] * sigmoidf_(b[j]); }
            *(u32x4*)(O + off) = pack8(o[0], o[1]); }
    }
};
struct EpiPairI8 {
    static constexpr bool STAGED = true;
    unsigned char* O;     int ldc; const float* sx; const float* sw;
    DI void stage(LAS unsigned char* lds_sc, const Unit& u, int wid, int lane) const {
        const int wr = wid >> 2, wc = wid & 3;
        LAS unsigned* base = (LAS unsigned*)(lds_sc + 768 * wid);
        __builtin_amdgcn_global_load_lds((const unsigned*)(sw + (size_t)u.e * (2 * FF) + u.pn * BM + (lane >> 5) * HALF + wc * 32 + (lane & 31)), base, 4, 0, 0);
        __builtin_amdgcn_global_load_lds((const unsigned*)(sx + u.arow0 + wr * 64 + lane), base + 64, 4, 0, 0);
        __builtin_amdgcn_global_load_lds((const unsigned*)(sx + u.arow0 + HALF + wr * 64 + lane), base + 128, 4, 0, 0);
    }
    DI void operator()(const f32x4 (&acc)[2][2][4][2], const Unit& u, int wr, int wc, int fr, int fq, const LAS unsigned char* lds_sc) const {
        asm volatile("" : "+v"(fr), "+v"(fq));
        const int rloc = wr * 64 + fr, col0 = u.pn * HALF + wc * 32 + 8 * fq;
        const LAS unsigned char* wb = lds_sc + 768 * (wr * 4 + wc);
        f32x4 sg[2], su[2];
#pragma unroll
        for (int n = 0; n < 2; ++n) { sg[n] = __builtin_bit_cast(f32x4, *(const LAS bf16x8*)(wb + 4 * (8 * fq + 4 * n))); su[n] = __builtin_bit_cast(f32x4, *(const LAS bf16x8*)(wb + 4 * (32 + 8 * fq + 4 * n))); }
        float srv[8];
#pragma unroll
        for (int g = 0; g < 8; ++g) { typedef short s16x2 __attribute__((ext_vector_type(2))); srv[g] = __builtin_bit_cast(float, *(const LAS s16x2*)(wb + 4 * (64 + (g >> 2) * 64 + (g & 3) * 16 + fr))); }
#pragma unroll
        for (int ai = 0; ai < 2; ++ai)
#pragma unroll
            for (int m = 0; m < 4; ++m) {
                const int rr = rloc + ai * HALF + m * 16;
                const float sr = srv[ai * 4 + m];
                f32x4 o[2];
#pragma unroll
                for (int n = 0; n < 2; ++n) {
                    const f32x4 a = __builtin_convertvector(__builtin_bit_cast(i32x4, acc[ai][0][m][n]), f32x4) * (sg[n] * sr);
                    const f32x4 b = __builtin_convertvector(__builtin_bit_cast(i32x4, acc[ai][1][m][n]), f32x4) * (su[n] * sr);
                    const f32x4 t = a * (-LOG2E);
                    f32x4 e; e[0] = fast_exp2(t[0]); e[1] = fast_exp2(t[1]); e[2] = fast_exp2(t[2]); e[3] = fast_exp2(t[3]);
                    e = e + 1.0f;
                    f32x4 r; r[0] = fast_rcp(e[0]); r[1] = fast_rcp(e[1]); r[2] = fast_rcp(e[2]); r[3] = fast_rcp(e[3]);
                    o[n] = (a * r) * b; }
                u32x2 w8; w8.x = pk4_fp8(o[0][0], o[0][1], o[0][2], o[0][3]); w8.y = pk4_fp8(o[1][0], o[1][1], o[1][2], o[1][3]);
                *(u32x2*)(O + (size_t)(u.row0 + rr) * ldc + col0) = w8; }
    }
};
struct EpiWin {
    static constexpr bool STAGED = false;
    bf16 *Q, *Kb, *Vb, *ZU, *ZV; const float *cosT, *sinT, *lng, *lnb;
    DI void operator()(const f32x4 (&acc)[2][2][4][2], const Unit& u, int wr, int wc, int fr, int fq) const {
        asm volatile("" : "+v"(fr), "+v"(fq));
        const int rbase = u.row0 + wr * 64 + fr, pn = u.pn;
        if (pn < 2 || (pn == 2 && wc < 2)) {
            bf16* dst; int ld, colb; float sc;
            if (pn < 2) { dst = Q; ld = 512; colb = 64 * (4 * pn + wc); sc = QSCALE; } else { dst = Kb; ld = 128; colb = 64 * wc; sc = 1.0f; }
#pragma unroll
            for (int hb = 0; hb < 2; ++hb) {
                f32x4 cc[4][2], ss[4][2];
#pragma unroll
                for (int m = 0; m < 4; ++m) { const int pos = (rbase + hb * HALF + m * 16) & (SEQ - 1);
#pragma unroll
                    for (int n = 0; n < 2; ++n) { cc[m][n] = *(const f32x4*)(cosT + pos * 32 + 8 * fq + 4 * n); ss[m][n] = *(const f32x4*)(sinT + pos * 32 + 8 * fq + 4 * n); } }
                asm volatile("" ::: "memory");
#pragma unroll
                for (int m = 0; m < 4; ++m) { const int ai = hb; const int row = rbase + ai * HALF + m * 16;
                    f32x4 o1[2], o2[2];
#pragma unroll
                    for (int n = 0; n < 2; ++n) { const f32x4 x1 = acc[ai][0][m][n], x2 = acc[ai][1][m][n];
                        o1[n] = (x1 * cc[m][n] - x2 * ss[m][n]) * sc; o2[n] = (x2 * cc[m][n] + x1 * ss[m][n]) * sc; }
                    bf16* rp = dst + (size_t)row * ld + colb + 8 * fq;
                    *(u32x4*)(rp) = pack8(o1[0], o1[1]); *(u32x4*)(rp + 32) = pack8(o2[0], o2[1]); }
                asm volatile("" ::: "memory");
            }
        } else if (pn == 2) {
#pragma unroll
            for (int ai = 0; ai < 2; ++ai)
#pragma unroll
                for (int m = 0; m < 4; ++m) { int row = rbase + ai * HALF + m * 16; asm volatile("" : "+v"(row) :: "memory"); bf16* rp = Vb + (size_t)row * 128 + 64 * (wc - 2) + 8 * fq;
#pragma unroll
                    for (int bj = 0; bj < 2; ++bj) *(u32x4*)(rp + 32 * bj) = pack8(acc[ai][bj][m][0], acc[ai][bj][m][1]); }
        } else if (pn < 5) {
#pragma unroll
            for (int ai = 0; ai < 2; ++ai)
#pragma unroll
                for (int m = 0; m < 4; ++m) { int row = rbase + ai * HALF + m * 16; asm volatile("" : "+v"(row) :: "memory"); bf16* rp = ZU + (size_t)row * 512 + 256 * (pn - 3) + 64 * wc + 8 * fq;
#pragma unroll
                    for (int bj = 0; bj < 2; ++bj) { f32x4 a = acc[ai][bj][m][0], b = acc[ai][bj][m][1];
#pragma unroll
                        for (int j = 0; j < 4; ++j) { a[j] = gelu_tanh(a[j]); b[j] = gelu_tanh(b[j]); }
                        *(u32x4*)(rp + 32 * bj) = pack8(a, b); } }
        } else {
            const int gi = 4 * (pn - 5) + wc;
            f32x4 gg[2][2], bb[2][2];
#pragma unroll
            for (int bj = 0; bj < 2; ++bj)
#pragma unroll
                for (int n = 0; n < 2; ++n) { gg[bj][n] = *(const f32x4*)(lng + gi * 64 + 32 * bj + 8 * fq + 4 * n); bb[bj][n] = *(const f32x4*)(lnb + gi * 64 + 32 * bj + 8 * fq + 4 * n); }
#pragma unroll
            for (int ai = 0; ai < 2; ++ai)
#pragma unroll
                for (int m = 0; m < 4; ++m) { int row = rbase + ai * HALF + m * 16; asm volatile("" : "+v"(row) :: "memory");
                    f32x4 z[2][2]; float s = 0.f;
#pragma unroll
                    for (int bj = 0; bj < 2; ++bj)
#pragma unroll
                        for (int n = 0; n < 2; ++n) {
#pragma unroll
                            for (int j = 0; j < 4; ++j) { z[bj][n][j] = gelu_tanh(acc[ai][bj][m][n][j]); s += z[bj][n][j]; } }
                    s += swz16_f(s); s = sum_x32(s);
                    const float mean = s * (1.0f / 64.0f); float q = 0.f;
#pragma unroll
                    for (int bj = 0; bj < 2; ++bj)
#pragma unroll
                        for (int n = 0; n < 2; ++n) { z[bj][n] = z[bj][n] - mean; q += (z[bj][n][0] * z[bj][n][0] + z[bj][n][1] * z[bj][n][1]) + (z[bj][n][2] * z[bj][n][2] + z[bj][n][3] * z[bj][n][3]); }
                    q += swz16_f(q); q = sum_x32(q);
                    const float rstd = 1.0f / sqrtf(q * (1.0f / 64.0f) + LN_EPS);
                    bf16* rp = ZV + (size_t)row * 512 + 64 * gi + 8 * fq;
#pragma unroll
                    for (int bj = 0; bj < 2; ++bj) *(u32x4*)(rp + 32 * bj) = pack8(z[bj][0] * rstd * gg[bj][0] + bb[bj][0], z[bj][1] * rstd * gg[bj][1] + bb[bj][1]); asm volatile("" ::: "memory"); }
        }
    }
};
}

#define XB_TMO      128
#define XB_XCNT(j)  (256  + 64 * (j))
#define XB_XSUB(j)  (1280 + 64 * (j))
#define XB_XGEN(j)  (2304 + 64 * (j))
#define XB_TOP      3328
#define XB_TOPGEN   3392
#define XCD_BAR_WORDS 3456
#define XB_SPIN_CAP (1u << 22)
DI unsigned xb_ld(unsigned* p)              { return __hip_atomic_load(p, __ATOMIC_RELAXED, __HIP_MEMORY_SCOPE_AGENT); }
DI unsigned xb_add(unsigned* p, unsigned v) { return __hip_atomic_fetch_add(p, v, __ATOMIC_RELAXED, __HIP_MEMORY_SCOPE_AGENT); }
DI unsigned xb_xcc_id() { return (unsigned)__builtin_amdgcn_s_getreg((3 << 11) | 20) & 0xFu; }
#define XB_SPIN(cond, bar) do { unsigned _sp = 0; while (cond) { __builtin_amdgcn_s_sleep(1); \
    if ((++_sp & 255u) == 0u) { if (xb_ld(&(bar)[XB_TMO])) break; if (_sp > XB_SPIN_CAP) { atomicAdd(&(bar)[XB_TMO], 1u); break; } } } } while (0)
struct XcdBarrier { GASP unsigned* bar; unsigned x; volatile LAS unsigned* st; };
DI XcdBarrier xcd_barrier_post(GASP unsigned* bar, volatile LAS unsigned* st, bool leader) {
    XcdBarrier b; b.bar = bar; b.x = xb_xcc_id(); b.st = st;
    if (leader) (void)xb_add((unsigned*)&bar[XB_XCNT(b.x)], 1u);
    return b;
}
DI void xcd_barrier_complete(unsigned* bar, unsigned x, unsigned& nloc, unsigned& nx) {
    const unsigned G = gridDim.x * gridDim.y * gridDim.z;
    unsigned sum, cnt, mine, sp = 0u;
    for (;;) {
        sum = 0u; cnt = 0u; mine = 0u;
#pragma unroll
        for (unsigned j = 0; j < 16; ++j) { const unsigned c = xb_ld(&bar[XB_XCNT(j)]); sum += c; cnt += (c > 0u) ? 1u : 0u; mine = (j == x) ? c : mine; }
        if (sum == G) break;
        __builtin_amdgcn_s_sleep(1);
        if ((++sp & 255u) == 0u) { if (xb_ld(&bar[XB_TMO])) break; if (sp > XB_SPIN_CAP) { atomicAdd(&bar[XB_TMO], 1u); break; } }
    }
    nloc = mine > 0u ? mine : 1u; nx = cnt > 0u ? cnt : 1u;
}
DI void xcd_barrier(const XcdBarrier& b, int wave) {
    asm volatile("s_waitcnt vmcnt(0)" ::: "memory");
    __syncthreads();
    if (wave == 0 && lane_id() == 0) {
        GASP unsigned* barg = b.bar; unsigned bx = b.x; asm volatile("" : "+s"(barg), "+s"(bx)); unsigned* bar = (unsigned*)barg;
        __builtin_amdgcn_s_waitcnt(0);
        unsigned nloc = b.st[0], nx = b.st[1];
        if (nloc == 0u) { xcd_barrier_complete(bar, bx, nloc, nx); b.st[0] = nloc; b.st[1] = nx; }
        const unsigned old = xb_add(&bar[XB_XSUB(bx)], 1u);
        const unsigned gen = old / nloc;
        if (old + 1u == (gen + 1u) * nloc) {
            __builtin_amdgcn_fence(__ATOMIC_RELEASE, "agent");
            asm volatile("s_waitcnt vmcnt(0)" ::: "memory");
            const unsigned og = xb_add(&bar[XB_TOP], 1u);
            const unsigned tg = og / nx;
            if (og + 1u == (tg + 1u) * nx) xb_add(&bar[XB_TOPGEN], 1u);
            else XB_SPIN(xb_ld(&bar[XB_TOPGEN]) == tg, bar);
            __builtin_amdgcn_fence(__ATOMIC_ACQUIRE, "agent");
            xb_add(&bar[XB_XGEN(bx)], 1u);
            asm volatile("s_waitcnt vmcnt(0)" ::: "memory");
        } else {
            XB_SPIN(xb_ld(&bar[XB_XGEN(bx)]) == gen, bar);
            __builtin_amdgcn_fence(__ATOMIC_ACQUIRE, "agent");
            asm volatile("s_waitcnt vmcnt(0)" ::: "memory");
        }
    }
    __syncthreads();
}

struct Frame {
    LAS unsigned char* lds;
    volatile LAS unsigned* MISC;
    unsigned* ctl;
    int tid, lane, wave, G, bid;
    GASP unsigned char* ws;
    GASP float* out;
};
struct Args { const float* in[27]; float* out; unsigned char* ws; };
typedef const unsigned char __attribute__((address_space(4)))* kptr_t;
DI const float* in_ptr(int k) { kptr_t p = (kptr_t)__builtin_amdgcn_kernarg_segment_ptr(); asm volatile("" : "+s"(p)); return (const float*)(*(GASP const float* const __attribute__((address_space(4)))*)(p + 8 * k)); }
struct ArgsRef { struct Acc { DI const float* operator[](int k) const { return in_ptr(k); } } in; };

template <int MAP>
DI int conv_col(int nb2, int lane, bool& second) {
    second = false;
    if (MAP == 0) return 64 * nb2 + lane;
    const int pn = nb2 >> 2, bj = (nb2 >> 1) & 1, wcp = nb2 & 1;
    if (MAP == 2) { second = bj != 0; return 128 * pn + 64 * wcp + lane; }
    return 256 * pn + 128 * wcp + 32 * bj + 64 * (lane >> 5) + (lane & 31);
}
template <int MAP>
DI void conv_job(Frame& F, const float* s1, const float* s2, bf16* dst, int K, int ldw, int nblk64, int nexp) {
    const int gw = F.bid * NWAVES + F.wave, NGW = F.G * NWAVES, lane = F.lane;
    const int per = (K / 64) * nblk64, total = per * nexp;
    for (int it = gw; it < total; it += NGW) {
        const int e = it / per, r = it - e * per, kb = r / nblk64, nb2 = r - kb * nblk64;
        bool second; const int col = conv_col<MAP>(nb2, lane, second);
        const float* W = (second ? s2 : s1) + (size_t)e * K * ldw + (size_t)(64 * kb) * ldw + col;
        float v[64];
#pragma unroll
        for (int k = 0; k < 64; ++k) v[k] = W[(size_t)k * ldw];
        bf16* drow = dst + ((size_t)e * nblk64 * 64 + (size_t)nb2 * 64 + lane) * K + 64 * kb;
#pragma unroll
        for (int q = 0; q < 8; ++q) { u32x4 o; o.x = pk2(v[8 * q], v[8 * q + 1]); o.y = pk2(v[8 * q + 2], v[8 * q + 3]); o.z = pk2(v[8 * q + 4], v[8 * q + 5]); o.w = pk2(v[8 * q + 6], v[8 * q + 7]); *(u32x4*)(drow + 8 * q) = o; }
    }
}
template <int MAP>
DI void conv_job_i8(Frame& F, const float* s1, const float* s2, unsigned char* dst, float* swout, int ldw, int nblk64, int nexp) {
    constexpr int K = D, KW = K / NWAVES;
    LAS float* wmax = (LAS float*)(F.lds + 124 * 1024);
    LAS float* sinv = wmax + 512;
    const int lane = F.lane, w = F.wave;
    for (int it = F.bid; it < nblk64 * nexp; it += F.G) {
        const int e = it / nblk64, nb2 = it - e * nblk64;
        bool second; const int col = conv_col<MAP>(nb2, lane, second);
        const float* W = (second ? s2 : s1) + (size_t)e * K * ldw + (size_t)(KW * w) * ldw + col;
        float v[KW]; float mx = 0.f;
#pragma unroll
        for (int k = 0; k < KW; ++k) v[k] = W[(size_t)k * ldw];
#pragma unroll
        for (int k = 0; k < KW; ++k) mx = fmaxf(mx, fabsf(v[k]));
        wmax[w * 64 + lane] = mx;
        __syncthreads();
        if (w == 0) { float m = wmax[lane];
#pragma unroll
            for (int j = 1; j < 8; ++j) m = fmaxf(m, wmax[j * 64 + lane]);
            swout[(size_t)e * nblk64 * 64 + nb2 * 64 + lane] = m * (1.0f / 127.0f); sinv[lane] = m > 0.f ? 127.0f / m : 0.f; }
        __syncthreads();
        const float iv = sinv[lane];
        unsigned char* drow = dst + ((size_t)e * nblk64 * 64 + (size_t)nb2 * 64 + lane) * K + KW * w;
#pragma unroll
        for (int q = 0; q < KW / 16; ++q) { u32x4 o;
            o.x = pk4_i8(v[16 * q], v[16 * q + 1], v[16 * q + 2], v[16 * q + 3], iv); o.y = pk4_i8(v[16 * q + 4], v[16 * q + 5], v[16 * q + 6], v[16 * q + 7], iv);
            o.z = pk4_i8(v[16 * q + 8], v[16 * q + 9], v[16 * q + 10], v[16 * q + 11], iv); o.w = pk4_i8(v[16 * q + 12], v[16 * q + 13], v[16 * q + 14], v[16 * q + 15], iv);
            *(u32x4*)(drow + 16 * q) = o; }
        __syncthreads();
    }
}
DI void wmax_job(Frame& F, const float* s1, unsigned* wmax, int K, int ldw, int nexp) {
    const int gw = F.bid * NWAVES + F.wave, NGW = F.G * NWAVES, lane = F.lane;
    const int nb = ldw / 64, ks = K / 352, per = nb * ks, total = per * nexp;
    for (int it = gw; it < total; it += NGW) {
        const int e = it / per, r = it - e * per, kb = r / nb, nb2 = r - kb * nb;
        const float* W = s1 + (size_t)e * K * ldw + (size_t)(352 * kb) * ldw + 64 * nb2 + lane;
        float mx = 0.f;
#pragma unroll 32
        for (int k = 0; k < 352; ++k) mx = fmaxf(mx, fabsf(W[(size_t)k * ldw]));
        atomicMax(wmax + (size_t)e * ldw + 64 * nb2 + lane, __float_as_uint(mx));
    }
}
DI void conv_job_f8(Frame& F, const float* s1, unsigned char* dst, float* swout, const unsigned* wmax, int K, int ldw, int nblk64, int nexp) {
    const int gw = F.bid * NWAVES + F.wave, NGW = F.G * NWAVES, lane = F.lane;
    const int per = (K / 64) * nblk64, total = per * nexp;
    for (int it = gw; it < total; it += NGW) {
        const int e = it / per, r = it - e * per, kb = r / nblk64, nb2 = r - kb * nblk64;
        const float m = __uint_as_float(__hip_atomic_load(wmax + (size_t)e * ldw + 64 * nb2 + lane, __ATOMIC_RELAXED, __HIP_MEMORY_SCOPE_AGENT));
        const float iv = m > 0.f ? 256.0f / m : 0.f;
        if (kb == 0) swout[(size_t)e * nblk64 * 64 + nb2 * 64 + lane] = m * (1.0f / 256.0f);
        const float* W = s1 + (size_t)e * K * ldw + (size_t)(64 * kb) * ldw + 64 * nb2 + lane;
        float v[64];
#pragma unroll
        for (int k = 0; k < 64; ++k) v[k] = W[(size_t)k * ldw];
        unsigned char* drow = dst + ((size_t)e * nblk64 * 64 + (size_t)nb2 * 64 + lane) * K + 64 * kb;
#pragma unroll
        for (int q = 0; q < 4; ++q) { u32x4 o; o.x = pk4_fp8(v[16 * q] * iv, v[16 * q + 1] * iv, v[16 * q + 2] * iv, v[16 * q + 3] * iv); o.y = pk4_fp8(v[16 * q + 4] * iv, v[16 * q + 5] * iv, v[16 * q + 6] * iv, v[16 * q + 7] * iv);
            o.z = pk4_fp8(v[16 * q + 8] * iv, v[16 * q + 9] * iv, v[16 * q + 10] * iv, v[16 * q + 11] * iv); o.w = pk4_fp8(v[16 * q + 12] * iv, v[16 * q + 13] * iv, v[16 * q + 14] * iv, v[16 * q + 15] * iv);
            *(u32x4*)(drow + 16 * q) = o; }
    }
}
DI void wmax_layer(Frame& F, const ArgsRef& a, int L) {
    FRESH(F);
    const int i = L >> 1; unsigned* wm = F.ctl + CW_WMAX + (size_t)i * 9 * D;
    if ((L & 1) == 0) wmax_job(F, a.in[12] + (size_t)i * FF * D, wm + 8 * D, FF, D, 1);
    else wmax_job(F, a.in[26] + (size_t)i * NE * FF * D, wm, FF, D, NE);
}
DI void conv_down(Frame& F, const ArgsRef& a, int L) {
    FRESH(F);
    const int i = L >> 1; const unsigned* wm = F.ctl + CW_WMAX + (size_t)i * 9 * D; unsigned char* Wb8 = (unsigned char*)(F.ws + WS_W);
    if ((L & 1) == 0) conv_job_f8(F, a.in[12] + (size_t)i * FF * D, Wb8 + W_DN, (float*)(F.ws + WS_SWD), wm + 8 * D, FF, D, D / 64, 1);
    else conv_job_f8(F, a.in[26] + (size_t)i * NE * FF * D, Wb8 + W_MDN, (float*)(F.ws + WS_SWD), wm, FF, D, D / 64, NE);
}
DI void conv_layer(Frame& F, const ArgsRef& a, int L) {
    FRESH(F);
    bf16* Wb = (bf16*)(F.ws + WS_W);
    const int i = L >> 1;
    if ((L & 1) == 0) {
        conv_job<1>(F, a.in[3] + (size_t)i * D * INW, nullptr, (bf16*)((char*)Wb + W_IN), D, INW, INW / 64, 1);
        conv_job<0>(F, a.in[9] + (size_t)i * D * D, nullptr, (bf16*)((char*)Wb + W_OUT), D, D, D / 64, 1);
        conv_job_i8<2>(F, a.in[10] + (size_t)i * D * FF, a.in[11] + (size_t)i * D * FF, (unsigned char*)Wb + W_GU, (float*)(F.ws + WS_SW), FF, 2 * FF / 64, 1);
        const float* sw = a.in[5] + (size_t)i * 8 * 128 * 128; bf16* dw = (bf16*)(F.ws + WS_SGUW);
        for (int idx = F.bid * 512 + F.tid; idx < 8 * 128 * 128 / 4; idx += F.G * 512) { const f32x4 v = *(const f32x4*)(sw + 4 * idx); u32x2 o; o.x = pk2(v[0], v[1]); o.y = pk2(v[2], v[3]); *(u32x2*)(dw + 4 * idx) = o; }
    } else {
        conv_job<2>(F, a.in[21] + (size_t)i * D * D, a.in[22] + (size_t)i * D * D, (bf16*)((char*)Wb + W_GLU), D, D, 2 * D / 64, 1);
        conv_job_i8<2>(F, a.in[24] + (size_t)i * NE * D * FF, a.in[25] + (size_t)i * NE * D * FF, (unsigned char*)Wb + W_MGU, (float*)(F.ws + WS_SW), FF, 2 * FF / 64, NE);
    }
}

DI void prologue(Frame& F, const ArgsRef& a) {
    FRESH(F);
    const float* x = a.in[0]; bf16* XB = (bf16*)(F.ws + WS_XB);
    const size_t nthr = (size_t)F.G * 512, t0 = (size_t)F.bid * 512 + F.tid;
    for (size_t i = t0; i < (size_t)T * D / 8; i += nthr) { const f32x4 v0 = *(const f32x4*)(x + 8 * i), v1 = *(const f32x4*)(x + 8 * i + 4); *(u32x4*)(XB + 8 * i) = pg8::pack8(v0, v1); }
    float* cosT = (float*)(F.ws + WS_ROPE); float* sinT = cosT + SEQ * 32;
    for (size_t i = t0; i < (size_t)SEQ * 32; i += nthr) { const int pos = (int)(i >> 5), d = (int)(i & 31);
        const float invf = (float)exp_d(-(double)(2 * d) * (9.2103403719761836 / 64.0));
        const float ang = (float)pos * invf; double s, c; sincos_d((double)ang, s, c); cosT[i] = (float)c; sinT[i] = (float)s; }
}

DI void ln_core(f32x4 (&v)[4], const f32x4 (&g)[4], const f32x4 (&b)[4]) {
    float s = 0.f;
#pragma unroll
    for (int j = 0; j < 4; ++j) s += (v[j][0] + v[j][1]) + (v[j][2] + v[j][3]);
    const float mean = wave_sum(s) * (1.0f / D); float q = 0.f;
#pragma unroll
    for (int j = 0; j < 4; ++j) { v[j] = v[j] - mean; q += (v[j][0] * v[j][0] + v[j][1] * v[j][1]) + (v[j][2] * v[j][2] + v[j][3] * v[j][3]); }
    const float rstd = 1.0f / sqrtf(wave_sum(q) * (1.0f / D) + LN_EPS);
#pragma unroll
    for (int j = 0; j < 4; ++j) v[j] = v[j] * rstd * g[j] + b[j];
}
DI void ln_store(const f32x4 (&v)[4], bf16* XB, size_t row, int lane) {
#pragma unroll
    for (int j = 0; j < 4; ++j) { u32x2 o; o.x = pk2(v[j][0], v[j][1]); o.y = pk2(v[j][2], v[j][3]); *(u32x2*)(XB + row * D + 4 * lane + 256 * j) = o; }
}
DI void ln_load(f32x4 (&v)[4], const bf16* Y, size_t row, int lane) {
#pragma unroll
    for (int j = 0; j < 4; ++j) { const u32x2 yv = *(const u32x2*)(Y + row * D + 4 * lane + 256 * j); v[j] = (f32x4){bf_lo(yv.x), bf_hi(yv.x), bf_lo(yv.y), bf_hi(yv.y)}; }
}
DI void ln_pass_plain(Frame& F, const float* g_, const float* b_, const bool q8copy) {
    FRESH(F);
    const bf16* Y = (const bf16*)(F.ws + WS_Y); bf16* XB = (bf16*)(F.ws + WS_XB);
    f32x4 g[4], b[4];
#pragma unroll
    for (int j = 0; j < 4; ++j) { g[j] = *(const f32x4*)(g_ + 4 * F.lane + 256 * j); b[j] = *(const f32x4*)(b_ + 4 * F.lane + 256 * j); }
    const int gw = F.bid * NWAVES + F.wave, NGW = F.G * NWAVES;
    for (int row = gw; row < T; row += NGW) {
        f32x4 v[4]; ln_load(v, Y, (size_t)row, F.lane);
        ln_core(v, g, b);
        ln_store(v, XB, (size_t)row, F.lane);
        if (q8copy) {
            float mx = 0.f;
#pragma unroll
            for (int j = 0; j < 4; ++j) mx = fmaxf(mx, fmaxf(fmaxf(fabsf(v[j][0]), fabsf(v[j][1])), fmaxf(fabsf(v[j][2]), fabsf(v[j][3]))));
            mx = wave_max(mx);
            const float inv = mx > 0.f ? 127.0f / mx : 0.f;
            unsigned char* X8 = (unsigned char*)(F.ws + WS_XB8);
#pragma unroll
            for (int j = 0; j < 4; ++j) *(unsigned*)(X8 + (size_t)row * D + 4 * F.lane + 256 * j) = pk4_i8(v[j][0], v[j][1], v[j][2], v[j][3], inv);
            if (F.lane == 0) ((float*)(F.ws + WS_SX))[row] = mx * (1.0f / 127.0f);
        }
    }
}
DI void ln_pass_router(Frame& F, const float* g_, const float* b_, const float* rw_, unsigned* cnt, const size_t rec_off) {
    FRESH(F);
    const bf16* Y = (const bf16*)(F.ws + WS_Y); bf16* XB = (bf16*)(F.ws + WS_XB);
    i32x4* RECI = (i32x4*)(F.ws + WS_RECI + rec_off); f32x2* RECW = (f32x2*)(F.ws + WS_RECW + rec_off);
    LAS int* lcnt = (LAS int*)(F.lds); LAS int* lbase = lcnt + 8;
    LAS int* re0 = lcnt + 64; LAS int* re1 = re0 + 256; LAS int* rp0 = re1 + 256; LAS int* rp1 = rp0 + 256; LAS float* rw0 = (LAS float*)(rp1 + 256); LAS float* rw1 = rw0 + 256;
    f32x4 g[4], b[4];
#pragma unroll
    for (int j = 0; j < 4; ++j) { g[j] = *(const f32x4*)(g_ + 4 * F.lane + 256 * j); b[j] = *(const f32x4*)(b_ + 4 * F.lane + 256 * j); }
    f32x4 rwa[4][4], rwb[4][4];
#pragma unroll
    for (int j = 0; j < 4; ++j)
#pragma unroll
        for (int c = 0; c < 4; ++c) { const float* p = rw_ + (size_t)(4 * F.lane + 256 * j + c) * 8; rwa[j][c] = *(const f32x4*)p; rwb[j][c] = *(const f32x4*)(p + 4); }
    for (int pnl = F.bid; pnl < T / 256; pnl += F.G) {
        if (F.tid < 8) lcnt[F.tid] = 0;
        __syncthreads();
        for (int rr = 0; rr < 32; ++rr) {
            const int lr = F.wave + 8 * rr; const size_t row = (size_t)pnl * 256 + lr;
            f32x4 v[4]; ln_load(v, Y, row, F.lane);
            ln_core(v, g, b);
            ln_store(v, XB, row, F.lane);
            f32x4 la = {0.f, 0.f, 0.f, 0.f}, lb = {0.f, 0.f, 0.f, 0.f};
#pragma unroll
            for (int j = 0; j < 4; ++j)
#pragma unroll
                for (int c = 0; c < 4; ++c) { la += rwa[j][c] * v[j][c]; lb += rwb[j][c] * v[j][c]; }
            float lg[8];
#pragma unroll
            for (int e = 0; e < 4; ++e) { lg[e] = wave_sum(la[e]); lg[4 + e] = wave_sum(lb[e]); }
            int i0 = 0; float l0 = lg[0];
#pragma unroll
            for (int e = 1; e < 8; ++e) if (lg[e] > l0) { l0 = lg[e]; i0 = e; }
            int i1 = -1; float l1 = -3.0e38f;
#pragma unroll
            for (int e = 0; e < 8; ++e) if (e != i0 && lg[e] > l1) { l1 = lg[e]; i1 = e; }
            const float w0 = 1.0f / (1.0f + __expf(l1 - l0)), w1 = 1.0f - w0;
            if (F.lane == 0) { const int p0 = atomicAdd((int*)(lcnt + i0), 1), p1 = atomicAdd((int*)(lcnt + i1), 1);
                re0[lr] = i0; re1[lr] = i1; rp0[lr] = p0; rp1[lr] = p1; rw0[lr] = w0; rw1[lr] = w1; }
        }
        __syncthreads();
        if (F.tid < 8) lbase[F.tid] = (int)xb_add(cnt + F.tid, (unsigned)lcnt[F.tid]);
        __syncthreads();
        if (F.tid < 256) { const int e0 = re0[F.tid], e1 = re1[F.tid]; const size_t row = (size_t)pnl * 256 + F.tid;
            RECI[row] = (i32x4){e0, lbase[e0] + rp0[F.tid], e1, lbase[e1] + rp1[F.tid]}; RECW[row] = (f32x2){rw0[F.tid], rw1[F.tid]}; }
        __syncthreads();
    }
}
DI void moe_tiles(const unsigned* cnt, int (&tb)[9], int (&cn)[8]) {
    int acc = 0;
#pragma unroll
    for (int e = 0; e < 8; ++e) { cn[e] = __builtin_amdgcn_readfirstlane((int)__hip_atomic_load(cnt + e, __ATOMIC_RELAXED, __HIP_MEMORY_SCOPE_AGENT)); tb[e] = acc; acc += (cn[e] + 255) >> 8; }
    tb[8] = acc;
}
DI void moe_gather(Frame& F, const unsigned* cnt) {
    FRESH(F);
    int tb[9], cn[8]; moe_tiles(cnt, tb, cn);
    const bf16* XB = (const bf16*)(F.ws + WS_XB); unsigned char* XS = (unsigned char*)(F.ws + WS_XS); float* SXS = (float*)(F.ws + WS_SXS); const i32x4* RECI = (const i32x4*)(F.ws + WS_RECI);
    const int gw = F.bid * NWAVES + F.wave, NGW = F.G * NWAVES;
    for (int t = gw; t < T; t += NGW) {
        const i32x4 r = RECI[t];
        int b0 = 0, b1 = 0;
#pragma unroll
        for (int e = 0; e < 8; ++e) { b0 = (r[0] == e) ? tb[e] : b0; b1 = (r[2] == e) ? tb[e] : b1; }
        const size_t r0 = (size_t)b0 * 256 + r[1], r1 = (size_t)b1 * 256 + r[3];
        const u32x4 v0 = *(const u32x4*)(XB + (size_t)t * D + 8 * F.lane), v1 = *(const u32x4*)(XB + (size_t)t * D + 512 + 8 * F.lane);
        float f[16] = {bf_lo(v0.x), bf_hi(v0.x), bf_lo(v0.y), bf_hi(v0.y), bf_lo(v0.z), bf_hi(v0.z), bf_lo(v0.w), bf_hi(v0.w),
                       bf_lo(v1.x), bf_hi(v1.x), bf_lo(v1.y), bf_hi(v1.y), bf_lo(v1.z), bf_hi(v1.z), bf_lo(v1.w), bf_hi(v1.w)};
        float mx = 0.f;
#pragma unroll
        for (int k = 0; k < 16; ++k) mx = fmaxf(mx, fabsf(f[k]));
        mx = wave_max(mx);
        const float inv = mx > 0.f ? 127.0f / mx : 0.f, sc = mx * (1.0f / 127.0f);
        u32x2 q0, q1;
        q0.x = pk4_i8(f[0], f[1], f[2], f[3], inv); q0.y = pk4_i8(f[4], f[5], f[6], f[7], inv); q1.x = pk4_i8(f[8], f[9], f[10], f[11], inv); q1.y = pk4_i8(f[12], f[13], f[14], f[15], inv);
        *(u32x2*)(XS + r0 * D + 8 * F.lane) = q0; *(u32x2*)(XS + r0 * D + 512 + 8 * F.lane) = q1;
        *(u32x2*)(XS + r1 * D + 8 * F.lane) = q0; *(u32x2*)(XS + r1 * D + 512 + 8 * F.lane) = q1;
        if (F.lane == 0) { SXS[r0] = sc; SXS[r1] = sc; }
    }
#pragma unroll
    for (int e = 0; e < 8; ++e) { const int first = tb[e] * 256 + cn[e], last = tb[e + 1] * 256;
        for (int r = first + gw; r < last; r += NGW) { const u32x2 z = {0u, 0u}; *(u32x2*)(XS + (size_t)r * D + 8 * F.lane) = z; *(u32x2*)(XS + (size_t)r * D + 512 + 8 * F.lane) = z; if (F.lane == 0) SXS[r] = 0.f; } }
}
DI void ln_pass_combine(Frame& F, const float* g_, const float* b_, const unsigned* cnt, const bool final_, const bool dummy_) {
    FRESH(F);
    int tb[9], cn[8]; moe_tiles(cnt, tb, cn);
    const bf16* YS = (const bf16*)(F.ws + WS_YS); bf16* XB = (bf16*)(F.ws + WS_XB); float* X = (float*)F.out;
    const i32x4* RECI = (const i32x4*)(F.ws + WS_RECI); const f32x2* RECW = (const f32x2*)(F.ws + WS_RECW);
    f32x4 g[4], b[4];
#pragma unroll
    for (int j = 0; j < 4; ++j) { g[j] = *(const f32x4*)(g_ + 4 * F.lane + 256 * j); b[j] = *(const f32x4*)(b_ + 4 * F.lane + 256 * j); }
    const int gw = F.bid * NWAVES + F.wave, NGW = F.G * NWAVES;
    for (int row = gw; row < T; row += NGW) {
        const i32x4 r = RECI[row]; const f32x2 w = RECW[row];
        int b0 = 0, b1 = 0;
#pragma unroll
        for (int e = 0; e < 8; ++e) { b0 = (r[0] == e) ? tb[e] : b0; b1 = (r[2] == e) ? tb[e] : b1; }
        const size_t r0 = (size_t)b0 * 256 + r[1], r1 = (size_t)b1 * 256 + r[3];
        f32x4 v[4];
#pragma unroll
        for (int j = 0; j < 4; ++j) { const u32x2 xv = *(const u32x2*)(XB + (size_t)row * D + 4 * F.lane + 256 * j);
            const u32x2 ya = *(const u32x2*)(YS + r0 * D + 4 * F.lane + 256 * j), yb = *(const u32x2*)(YS + r1 * D + 4 * F.lane + 256 * j);
            v[j][0] = ALPHA * bf_lo(xv.x) + (w[0] * bf_lo(ya.x) + w[1] * bf_lo(yb.x)); v[j][1] = ALPHA * bf_hi(xv.x) + (w[0] * bf_hi(ya.x) + w[1] * bf_hi(yb.x));
            v[j][2] = ALPHA * bf_lo(xv.y) + (w[0] * bf_lo(ya.y) + w[1] * bf_lo(yb.y)); v[j][3] = ALPHA * bf_hi(xv.y) + (w[0] * bf_hi(ya.y) + w[1] * bf_hi(yb.y)); }
        ln_core(v, g, b);
        if (dummy_) ln_store(v, (bf16*)(F.ws + WS_XS), (size_t)row, F.lane);
        else if (final_) {
#pragma unroll
            for (int j = 0; j < 4; ++j) *(f32x4*)(X + (size_t)row * D + 4 * F.lane + 256 * j) = v[j];
        } else ln_store(v, XB, (size_t)row, F.lane);
    }
}

constexpr int KL_STRIDE = 144, VT_STRIDE = 776, VT_OFF = 384 * KL_STRIDE;
DI void attn_phase(Frame& F, const float* sink) {
    FRESH(F);
    const bf16* Q = (const bf16*)(F.ws + WS_Q); const bf16* Kb = (const bf16*)(F.ws + WS_K); const bf16* Vb = (const bf16*)(F.ws + WS_V); bf16* MIX = (bf16*)(F.ws + WS_MIX);
    LAS unsigned char* Kl = F.lds; LAS unsigned char* Vt = F.lds + VT_OFF;
    const int lane = F.lane, l31 = lane & 31, h = lane >> 5, w = F.wave;
    for (int unit = F.bid; unit < BATCH * 2 * 16; unit += F.G) {
        const int b = unit >> 5, kvh = (unit >> 4) & 1, n = unit & 15;
        __syncthreads();
        for (int idx = F.tid; idx < 384 * 8; idx += 512) {
            const int key = idx >> 3, ch = idx & 7, kp = (n - 1) * 128 + key;
            u32x4 kv = {0u, 0u, 0u, 0u}, vv = {0u, 0u, 0u, 0u};
            if (kp >= 0 && kp < SEQ) { const size_t off = (size_t)(b * SEQ + kp) * 128 + kvh * 64 + ch * 8; kv = *(const u32x4*)(Kb + off); vv = *(const u32x4*)(Vb + off); }
            *(LAS u32x4*)(Kl + key * KL_STRIDE + ch * 16) = kv;
            LAS unsigned short* vd = (LAS unsigned short*)(Vt + (ch * 8) * VT_STRIDE + key * 2);
            constexpr int RS = VT_STRIDE / 2;
            vd[0 * RS] = (unsigned short)(vv.x & 0xffffu); vd[1 * RS] = (unsigned short)(vv.x >> 16); vd[2 * RS] = (unsigned short)(vv.y & 0xffffu); vd[3 * RS] = (unsigned short)(vv.y >> 16);
            vd[4 * RS] = (unsigned short)(vv.z & 0xffffu); vd[5 * RS] = (unsigned short)(vv.z >> 16); vd[6 * RS] = (unsigned short)(vv.w & 0xffffu); vd[7 * RS] = (unsigned short)(vv.w >> 16);
        }
        __syncthreads();
        const int hq = kvh * 4 + (w >> 1);
        const float m0 = sink[hq] * LOG2E;
        for (int qb = 0; qb < 2; ++qb) {
            const int q0 = 64 * (w & 1) + 32 * qb;
            const size_t qrow = (size_t)(b * SEQ + n * 128 + q0 + l31);
            bf16x8 bq[4];
#pragma unroll
            for (int ks = 0; ks < 4; ++ks) bq[ks] = *(const bf16x8*)(Q + qrow * 512 + hq * 64 + 16 * ks + 8 * h);
            float m2 = m0, l = 1.0f;
            f32x16 O0, O1;
#pragma unroll
            for (int i = 0; i < 16; ++i) { O0[i] = 0.f; O1[i] = 0.f; }
            const int kt0 = q0 >> 5, qk = q0 + l31; const bool edge = (n == 0) || (n == 15);
            for (int kt = kt0; kt <= kt0 + 8; ++kt) {
                f32x16 X;
#pragma unroll
                for (int i = 0; i < 16; ++i) X[i] = 0.f;
#pragma unroll
                for (int ks = 0; ks < 4; ++ks) { const bf16x8 a = *(const LAS bf16x8*)(Kl + (32 * kt + l31) * KL_STRIDE + (16 * ks + 8 * h) * 2); X = MFMA32(a, bq[ks], X); }
                float mx = -1.0e30f;
                if (kt == kt0 || kt == kt0 + 8 || edge) {
#pragma unroll
                    for (int i = 0; i < 16; ++i) { const int kk = 32 * kt + crow(i, h); const int kp = (n - 1) * 128 + kk;
                        const bool valid = (kk >= qk) && (kk <= qk + 256) && (kp >= 0) && (kp < SEQ);
                        X[i] = valid ? X[i] : -1.0e30f; mx = fmaxf(mx, X[i]); }
                } else {
#pragma unroll
                    for (int i = 0; i < 16; ++i) mx = fmaxf(mx, X[i]);
                }
                mx = max_x32(mx);
                const float mn = fmaxf(m2, mx), alpha = fast_exp2(m2 - mn); m2 = mn;
                float ps = 0.f;
#pragma unroll
                for (int i = 0; i < 16; ++i) { X[i] = fast_exp2(X[i] - mn); ps += X[i]; }
                ps = sum_x32(ps);
                l = l * alpha + ps;
#pragma unroll
                for (int i = 0; i < 16; ++i) { O0[i] *= alpha; O1[i] *= alpha; }
#pragma unroll
                for (int s = 0; s < 2; ++s) {
                    u32x4 pw; pw.x = pk2(X[8 * s + 0], X[8 * s + 1]); pw.y = pk2(X[8 * s + 2], X[8 * s + 3]); pw.z = pk2(X[8 * s + 4], X[8 * s + 5]); pw.w = pk2(X[8 * s + 6], X[8 * s + 7]);
                    const bf16x8 pf = __builtin_bit_cast(bf16x8, pw);
                    const int kb = (32 * kt + 16 * s + 4 * h) * 2;
                    { const s16x4 lo = *(const LAS s16x4*)(Vt + l31 * VT_STRIDE + kb), hi = *(const LAS s16x4*)(Vt + l31 * VT_STRIDE + kb + 16);
                      O0 = MFMA32(__builtin_shufflevector(lo, hi, 0, 1, 2, 3, 4, 5, 6, 7), pf, O0); }
                    { const s16x4 lo = *(const LAS s16x4*)(Vt + (32 + l31) * VT_STRIDE + kb), hi = *(const LAS s16x4*)(Vt + (32 + l31) * VT_STRIDE + kb + 16);
                      O1 = MFMA32(__builtin_shufflevector(lo, hi, 0, 1, 2, 3, 4, 5, 6, 7), pf, O1); }
                }
            }
            const float inv = 1.0f / l;
            bf16* orow = MIX + qrow * D + hq * 64;
#pragma unroll
            for (int g4 = 0; g4 < 4; ++g4) {
                u32x2 o; o.x = pk2(O0[4 * g4] * inv, O0[4 * g4 + 1] * inv); o.y = pk2(O0[4 * g4 + 2] * inv, O0[4 * g4 + 3] * inv); *(u32x2*)(orow + 8 * g4 + 4 * h) = o;
                u32x2 p; p.x = pk2(O1[4 * g4] * inv, O1[4 * g4 + 1] * inv); p.y = pk2(O1[4 * g4 + 2] * inv, O1[4 * g4 + 3] * inv); *(u32x2*)(orow + 32 + 8 * g4 + 4 * h) = p;
            }
        }
    }
    __syncthreads();
}

constexpr int SG_STRIDE = 272;
DI void sgu_phase(Frame& F, const float* sgu_b) {
    FRESH(F);
    const bf16* ZU = (const bf16*)(F.ws + WS_ZU); const bf16* ZV = (const bf16*)(F.ws + WS_ZV); const bf16* Wsb = (const bf16*)(F.ws + WS_SGUW); bf16* MIX = (bf16*)(F.ws + WS_MIX);
    LAS unsigned char* VT = F.lds + F.wave * (32 * SG_STRIDE);
    const int lane = F.lane, l31 = lane & 31, h = lane >> 5;
    const int gw = F.bid * NWAVES + F.wave, NGW = F.G * NWAVES;
    for (int su = gw; su < BATCH * 16 * 8 * 2; su += NGW) {
        const int dh = su & 1, g = (su >> 1) & 7, n = (su >> 4) & 15, b = su >> 8;
        const size_t rowb = (size_t)(b * SEQ + n * 128);
#pragma unroll
        for (int i = 0; i < 8; ++i) { const int c = lane + 64 * i, q = c >> 2, ch = c & 3;
            const u32x4 vv = *(const u32x4*)(ZV + (rowb + q) * 512 + 64 * g + 32 * dh + 8 * ch);
            LAS unsigned short* vd = (LAS unsigned short*)(VT + (ch * 8) * SG_STRIDE + q * 2);
            constexpr int RS = SG_STRIDE / 2;
            vd[0 * RS] = (unsigned short)(vv.x & 0xffffu); vd[1 * RS] = (unsigned short)(vv.x >> 16); vd[2 * RS] = (unsigned short)(vv.y & 0xffffu); vd[3 * RS] = (unsigned short)(vv.y >> 16);
            vd[4 * RS] = (unsigned short)(vv.z & 0xffffu); vd[5 * RS] = (unsigned short)(vv.z >> 16); vd[6 * RS] = (unsigned short)(vv.w & 0xffffu); vd[7 * RS] = (unsigned short)(vv.w >> 16); }
        bf16x8 af[8];
#pragma unroll
        for (int ks = 0; ks < 8; ++ks) af[ks] = *(const LAS bf16x8*)(VT + l31 * SG_STRIDE + (16 * ks + 8 * h) * 2);
#pragma unroll
        for (int pt = 0; pt < 4; ++pt) {
            const int p = 32 * pt + l31;
            f32x16 acc;
#pragma unroll
            for (int i = 0; i < 16; ++i) acc[i] = 0.f;
#pragma unroll
            for (int ks = 0; ks < 8; ++ks) { const bf16x8 bw = *(const bf16x8*)(Wsb + ((size_t)g * 128 + p) * 128 + 16 * ks + 8 * h); acc = MFMA32(af[ks], bw, acc); }
            const float bias = sgu_b[g * 128 + p];
            const size_t row = rowb + p;
#pragma unroll
            for (int g4 = 0; g4 < 4; ++g4) { const int d = 32 * dh + 8 * g4 + 4 * h;
                const u32x2 uu = *(const u32x2*)(ZU + row * 512 + 64 * g + d);
                u32x2 o; o.x = pk2(bf_lo(uu.x) * (acc[4 * g4] + bias), bf_hi(uu.x) * (acc[4 * g4 + 1] + bias)); o.y = pk2(bf_lo(uu.y) * (acc[4 * g4 + 2] + bias), bf_hi(uu.y) * (acc[4 * g4 + 3] + bias));
                *(u32x2*)(MIX + row * D + 512 + 64 * g + d) = o; }
        }
        LDS_WAIT();
    }
}

constexpr int S5_STRIDE = 272;
DI void sincos_f(float th, float& s, float& c) {
    const float tq = th * 0.636619772367581f, q = rintf(tq), f = (tq - q) * 1.5707963267948966f, f2 = f * f;
    const float sp = f * (1.0f + f2 * (-1.6666667e-1f + f2 * (8.3333333e-3f + f2 * (-1.9841270e-4f + f2 * 2.7557319e-6f))));
    const float cp = 1.0f + f2 * (-0.5f + f2 * (4.1666667e-2f + f2 * (-1.3888889e-3f + f2 * (2.4801587e-5f + f2 * (-2.7557319e-7f)))));
    const int qi = ((int)q) & 3;
    s = (qi == 0) ? sp : (qi == 1) ? cp : (qi == 2) ? -sp : -cp;
    c = (qi == 0) ? cp : (qi == 1) ? -sp : (qi == 2) ? -cp : sp;
}
DI void zoh_params(float lr, float li, float logdt, float& br, float& bi, float& cr, float& ci) {
    const float dt = expf(logdt);
    const float ea = expf(lr * dt);
    float sn, cs; sincos_f(li * dt, sn, cs);
    br = ea * cs; bi = ea * sn;
    const float nr = br - 1.0f, rden = 1.0f / (lr * lr + li * li);
    cr = (nr * lr + bi * li) * rden; ci = (bi * lr - nr * li) * rden;
}
DI void s5_phase(Frame& F, const ArgsRef& a, int i) {
    FRESH(F);
    const bf16* XB = (const bf16*)(F.ws + WS_XB); bf16* YF = (bf16*)(F.ws + WS_YF);     bf16* YG = (bf16*)(F.ws + WS_YG);
    LAS unsigned char* xs = F.lds + F.wave * (32 * S5_STRIDE);
    const int lane = F.lane, l31 = lane & 31, h = lane >> 5, l15 = lane & 15, q4 = lane >> 4;
    const int gw = F.bid * NWAVES + F.wave, NGW = F.G * NWAVES;
    const bool fwdrow = (l31 & 4) == 0; const int slot = (l31 & 3) + 4 * (l31 >> 3);
    for (int unit = gw; unit < BATCH * 64; unit += NGW) {
        const int b = unit >> 6, g = unit & 63;
        const f32x4 dsk = *(const f32x4*)(a.in[20] + ((size_t)i * 64 + g) * 16 + 4 * q4);
        bf16x8 bfr[2][2][2]; float lbr[2], lbi[2];
#pragma unroll
        for (int dir = 0; dir < 2; ++dir) { const size_t pg = ((size_t)(i * 2 + dir) * 64 + g); const float logdt = a.in[15][pg];
#pragma unroll
            for (int ph = 0; ph < 2; ++ph) { const int pp = 32 * ph + l31; float tbr, tbi, tcr, tci;
                zoh_params(a.in[13][pg * 64 + pp], a.in[14][pg * 64 + pp], logdt, tbr, tbi, tcr, tci);
                if (dir == 0) { lbr[ph] = tbr; lbi[ph] = tbi; } else { lbr[ph] = h ? tbr : lbr[ph]; lbi[ph] = h ? tbi : lbi[ph]; }
                const float* brp = a.in[16] + (pg * 64 + pp) * 16 + 8 * h; const float* bip = a.in[17] + (pg * 64 + pp) * 16 + 8 * h;
                const f32x4 r0 = *(const f32x4*)brp, r1 = *(const f32x4*)(brp + 4), m0 = *(const f32x4*)bip, m1 = *(const f32x4*)(bip + 4);
                bfr[dir][ph][0] = __builtin_bit_cast(bf16x8, pg8::pack8(r0 * tcr - m0 * tci, r1 * tcr - m1 * tci));
                bfr[dir][ph][1] = __builtin_bit_cast(bf16x8, pg8::pack8(m0 * tcr + r0 * tci, m1 * tcr + r1 * tci)); } }
        bf16x8 cf[2][4];
#pragma unroll
        for (int dir = 0; dir < 2; ++dir) { const size_t pg = ((size_t)(i * 2 + dir) * 64 + g);
#pragma unroll
            for (int ks = 0; ks < 4; ++ks) { const size_t co = (pg * 16 + l15) * 64 + 16 * ks + 4 * q4;
                const f32x4 cre = *(const f32x4*)(a.in[18] + co), cim = *(const f32x4*)(a.in[19] + co);
                u32x4 wv; wv.x = pk2(cre[0], -cim[0]); wv.y = pk2(cre[1], -cim[1]); wv.z = pk2(cre[2], -cim[2]); wv.w = pk2(cre[3], -cim[3]);
                cf[dir][ks] = __builtin_bit_cast(bf16x8, wv); } }
        float xr[2] = {0.f, 0.f}, xi[2] = {0.f, 0.f};
        const size_t seq0 = (size_t)b * SEQ;
        bf16x8 au_n = *(const bf16x8*)(XB + (seq0 + (fwdrow ? slot : 16 * 127 + 15 - slot)) * D + 16 * g + 8 * h);
#pragma unroll 1
        for (int j = 0; j < 128; ++j) {
            const bf16x8 au = au_n;
            const size_t orow_f = seq0 + 16 * j + l15, orow_b = seq0 + 16 * (127 - j) + l15;
            const size_t oo_f = orow_f * D + 16 * g + 4 * q4, oo_b = orow_b * D + 16 * g + 4 * q4;
            u32x2 yfp[2], uup[2];
            if (j >= 64) { yfp[0] = *(const u32x2*)(YF + oo_f); yfp[1] = *(const u32x2*)(YF + oo_b); uup[0] = *(const u32x2*)(XB + oo_f); uup[1] = *(const u32x2*)(XB + oo_b); }
            else { yfp[0] = yfp[1] = (u32x2){0u, 0u}; uup[0] = uup[1] = (u32x2){0u, 0u}; }
            const bf16x8 zero8 = {0, 0, 0, 0, 0, 0, 0, 0};
            const bf16x8 a0 = fwdrow ? au : zero8, a1 = fwdrow ? zero8 : au;
            f32x16 z16;
#pragma unroll
            for (int k = 0; k < 16; ++k) z16[k] = 0.f;
            f32x16 P[2][2];
#pragma unroll
            for (int ph = 0; ph < 2; ++ph)
#pragma unroll
                for (int ri = 0; ri < 2; ++ri) { P[ph][ri] = MFMA32(a0, bfr[0][ph][ri], z16); P[ph][ri] = MFMA32(a1, bfr[1][ph][ri], P[ph][ri]); }
            __builtin_amdgcn_sched_barrier(0);
            { const int jn = (j < 127) ? j + 1 : j;
              au_n = *(const bf16x8*)(XB + (seq0 + (fwdrow ? 16 * jn + slot : 16 * (127 - jn) + 15 - slot)) * D + 16 * g + 8 * h); }
#pragma unroll
            for (int t = 0; t < 16; ++t) {
#pragma unroll
                for (int ph = 0; ph < 2; ++ph) {
                    const float t1 = __builtin_fmaf(-lbi[ph], xi[ph], P[ph][0][t]), t2 = __builtin_fmaf(lbi[ph], xr[ph], P[ph][1][t]);
                    xr[ph] = __builtin_fmaf(lbr[ph], xr[ph], t1); xi[ph] = __builtin_fmaf(lbr[ph], xi[ph], t2);
                    asm volatile("" : "+v"(xr[ph]), "+v"(xi[ph]));
                    *(LAS unsigned*)(xs + (16 * h + t) * S5_STRIDE + 4 * (32 * ph + l31)) = pk2(xr[ph], xi[ph]);
                }
            }
            f32x4 y4[2];
#pragma unroll
            for (int dd = 0; dd < 2; ++dd) {
                y4[dd] = (f32x4){0.f, 0.f, 0.f, 0.f};
                const int srow = dd ? 16 + (15 - l15) : l15;
#pragma unroll
                for (int ks = 0; ks < 4; ++ks) { const bf16x8 bx = *(const LAS bf16x8*)(xs + srow * S5_STRIDE + (32 * ks + 8 * q4) * 2); y4[dd] = MFMA16(cf[dd][ks], bx, y4[dd]); }
            }
            if (j < 64) { u32x2 p0, p1; p0.x = pk2(y4[0][0], y4[0][1]); p0.y = pk2(y4[0][2], y4[0][3]); p1.x = pk2(y4[1][0], y4[1][1]); p1.y = pk2(y4[1][2], y4[1][3]); *(u32x2*)(YF + oo_f) = p0; *(u32x2*)(YF + oo_b) = p1; }
            else {
#pragma unroll
                for (int dd = 0; dd < 2; ++dd) { const u32x2 uu = uup[dd];
                    const f32x4 uv = {bf_lo(uu.x), bf_hi(uu.x), bf_lo(uu.y), bf_hi(uu.y)};
                    const f32x4 yp = {bf_lo(yfp[dd].x), bf_hi(yfp[dd].x), bf_lo(yfp[dd].y), bf_hi(yfp[dd].y)};
                    const f32x4 y = yp + y4[dd] + dsk * uv;
                    u32x2 ov; ov.x = pk2(gelu_tanh(y[0]), gelu_tanh(y[1])); ov.y = pk2(gelu_tanh(y[2]), gelu_tanh(y[3])); *(u32x2*)(YG + (dd ? oo_b : oo_f)) = ov; }
            }
            { u32x4 t_ = __builtin_bit_cast(u32x4, au_n); asm volatile("" : "+v"(t_.x), "+v"(t_.y), "+v"(t_.z), "+v"(t_.w)); au_n = __builtin_bit_cast(bf16x8, t_); }
            LDS_WAIT();
        }
    }
}

__global__ void __launch_bounds__(NWAVES * 64, 2) fwd_kernel(Args args_by_value) {
    extern __shared__ __attribute__((aligned(16))) unsigned char lds[];
    Frame F;
    F.lds = (LAS unsigned char*)lds;
    F.MISC = (volatile LAS unsigned*)(F.lds + MISC_OFF);
    F.tid = threadIdx.x; F.lane = F.tid & 63; F.wave = __builtin_amdgcn_readfirstlane(F.tid >> 6);
    F.G = gridDim.x; F.bid = blockIdx.x;
    { kptr_t kp = (kptr_t)__builtin_amdgcn_kernarg_segment_ptr(); F.out = *(GASP float* const __attribute__((address_space(4)))*)(kp + 8 * 27); F.ws = *(GASP unsigned char* const __attribute__((address_space(4)))*)(kp + 8 * 28); }
    F.ctl = (unsigned*)(F.ws + WS_CTL);
    const ArgsRef args{};
    for (int u = F.tid; u < (LDS_BYTES - LDSCTL_OFF) / 4; u += NWAVES * 64) ((LAS unsigned*)(F.lds + LDSCTL_OFF))[u] = 0u;
    __syncthreads();
    XcdBarrier bar = xcd_barrier_post((GASP unsigned*)(F.ws + WS_CTL) + CW_BAR, F.MISC + 8, F.tid == 0);
#define GRID_BAR() xcd_barrier(bar, F.wave)
#define XB ((bf16*)(F.ws + WS_XB))
#define Yb ((bf16*)(F.ws + WS_Y))
#define Wb ((const char*)(F.ws + WS_W))
#define cosT ((const float*)(F.ws + WS_ROPE))
#define sinT ((const float*)(F.ws + WS_ROPE) + SEQ * 32)

    RPT(10) PH(0) prologue(F, args);
    RPT(4) PH(1) conv_layer(F, args, 0);
    wmax_layer(F, args, 0);
    GRID_BAR();

#pragma unroll 1
    for (int lp = 0; lp < 2; ++lp) {
        {
            const int L = 2 * lp, i = lp;
            { UFRESH(F); pg8::Order S{}; S.nM = T / 256; S.nN = INW / 256; S.nwg = S.nM * S.nN; S.G = F.G; S.c = F.bid; S.A = (const char*)XB; S.Bt = Wb + W_IN; S.tstep = (size_t)256 * D * 2; S.estride = 0;
              RPT(0) PH(2) { pg8::EpiWin E{(bf16*)(F.ws + WS_Q), (bf16*)(F.ws + WS_K), (bf16*)(F.ws + WS_V), (bf16*)(F.ws + WS_ZU), (bf16*)(F.ws + WS_ZV), cosT, sinT, args.in[7] + (size_t)i * 512, args.in[8] + (size_t)i * 512};
              pg8::gemm_phase(F.lds, D, S, E, F.wave); } }
            GRID_BAR();
            RPT(2) PH(3) attn_phase(F, args.in[4] + (size_t)i * 8);
            RPT(9) PH(4) sgu_phase(F, args.in[6] + (size_t)i * 8 * 128);
            if (L == 0) conv_down(F, args, 0);
            GRID_BAR();
            { UFRESH(F); pg8::Order S{}; S.nM = T / 256; S.nN = D / 256; S.nwg = S.nM * S.nN; S.G = F.G; S.c = F.bid; S.A = (const char*)(F.ws + WS_MIX); S.Bt = Wb + W_OUT; S.tstep = (size_t)256 * D * 2; S.estride = 0;
              pg8::EpiPlain<true, false> E{Yb, D, XB, nullptr};
              RPT(0) PH(10) pg8::gemm_phase(F.lds, D, S, E, F.wave); }
            GRID_BAR();
            RPT(5) PH(5) ln_pass_plain(F, args.in[1] + (size_t)(L * 2 + 0) * D, args.in[2] + (size_t)(L * 2 + 0) * D, true);
            wmax_layer(F, args, L + 1);
            GRID_BAR();
            { UFRESH(F); pg8::Order S{}; S.nM = T / 256; S.nN = 2 * FF / 256; S.nwg = S.nM * S.nN; S.G = F.G; S.c = F.bid; S.A = (const char*)(F.ws + WS_XB8); S.Bt = Wb + W_GU; S.tstep = (size_t)256 * D; S.estride = 0;
              pg8::EpiPairI8 E{(unsigned char*)(F.ws + WS_H), FF, (const float*)(F.ws + WS_SX), (const float*)(F.ws + WS_SW)};
              RPT(0) PH(11) pg8::gemm_phase<pg8::EpiPairI8, 1>(F.lds, D / 2, S, E, F.wave); }
            GRID_BAR();
            { UFRESH(F); pg8::Order S{}; S.nM = T / 256; S.nN = D / 256; S.nwg = S.nM * S.nN; S.G = F.G; S.c = F.bid; S.A = (const char*)(F.ws + WS_H); S.Bt = Wb + W_DN; S.tstep = (size_t)256 * FF; S.estride = 0;
              pg8::EpiPlain<true, true> E{Yb, D, XB, (const float*)(F.ws + WS_SWD)};
              RPT(0) PH(10) pg8::gemm_phase<pg8::EpiPlain<true, true>, 2>(F.lds, FF / 2, S, E, F.wave); }
            GRID_BAR();
            RPT(5) PH(5) ln_pass_plain(F, args.in[1] + (size_t)(L * 2 + 1) * D, args.in[2] + (size_t)(L * 2 + 1) * D, false);
            RPT(4) PH(1) conv_layer(F, args, L + 1);
            RPT(4) conv_down(F, args, L + 1);
            GRID_BAR();
        }
        {
            const int L = 2 * lp + 1, i = lp;
            unsigned* cnt = F.ctl + CW_CNT + 64 * i;
            RPT(3) PH(6) s5_phase(F, args, i);
            GRID_BAR();
            { UFRESH(F); pg8::Order S{}; S.nM = T / 256; S.nN = 2 * D / 256; S.nwg = S.nM * S.nN; S.G = F.G; S.c = F.bid; S.A = (const char*)(F.ws + WS_YG); S.Bt = Wb + W_GLU; S.tstep = (size_t)256 * D * 2; S.estride = 0;
              pg8::EpiPair<1, true> E{Yb, D, XB};
              RPT(0) PH(12) pg8::gemm_phase(F.lds, D, S, E, F.wave); }
            GRID_BAR();
            if ((RG >> 6) & 1) { PH(7) ln_pass_router(F, args.in[1] + (size_t)(L * 2 + 0) * D, args.in[2] + (size_t)(L * 2 + 0) * D, args.in[23] + (size_t)i * D * 8, cnt + 1024, WS_YS - WS_RECI); }
            PH(7) ln_pass_router(F, args.in[1] + (size_t)(L * 2 + 0) * D, args.in[2] + (size_t)(L * 2 + 0) * D, args.in[23] + (size_t)i * D * 8, cnt, 0);
            if (L + 1 < 4) wmax_layer(F, args, L + 1);
            GRID_BAR();
            RPT(11) PH(8) moe_gather(F, cnt);
            GRID_BAR();
            {
                int tb[9], cn[8]; moe_tiles(cnt, tb, cn);
                const int ntt = tb[8], TC = 256, nch = (ntt + TC - 1) / TC;
RPT(1)
#pragma unroll 1
                for (int ch = 0; ch < nch; ++ch) {
                    const int t0 = ch * TC, t1 = (t0 + TC < ntt) ? t0 + TC : ntt, nM = (t1 > t0) ? t1 - t0 : 0;
                    { UFRESH(F); pg8::Order S{}; S.nM = nM; S.nN = 2 * FF / 256; S.nwg = S.nM * S.nN; S.G = F.G; S.c = F.bid; S.atile0 = t0; S.otile0 = 0; S.etile0 = t0;
                      S.A = (const char*)(F.ws + WS_XS); S.Bt = Wb + W_MGU; S.tstep = (size_t)256 * D; S.estride = (size_t)2 * FF * D;
#pragma unroll
                      for (int e = 0; e < 8; ++e) S.tb[e] = tb[e];
                      pg8::EpiPairI8 E{(unsigned char*)(F.ws + WS_HS), FF, (const float*)(F.ws + WS_SXS), (const float*)(F.ws + WS_SW)};
                      PH(13) pg8::gemm_phase<pg8::EpiPairI8, 1>(F.lds, D / 2, S, E, F.wave); }
                    GRID_BAR();
                    { UFRESH(F); pg8::Order S{}; S.nM = nM; S.nN = D / 256; S.nwg = S.nM * S.nN; S.G = F.G; S.c = F.bid; S.atile0 = 0; S.otile0 = t0; S.etile0 = t0;
                      S.A = (const char*)(F.ws + WS_HS); S.Bt = Wb + W_MDN; S.tstep = (size_t)256 * FF; S.estride = (size_t)D * FF;
#pragma unroll
                      for (int e = 0; e < 8; ++e) S.tb[e] = tb[e];
                      pg8::EpiPlain<false, true> E{(bf16*)(F.ws + WS_YS), D, nullptr, (const float*)(F.ws + WS_SWD)};
                      PH(14) pg8::gemm_phase<pg8::EpiPlain<false, true>, 2>(F.lds, FF / 2, S, E, F.wave); }
                    GRID_BAR();
                }
            }
            if ((RG >> 7) & 1) { PH(9) ln_pass_combine(F, args.in[1] + (size_t)(L * 2 + 1) * D, args.in[2] + (size_t)(L * 2 + 1) * D, cnt, L == 3, true); }
            PH(9) ln_pass_combine(F, args.in[1] + (size_t)(L * 2 + 1) * D, args.in[2] + (size_t)(L * 2 + 1) * D, cnt, L == 3, false);
            if (L + 1 < 4) { RPT(4) PH(1) conv_layer(F, args, L + 1); RPT(4) conv_down(F, args, L + 1); GRID_BAR(); }
        }
    }
}

extern "C" void kernel_launch(void* const* d_in, const int* in_sizes, int n_in, void* d_out, int out_size, void* d_ws, size_t ws_size, hipStream_t stream) {
    static int grid = 0;
    if (grid == 0) {
        if (n_in != 27 || in_sizes[0] != T * D || out_size != T * D || ws_size < WS_END) {
            fprintf(stderr, "kernel_launch: unexpected shapes (n_in %d, in0 %d, out %d, ws %zu; need ws >= %zu); nothing launched\n", n_in, n_in > 0 ? in_sizes[0] : -1, out_size, ws_size, (size_t)WS_END); grid = -1; return; }
        int dev = 0, cus = 0, per_cu = 0;
        if (hipGetDevice(&dev) != hipSuccess || hipDeviceGetAttribute(&cus, hipDeviceAttributeMultiprocessorCount, dev) != hipSuccess) { grid = -1; return; }
        if (hipFuncSetAttribute((const void*)fwd_kernel, hipFuncAttributeMaxDynamicSharedMemorySize, LDS_BYTES) != hipSuccess) { fprintf(stderr, "kernel_launch: hipFuncSetAttribute failed\n"); grid = -1; return; }
        if (hipOccupancyMaxActiveBlocksPerMultiprocessor(&per_cu, (const void*)fwd_kernel, NWAVES * 64, LDS_BYTES) != hipSuccess || per_cu < 1)
            fprintf(stderr, "kernel_launch: note: occupancy query reports %d workgroups per CU\n", per_cu);
        (void)hipGetLastError();
        grid = cus;
    }
    if (grid < 0) return;
    if (hipMemsetAsync((char*)d_ws + WS_CTL, 0, CTL_ZERO_BYTES, stream) != hipSuccess) return;
    Args a{};
    for (int i = 0; i < 27; ++i) a.in[i] = (const float*)d_in[i];
    a.out = (float*)d_out; a.ws = (unsigned char*)d_ws;
    hipLaunchKernelGGL(fwd_kernel, dim3(grid), dim3(NWAVES * 64), LDS_BYTES, stream, a);
}
```
